# Optimizing an MI355X kernel written in HIP

```python
import jax, jax.numpy as jnp
from jax import lax
import numpy as np


D_MODEL = 2048
BATCH = 8
SEQ = 2048
DEPTH = 1

GRID_W = 64
CTX_LEN = 256
HEAD_DIM = 128
MIX_WIDTH = D_MODEL
ATT_HEADS = MIX_WIDTH // 2 // HEAD_DIM
KV_HEADS = ATT_HEADS // 4
GROUP = ATT_HEADS // KV_HEADS
M_HEADS = (MIX_WIDTH - ATT_HEADS * HEAD_DIM) // HEAD_DIM
ATT_Q_W = ATT_HEADS * HEAD_DIM
KV_W = KV_HEADS * HEAD_DIM
M_W = M_HEADS * HEAD_DIM
N_GATES = 4 * M_HEADS
PROJ_WIDTH = ATT_Q_W + 2 * KV_W + 4 * M_W + N_GATES
SPLIT_POINTS = (ATT_Q_W, ATT_Q_W + KV_W, ATT_Q_W + 2 * KV_W, ATT_Q_W + 2 * KV_W + 2 * M_W,
                ATT_Q_W + 2 * KV_W + 3 * M_W, ATT_Q_W + 2 * KV_W + 4 * M_W)
AXIS_DIM = HEAD_DIM // 2
ROPE_THETA = 10000.0
Q_BLOCK = 128
MLSTM_CHUNK = 64
CONV_K = 5
D_FF = 256 * ((8 * D_MODEL // 3 + 255) // 256)
N_MOD = 9
RMS_EPS = 1e-6

kernel_name = 'hybrid_gqa_mlstm_macaron_dit_layer'


def rms_norm(x, g):
    xf = x.astype(jnp.float32)
    y = xf * lax.rsqrt(jnp.mean(xf * xf, axis=-1, keepdims=True) + RMS_EPS)
    return (y * g.astype(jnp.float32)).astype(x.dtype)


def adaln(x, g, mod, i):
    return rms_norm(x, g) * (1 + mod[:, i + 1, None, :]) + mod[:, i, None, :]


def half_step_ffn(x, mod, i, g, w_up, w_down):
    h = adaln(x, g, mod, i)
    a, b = jnp.split(h @ w_up, 2, axis=-1)
    return x + 0.5 * mod[:, i + 2, None, :] * ((jax.nn.silu(a) * b) @ w_down)


def axial_rope_tables(rows):
    row = jnp.repeat(jnp.arange(rows), GRID_W).astype(jnp.float32)
    col = jnp.tile(jnp.arange(GRID_W), rows).astype(jnp.float32)
    inv = jnp.power(ROPE_THETA, -jnp.arange(0, AXIS_DIM, 2, dtype=jnp.float32) / AXIS_DIM)
    ang_r = row[:, None] * inv[None, :]
    ang_c = col[:, None] * inv[None, :]
    return (jnp.cos(ang_r), jnp.sin(ang_r), jnp.cos(ang_c), jnp.sin(ang_c))


def rotate_half(x, cos, sin):
    x1, x2 = jnp.split(x, 2, axis=-1)
    c, s = cos[:, None, :], sin[:, None, :]
    return jnp.concatenate([x1 * c - x2 * s, x2 * c + x1 * s], axis=-1)


def apply_axial_rope(x, rope):
    cr, sr, cc, sc = rope
    xr, xcol = jnp.split(x.astype(jnp.float32), 2, axis=-1)
    return jnp.concatenate([rotate_half(xr, cr, sr), rotate_half(xcol, cc, sc)], axis=-1).astype(x.dtype)


def short_conv(x, w, b):
    y = lax.conv_general_dilated(x, w[:, None, :].astype(x.dtype), window_strides=(1,),
                                 padding=[(CONV_K // 2, CONV_K // 2)],
                                 dimension_numbers=('NWC', 'WIO', 'NWC'),
                                 feature_group_count=x.shape[-1])
    return y + b


def mixer_projections(h, w_in, q_gain, k_gain, conv_w, conv_b, gate_b, rope):
    B, T, _ = h.shape
    aq, ak, av, mqk, mv, mo, gt = jnp.split(h @ w_in, SPLIT_POINTS, axis=-1)
    aq = rms_norm(aq.reshape(B, T, ATT_HEADS, HEAD_DIM), q_gain)
    ak = rms_norm(ak.reshape(B, T, KV_HEADS, HEAD_DIM), k_gain)
    if rope is not None:
        aq = apply_axial_rope(aq, rope)
        ak = apply_axial_rope(ak, rope)
    av = av.reshape(B, T, KV_HEADS, HEAD_DIM)
    mq, mk = jnp.split(jax.nn.silu(short_conv(mqk, conv_w, conv_b)), 2, axis=-1)
    mq = mq.reshape(B, T, M_HEADS, HEAD_DIM)
    mk = mk.reshape(B, T, M_HEADS, HEAD_DIM) * HEAD_DIM ** -0.5
    mv = mv.reshape(B, T, M_HEADS, HEAD_DIM)
    mo = jax.nn.sigmoid(mo)
    gt = (gt.astype(jnp.float32) + gate_b.astype(jnp.float32)).reshape(B, T, 4, M_HEADS)
    ig_f = gt[:, :, 0]
    lf_f = jax.nn.log_sigmoid(gt[:, :, 1])
    ig_b = gt[:, :, 2]
    lf_b = jax.nn.log_sigmoid(gt[:, :, 3])
    return (aq, ak, av), (mq, mk, mv, mo, ig_f, lf_f, ig_b, lf_b)


def attend(q, k, v):
    s = jnp.einsum('bqhgd,bkhd->bhgqk', q, k, preferred_element_type=jnp.float32) * HEAD_DIM ** -0.5
    p = jax.nn.softmax(s, axis=-1).astype(v.dtype)
    return jnp.einsum('bhgqk,bkhd->bqhgd', p, v)


def latent_attention(q, k_all, v_all):
    B, T = q.shape[:2]
    qb = q.reshape(B, T // Q_BLOCK, Q_BLOCK, KV_HEADS, GROUP, HEAD_DIM).swapaxes(0, 1)
    out = lax.map(lambda blk: attend(blk, k_all, v_all), qb)
    return out.swapaxes(0, 1).reshape(B, T, ATT_Q_W)


def mlstm_chunk(carry, inp):
    C0, n0, m0 = carry
    q, k, v, ig, lf = inp
    L = q.shape[2]
    b = jnp.cumsum(lf, axis=-1)
    lower = jnp.tril(jnp.ones((L, L), dtype=bool))
    d_log = jnp.where(lower, b[..., :, None] - b[..., None, :] + ig[..., None, :], -jnp.inf)
    inter = b + m0[..., None]
    m = jnp.maximum(inter, jnp.max(d_log, axis=-1))
    s = jnp.einsum('bhld,bhsd->bhls', q, k) * jnp.exp(d_log - m[..., None])
    a = jnp.exp(inter - m)
    num = jnp.einsum('bhls,bhsd->bhld', s, v) + a[..., None] * jnp.einsum('bhld,bhde->bhle', q, C0)
    den = jnp.abs(jnp.sum(s, axis=-1) + a * jnp.einsum('bhld,bhd->bhl', q, n0))
    h = num / jnp.maximum(den, jnp.exp(-m))[..., None]
    g = b[..., -1:] - b + ig
    total = b[..., -1] + m0
    m_new = jnp.maximum(total, jnp.max(g, axis=-1))
    wg = jnp.exp(g - m_new[..., None])
    decay = jnp.exp(total - m_new)
    C_new = decay[..., None, None] * C0 + jnp.einsum('bhs,bhsd,bhse->bhde', wg, k, v)
    n_new = decay[..., None] * n0 + jnp.einsum('bhs,bhsd->bhd', wg, k)
    return (C_new, n_new, m_new), h


def mlstm_scan(q, k, v, ig, lf, state):
    B, T, H, d = q.shape
    nc = T // MLSTM_CHUNK

    def chunks(a):
        a = a.astype(jnp.float32).reshape((B, nc, MLSTM_CHUNK) + a.shape[2:])
        return jnp.moveaxis(jnp.moveaxis(a, 3, 2), 1, 0)

    state, h = lax.scan(mlstm_chunk, state, (chunks(q), chunks(k), chunks(v), chunks(ig), chunks(lf)))
    h = jnp.moveaxis(jnp.moveaxis(h, 0, 1), 2, 3).reshape(B, T, H, d)
    return h, state


def mlstm_bidir(q, k, v, ig_f, lf_f, ig_b, lf_b, s_f, s_b):
    h_f, s_f = mlstm_scan(q, k, v, ig_f, lf_f, s_f)
    flip = lambda a: jnp.flip(a, axis=1)
    h_b, s_b = mlstm_scan(flip(q), flip(k), flip(v), flip(ig_b), flip(lf_b), s_b)
    return (h_f + flip(h_b)).astype(q.dtype), s_f, s_b


def mixer_output(att, hm, mo, m_gain, w_out):
    B, T = att.shape[:2]
    hm = rms_norm(hm, m_gain.reshape(M_HEADS, HEAD_DIM)) * mo.reshape(B, T, M_HEADS, HEAD_DIM)
    return jnp.concatenate([att.reshape(B, T, ATT_Q_W), hm.reshape(B, T, M_W)], axis=-1) @ w_out


def setup_inputs(seed: int = 0) -> dict:
    key = jax.random.key(seed)
    ks = jax.random.split(key, 20)
    D = D_MODEL
    nrm = lambda k, shape, scale: jax.random.normal(k, shape, jnp.float32) * scale
    f_bias = jnp.linspace(3.0, 6.0, M_HEADS, dtype=jnp.float32)
    gate_sel = jnp.array([0.0, 1.0, 0.0, 1.0], jnp.float32)
    gate_b = (nrm(ks[16], (DEPTH, 4, M_HEADS), 0.1)
              + gate_sel[None, :, None] * f_bias[None, None, :]).reshape(DEPTH, N_GATES)
    return {
        'x': nrm(ks[0], (BATCH, SEQ, D), 1.0),
        'c': nrm(ks[1], (BATCH, D), 1.0),
        'ctx': nrm(ks[2], (BATCH, CTX_LEN, D), 1.0),
        'c_ctx': nrm(ks[3], (D,), 1.0),
        'w_mod': nrm(ks[4], (DEPTH, D, N_MOD * D), 0.5 * D ** -0.5),
        'b_mod': nrm(ks[5], (DEPTH, N_MOD * D), 0.02),
        'g_norm': 1.0 + nrm(ks[6], (DEPTH, 3, D), 0.02),
        'w_ffn1_up': nrm(ks[7], (DEPTH, D, 2 * D_FF), D ** -0.5),
        'w_ffn1_down': nrm(ks[8], (DEPTH, D_FF, D), D_FF ** -0.5),
        'w_ffn2_up': nrm(ks[9], (DEPTH, D, 2 * D_FF), D ** -0.5),
        'w_ffn2_down': nrm(ks[10], (DEPTH, D_FF, D), D_FF ** -0.5),
        'w_in': nrm(ks[11], (DEPTH, D, PROJ_WIDTH), D ** -0.5),
        'q_gain': 1.0 + nrm(ks[12], (DEPTH, HEAD_DIM), 0.02),
        'k_gain': 1.0 + nrm(ks[13], (DEPTH, HEAD_DIM), 0.02),
        'conv_w': nrm(ks[14], (DEPTH, CONV_K, 2 * M_W), CONV_K ** -0.5),
        'conv_b': nrm(ks[15], (DEPTH, 2 * M_W), 0.02),
        'gate_b': gate_b,
        'm_gain': 1.0 + nrm(ks[17], (DEPTH, M_W), 0.02),
        'w_out': nrm(ks[18], (DEPTH, MIX_WIDTH, D), MIX_WIDTH ** -0.5),
        'g_final': 1.0 + nrm(ks[19], (D,), 0.02),
    }


def reference(x, c, ctx, c_ctx, w_mod, b_mod, g_norm, w_ffn1_up, w_ffn1_down, w_ffn2_up, w_ffn2_down,
              w_in, q_gain, k_gain, conv_w, conv_b, gate_b, m_gain, w_out, g_final):
    B, T, _ = x.shape
    ROWS = T // GRID_W
    rope = axial_rope_tables(ROWS)
    silu_c = jax.nn.silu(c)
    silu_cc = jax.nn.silu(c_ctx)[None, :]
    zero_state = (jnp.zeros((B, M_HEADS, HEAD_DIM, HEAD_DIM), jnp.float32),
                  jnp.zeros((B, M_HEADS, HEAD_DIM), jnp.float32),
                  jnp.zeros((B, M_HEADS), jnp.float32))
    xl, xc = x, ctx
    for l in range(DEPTH):
        mod_l = (silu_c @ w_mod[l] + b_mod[l]).reshape(B, N_MOD, D_MODEL)
        mod_c = (silu_cc @ w_mod[l] + b_mod[l]).reshape(1, N_MOD, D_MODEL)
        xl = half_step_ffn(xl, mod_l, 0, g_norm[l, 0], w_ffn1_up[l], w_ffn1_down[l])
        xc = half_step_ffn(xc, mod_c, 0, g_norm[l, 0], w_ffn1_up[l], w_ffn1_down[l])
        hl = adaln(xl, g_norm[l, 1], mod_l, 3)
        hc = adaln(xc, g_norm[l, 1], mod_c, 3)
        mix = (w_in[l], q_gain[l], k_gain[l], conv_w[l], conv_b[l], gate_b[l])
        (aq_l, ak_l, av_l), m_l = mixer_projections(hl, *mix, rope)
        (aq_c, ak_c, av_c), m_c = mixer_projections(hc, *mix, None)
        hm_c, st_f, st_b = mlstm_bidir(*m_c[:3], *m_c[4:], zero_state, zero_state)
        hm_l, _, _ = mlstm_bidir(*m_l[:3], *m_l[4:], st_f, st_b)
        att_l = latent_attention(aq_l, jnp.concatenate([ak_c, ak_l], axis=1),
                                 jnp.concatenate([av_c, av_l], axis=1))
        xl = xl + mod_l[:, 5, None, :] * mixer_output(att_l, hm_l, m_l[3], m_gain[l], w_out[l])
        xl = half_step_ffn(xl, mod_l, 6, g_norm[l, 2], w_ffn2_up[l], w_ffn2_down[l])
        if l + 1 < DEPTH:
            Bc, Tc = aq_c.shape[:2]
            att_c = attend(aq_c.reshape(Bc, Tc, KV_HEADS, GROUP, HEAD_DIM), ak_c, av_c)
            xc = xc + mod_c[:, 5, None, :] * mixer_output(att_c, hm_c, m_c[3], m_gain[l], w_out[l])
            xc = half_step_ffn(xc, mod_c, 6, g_norm[l, 2], w_ffn2_up[l], w_ffn2_down[l])
    return rms_norm(xl, g_final)
```

```cpp
#include <hip/hip_runtime.h>
#include <hip/hip_cooperative_groups.h>
#include <cstdio>
#include <cstdint>
namespace cg = cooperative_groups;

#define LAS __attribute__((address_space(3)))
typedef unsigned short bf16_t;
typedef short bf16x8 __attribute__((ext_vector_type(8)));
typedef short s16x4 __attribute__((ext_vector_type(4)));
typedef float f32x4 __attribute__((ext_vector_type(4)));
typedef float f32x16 __attribute__((ext_vector_type(16)));
typedef unsigned u32x4 __attribute__((ext_vector_type(4)));
typedef unsigned u32x2 __attribute__((ext_vector_type(2)));

#ifndef PHMASK
#define PHMASK 0x1fff
#endif
#define HAS(k) ((PHMASK >> (k)) & 1)
#ifndef DUPMASK
#define DUPMASK 0
#endif
#ifndef MK_MULTI
#define MK_MULTI 0
#endif

constexpr int DM = 2048, NB = 8, TL = 2048, TCX = 256, NLAT = NB * TL, NCTX = NB * TCX, MR = NLAT + NCTX;
constexpr int DFF = 5632, NUP = 2 * DFF, PW = 5664, PWP = 5888, NMOD = 9, MODW = NMOD * DM;
constexpr int SKV = TCX + TL;
constexpr float RMS_EPS = 1e-6f;
constexpr int NPH = 13;

constexpr size_t al256(size_t x) { return (x + 255) / 256 * 256; }
constexpr size_t WS_MOD = 0;
constexpr size_t WS_CTR = WS_MOD + (size_t)9 * MODW * 4;
constexpr size_t WS_BAR = WS_CTR + 256;
constexpr size_t WS_RSS = al256(WS_BAR + 3456 * 4);
constexpr size_t WS_ROPE = WS_RSS + (size_t)NLAT * 4;
constexpr size_t WS_SW3 = al256(WS_ROPE + 4096 * 4);
constexpr size_t WS_WUP1 = WS_SW3 + (size_t)8 * NUP * 4;
constexpr size_t WS_WDN1 = WS_WUP1 + (size_t)NUP * DM * 2;
constexpr size_t WS_WIN = WS_WDN1 + (size_t)DM * DFF * 2;
constexpr size_t WS_WOUT = WS_WIN + (size_t)PWP * DM * 2;
constexpr size_t WS_WUP2 = WS_WOUT + (size_t)DM * DM * 2;
constexpr size_t WS_WDN2 = WS_WUP2 + (size_t)NUP * DM * 2;
constexpr size_t WS_H = WS_WDN2 + (size_t)DM * DFF * 2;
constexpr size_t WS_HID = WS_H + (size_t)MR * DM * 2;
constexpr size_t WS_Q = WS_HID;
constexpr size_t WS_K = WS_Q + (size_t)NLAT * 1024 * 2;
constexpr size_t WS_V = WS_K + (size_t)NB * SKV * 256 * 2;
constexpr size_t WS_MQK = WS_V + (size_t)NB * SKV * 256 * 2;
constexpr size_t WS_MV = WS_MQK + (size_t)MR * 2048 * 2;
constexpr size_t WS_MO = WS_MV + (size_t)MR * 1024 * 2;
constexpr size_t WS_GT = WS_MO + (size_t)NLAT * 1024 * 2;
constexpr size_t WS_PROJ_END = WS_GT + (size_t)MR * 32 * 4;
constexpr size_t WS_ATT = WS_HID + (size_t)MR * DFF * 2;
constexpr size_t WS_PART = WS_ATT;
constexpr size_t WS_XC = WS_ATT + (size_t)NLAT * 2048 * 2;
constexpr size_t WS_END = WS_XC + (size_t)NCTX * DM * 4;
static_assert(WS_PROJ_END <= WS_ATT, "projection outputs must fit in the hidden buffer");

constexpr int LDS_STAGE = 131072;
constexpr int LDS_RED = LDS_STAGE;
constexpr int LDS_CTL = LDS_STAGE + 8192;
constexpr int LDS_BYTES = LDS_CTL + 64;
constexpr int QS_LD = 136, JS_LD = 72;
constexpr int ML_QS = 0, ML_KS = ML_QS + 64 * QS_LD * 2, ML_KT = ML_KS + 64 * QS_LD * 2, ML_VT = ML_KT + 128 * 64 * 2, ML_PS = ML_VT + 144 * 64 * 2,
              ML_C0 = ML_PS + 64 * JS_LD * 2, ML_SC = ML_C0 + 144 * QS_LD * 2, ML_CW = ML_SC + 5 * 64 * 4, ML_CB = ML_CW + 5 * 256 * 4, ML_END = ML_CB + 256 * 4;
static_assert(ML_END <= LDS_BYTES, "mLSTM LDS");

struct Params {
    const float *x, *c, *ctx, *c_ctx, *w_mod, *b_mod, *g_norm, *w_up1, *w_dn1, *w_up2, *w_dn2, *w_in, *q_gain, *k_gain, *conv_w, *conv_b, *gate_b, *m_gain, *w_out, *g_final;
    float* out; unsigned char* ws; int ph_lo, ph_hi;
};

__device__ __forceinline__ int otid() { int t = threadIdx.x; asm volatile("" : "+v"(t)); return t; }
__device__ __forceinline__ unsigned cvt_pk_bf16(float lo, float hi) { unsigned r; asm volatile("v_cvt_pk_bf16_f32 %0, %1, %2" : "=v"(r) : "v"(lo), "v"(hi)); return r; }
__device__ __forceinline__ float bf2f(unsigned short v) { return __uint_as_float(((unsigned)v) << 16); }
__device__ __forceinline__ float silu_f(float x) { return x * __builtin_amdgcn_rcpf(1.0f + __expf(-x)); }
__device__ __forceinline__ float sigmoid_f(float x) { return __builtin_amdgcn_rcpf(1.0f + __expf(-x)); }
__device__ __forceinline__ float logsigmoid_f(float x) { return fminf(x, 0.f) - __logf(1.0f + __expf(-fabsf(x))); }

namespace pg8 {
constexpr int BM = 256, BK = 64, HALF = 128, HTB = HALF * BK * 2, NXCD = 8, WGM = 8;
__device__ __forceinline__ int lds_byte(int r, int c) { const int st = (r >> 4) * 2 + (c >> 5), rr = r & 15, cc = c & 31, ob = rr * 64 + cc * 2; return st * 1024 + (ob ^ (((ob >> 9) & 1) << 5)); }
__device__ __forceinline__ void stage_rc(int b, int& R, int& C) { const int st = b / 1024, sb = b % 1024, swz = sb ^ (((sb >> 9) & 1) << 5); R = (st >> 1) * 16 + swz / 64; C = (st & 1) * 32 + (swz % 64) / 2; }
__device__ __forceinline__ int perm32(int rho) { const int n = rho >> 4, i = rho & 15; return 8 * (i >> 2) + 4 * n + (i & 3); }
struct Unit { int pm, pn, ks; };
struct Gemm { const bf16_t* A; const bf16_t* Bt; int M, N, K, ld; };
struct StaticOrder {
    int nM, nN, nwg, G, c, pm0, nNr;
    __device__ void init(int M, int N, int G_, int c_, int pm0_ = 0, int ksplit = 1) { nM = M / BM; nNr = N / BM; nN = nNr * ksplit; nwg = nM * nN; G = G_; c = c_; pm0 = pm0_; }
    __device__ bool next(int i, Unit& u) const {
        const long L = (long)i * G + c; if (L >= nwg) return false;
        int wgid = (int)L; { const int q = nwg / NXCD, r = nwg % NXCD, xcd = wgid % NXCD, off = wgid / NXCD; wgid = (xcd < r ? xcd * (q + 1) : r * (q + 1) + (xcd - r) * q) + off; }
        const int nig = WGM * nN, gid = wgid / nig, fm = gid * WGM, gsz = (nM - fm) < WGM ? (nM - fm) : WGM;
        u.pm = pm0 + fm + ((wgid % nig) % gsz); const int pe = (wgid % nig) / gsz; u.pn = pe % nNr; u.ks = pe / nNr; return true;
    }
};

template <class Epi>
__device__ __forceinline__ void gemm_phase(LAS unsigned char* lds, const Gemm g, const StaticOrder& S, const Epi& E) {
    const int tid = otid(), wid = __builtin_amdgcn_readfirstlane(tid >> 6), lane = tid & 63, wr = wid >> 2, wc = wid & 3, fr = lane & 15, fq = lane >> 4;
    const int K = g.K, nt = K / BK;
    unsigned voffA[2], voffB[2];
#pragma unroll
    for (int i = 0; i < 2; ++i) { int R, C; stage_rc(tid * 16 + i * 8192, R, C); const int Rb = Epi::PERM ? ((R & ~31) + perm32(R & 31)) : R;
        voffA[i] = (unsigned)(R * g.ld + C) * 2u; voffB[i] = (unsigned)(Rb * g.ld + C) * 2u; }
    const size_t kstep = (size_t)(BK * 2);
    const size_t hstep = (size_t)HALF * g.ld * 2;
    const size_t ksB = (size_t)K * 2;
    const size_t tstep = 2 * hstep;
    const unsigned ldsw = (unsigned)wid * 1024u;
    const int aoff = lds_byte(wr * 64 + fr, fq * 8), boff = lds_byte(wc * 32 + fr, fq * 8);
#define PG8_SA(b, h) (((b) * 2 + (h)) * HTB)
#define PG8_SB(b, h) ((4 + (b) * 2 + (h)) * HTB)
#define PG8_STAGE(bufoff, gbase, voff) do { _Pragma("unroll") for (int _i = 0; _i < 2; ++_i) \
        __builtin_amdgcn_global_load_lds((const unsigned*)((const char*)(gbase) + (voff)[_i]), (LAS unsigned*)(lds + (bufoff) + ldsw + _i * 8192), 16, 0, 0); } while (0)
#define PG8_LDA(dst, b, h) do { _Pragma("unroll") for (int m = 0; m < 4; ++m) _Pragma("unroll") for (int k = 0; k < 2; ++k) dst[m][k] = *(const LAS bf16x8*)(lds + PG8_SA(b, h) + aoff + m * 2048 + k * 1024); } while (0)
#define PG8_LDB(dst, b, h) do { _Pragma("unroll") for (int n = 0; n < 2; ++n) _Pragma("unroll") for (int k = 0; k < 2; ++k) dst[n][k] = *(const LAS bf16x8*)(lds + PG8_SB(b, h) + boff + n * 2048 + k * 1024); } while (0)
#define PG8_MMA(ai, bj, At, Bt) do { __builtin_amdgcn_s_setprio(1); _Pragma("unroll") for (int m = 0; m < 4; ++m) _Pragma("unroll") for (int n = 0; n < 2; ++n) _Pragma("unroll") for (int k = 0; k < 2; ++k) \
        acc[ai][bj][m][n] = __builtin_amdgcn_mfma_f32_16x16x32_bf16(Bt[n][k], At[m][k], acc[ai][bj][m][n], 0, 0, 0); __builtin_amdgcn_s_setprio(0); } while (0)
#define PG8_WAIT_V(n) asm volatile("s_waitcnt vmcnt(" #n ")" ::: "memory")
#define PG8_WAIT_L(n) asm volatile("s_waitcnt lgkmcnt(" #n ")" ::: "memory")
#define PG8_BAR __builtin_amdgcn_s_barrier()
#define PG8_SCHED __builtin_amdgcn_sched_barrier(0)
    Unit cur, nxt; int ui = 0;
    if (!S.next(0, cur)) return;
    f32x4 acc[2][2][4][2];
#pragma unroll
    for (int a = 0; a < 2; ++a)
#pragma unroll
        for (int b = 0; b < 2; ++b)
#pragma unroll
            for (int m = 0; m < 4; ++m)
#pragma unroll
                for (int n = 0; n < 2; ++n) acc[a][b][m][n] = (f32x4){0.f, 0.f, 0.f, 0.f};
    bf16x8 At[4][2], B0[2][2], B1[2][2];
    typename Epi::Pre pre;
    const char* cA = (const char*)g.A + (size_t)cur.pm * tstep + cur.ks * ksB; const char* cB = (const char*)g.Bt + (size_t)cur.pn * tstep + cur.ks * ksB;
    PG8_STAGE(PG8_SB(0, 0), cB, voffB); PG8_STAGE(PG8_SA(0, 0), cA, voffA); PG8_STAGE(PG8_SB(0, 1), cB + hstep, voffB); PG8_STAGE(PG8_SA(0, 1), cA + hstep, voffA);
    if (wr == 1) PG8_BAR;
    PG8_WAIT_V(4); PG8_BAR;
    PG8_STAGE(PG8_SB(1, 0), cB + kstep, voffB); PG8_STAGE(PG8_SA(1, 0), cA + kstep, voffA); PG8_STAGE(PG8_SB(1, 1), cB + hstep + kstep, voffB);
    PG8_WAIT_V(6); PG8_BAR;
    for (;;) {
        const bool has_next = S.next(ui + 1, nxt);
        const char* nA = has_next ? (const char*)g.A + (size_t)nxt.pm * tstep + nxt.ks * ksB : cA; const char* nB = has_next ? (const char*)g.Bt + (size_t)nxt.pn * tstep + nxt.ks * ksB : cB;
        for (int t = 0; t < nt; t += 2) {
            const bool last = (t == nt - 2);
            if (last) E.prefetch(pre, cur, wr, wc, fr, fq);
            const char* a1 = cA + (size_t)(t + 1) * kstep;
            const char* a2 = last ? nA : cA + (size_t)(t + 2) * kstep; const char* b2 = last ? nB : cB + (size_t)(t + 2) * kstep;
            const char* a3 = a2 + kstep; const char* b3 = b2 + kstep;
            PG8_LDB(B0, 0, 0); PG8_SCHED; PG8_LDA(At, 0, 0); PG8_STAGE(PG8_SA(1, 1), a1 + hstep, voffA);
            PG8_WAIT_L(8); PG8_BAR; PG8_WAIT_L(0); PG8_MMA(0, 0, At, B0); PG8_BAR; PG8_SCHED;
            PG8_LDB(B1, 0, 1); PG8_STAGE(PG8_SB(0, 0), b2, voffB);
            PG8_BAR; PG8_WAIT_L(0); PG8_MMA(0, 1, At, B1); PG8_BAR;
            PG8_LDA(At, 0, 1); PG8_STAGE(PG8_SA(0, 0), a2, voffA);
            PG8_BAR; PG8_WAIT_L(0); PG8_MMA(1, 0, At, B0); PG8_BAR; PG8_SCHED;
            PG8_STAGE(PG8_SB(0, 1), b2 + hstep, voffB);
            PG8_WAIT_V(6); PG8_BAR; PG8_MMA(1, 1, At, B1); PG8_BAR;
            PG8_LDB(B0, 1, 0); PG8_SCHED; PG8_LDA(At, 1, 0); PG8_STAGE(PG8_SA(0, 1), a2 + hstep, voffA);
            PG8_WAIT_L(8); PG8_BAR; PG8_WAIT_L(0); PG8_MMA(0, 0, At, B0); PG8_BAR; PG8_SCHED;
            PG8_LDB(B1, 1, 1); PG8_STAGE(PG8_SB(1, 0), b3, voffB);
            PG8_BAR; PG8_WAIT_L(0); PG8_MMA(0, 1, At, B1); PG8_BAR;
            PG8_LDA(At, 1, 1); PG8_STAGE(PG8_SA(1, 0), a3, voffA);
            PG8_BAR; PG8_WAIT_L(0); PG8_MMA(1, 0, At, B0); PG8_BAR; PG8_SCHED;
            PG8_STAGE(PG8_SB(1, 1), b3 + hstep, voffB);
            PG8_WAIT_V(6); PG8_BAR; PG8_MMA(1, 1, At, B1); PG8_BAR;
        }
        E(acc, cur, wr, wc, fr, fq, pre);
        if (!has_next) break;
#pragma unroll
        for (int a = 0; a < 2; ++a)
#pragma unroll
            for (int b = 0; b < 2; ++b)
#pragma unroll
                for (int m = 0; m < 4; ++m)
#pragma unroll
                    for (int n = 0; n < 2; ++n) acc[a][b][m][n] = (f32x4){0.f, 0.f, 0.f, 0.f};
        cur = nxt; cA = nA; cB = nB; ++ui;
    }
    PG8_WAIT_V(0);
    if (wr == 0) PG8_BAR;
    PG8_BAR;
#undef PG8_SA
#undef PG8_SB
#undef PG8_STAGE
#undef PG8_LDA
#undef PG8_LDB
#undef PG8_MMA
#undef PG8_WAIT_V
#undef PG8_WAIT_L
#undef PG8_BAR
#undef PG8_SCHED
}
}

struct EpiSwiglu {
    static constexpr bool PERM = true;
    bf16_t* H; const float* rss; const bf16_t* sW;
    struct Pre { float rq[8]; u32x2 sa[2], sb[2]; };
    __device__ __forceinline__ void prefetch(Pre& q, const pg8::Unit& u, int wr, int wc, int fr, int fq) const {
#pragma unroll
        for (int n = 0; n < 2; ++n) { q.sa[n] = (u32x2){0u, 0u}; q.sb[n] = q.sa[n]; }
#pragma unroll
        for (int i = 0; i < 8; ++i) q.rq[i] = 0.f;
        if (rss != nullptr) { const bf16_t* bp = sW + (size_t)(u.pm >> 3) * NUP + u.pn * 256 + wc * 32 + 8 * fq; const float* rp = rss + u.pm * 256 + wr * 64 + fr;
#pragma unroll
            for (int n = 0; n < 2; ++n) { q.sa[n] = *(const u32x2*)(bp + 4 * n); q.sb[n] = *(const u32x2*)(bp + 128 + 4 * n); }
#pragma unroll
            for (int i = 0; i < 8; ++i) q.rq[i] = rp[(i >> 2) * 128 + (i & 3) * 16]; }
    }
    __device__ __forceinline__ void operator()(const f32x4 (&acc)[2][2][4][2], const pg8::Unit& u, int wr, int wc, int fr, int fq, const Pre& q) const {
        const int row0 = u.pm * 256 + wr * 64 + fr, col0 = u.pn * 128 + wc * 32 + 8 * fq;
        const bool fx = rss != nullptr;
        f32x4 sa[2], sb[2];
#pragma unroll
        for (int n = 0; n < 2; ++n) {
            sa[n] = (f32x4){__uint_as_float(q.sa[n].x << 16), __uint_as_float(q.sa[n].x & 0xffff0000u), __uint_as_float(q.sa[n].y << 16), __uint_as_float(q.sa[n].y & 0xffff0000u)};
            sb[n] = (f32x4){__uint_as_float(q.sb[n].x << 16), __uint_as_float(q.sb[n].x & 0xffff0000u), __uint_as_float(q.sb[n].y << 16), __uint_as_float(q.sb[n].y & 0xffff0000u)}; }
#pragma unroll
        for (int ai = 0; ai < 2; ++ai)
#pragma unroll
            for (int m = 0; m < 4; ++m) {
                const int row = row0 + ai * 128 + m * 16;
                bf16_t* rowp = H + (size_t)row * DFF + col0;
                const float rs = fx ? rsqrtf(q.rq[ai * 4 + m] * (1.0f / DM) + RMS_EPS) : 1.0f;
                const f32x4 a0 = acc[ai][0][m][0] * rs + sa[0], a1 = acc[ai][0][m][1] * rs + sa[1], b0 = acc[ai][1][m][0] * rs + sb[0], b1 = acc[ai][1][m][1] * rs + sb[1];
                float v[8];
#pragma unroll
                for (int j = 0; j < 4; ++j) { v[j] = silu_f(a0[j]) * b0[j]; v[4 + j] = silu_f(a1[j]) * b1[j]; }
                u32x4 w; w.x = cvt_pk_bf16(v[0], v[1]); w.y = cvt_pk_bf16(v[2], v[3]); w.z = cvt_pk_bf16(v[4], v[5]); w.w = cvt_pk_bf16(v[6], v[7]);
                *(u32x4*)rowp = w;
            }
    }
};
struct EpiResid {
    static constexpr bool PERM = false;
    struct Pre {}; __device__ __forceinline__ void prefetch(Pre&, const pg8::Unit&, int, int, int, int) const {}
    const float* x_in; float* out_l; unsigned char* wsb; const float* gnorm; int ph;
    __device__ __forceinline__ void operator()(const f32x4 (&acc)[2][2][4][2], const pg8::Unit& u, int wr, int wc, int fr, int fq, const Pre&) const {
        const float* resid_l = ph == 3 ? x_in : out_l; const float* resid_c = nullptr; float* out_c = nullptr;
        const float* mod = (const float*)(wsb + WS_MOD); const int gidx = ph == 3 ? 2 : (ph == 8 ? 5 : 8); const float coef = ph == 8 ? 1.0f : 0.5f;
        bf16_t* xb = ph == 8 ? (bf16_t*)(wsb + WS_H) : nullptr; float* rss = (float*)(wsb + WS_RSS); const float* gn = gnorm + 2 * DM; const int sidx = 7;
        const bool isctx = u.pm >= 64; const int b = isctx ? 8 : (u.pm >> 3);
        const int row0 = (isctx ? (u.pm - 64) : u.pm) * 256 + wr * 64 + fr, col0 = u.pn * 256 + wc * 32 + 4 * fq;
        const float* gp = mod + (size_t)(b * NMOD + gidx) * DM + col0;
        const float* rb = isctx ? resid_c : resid_l; float* ob = isctx ? out_c : out_l;
        const bool doxb = xb != nullptr;
        f32x4 gv[2][2], gm[2][2];
#pragma unroll
        for (int bj = 0; bj < 2; ++bj)
#pragma unroll
            for (int n = 0; n < 2; ++n) { gv[bj][n] = *(const f32x4*)(gp + bj * 128 + n * 16) * coef; gm[bj][n] = (f32x4){0.f, 0.f, 0.f, 0.f}; }
        if (doxb) { const float* sp = mod + (size_t)(b * NMOD + sidx) * DM + col0;
#pragma unroll
            for (int bj = 0; bj < 2; ++bj)
#pragma unroll
                for (int n = 0; n < 2; ++n) gm[bj][n] = *(const f32x4*)(gn + col0 + bj * 128 + n * 16) * (*(const f32x4*)(sp + bj * 128 + n * 16) + 1.0f); }
#pragma unroll
        for (int ai = 0; ai < 2; ++ai)
#pragma unroll
            for (int m = 0; m < 4; ++m) {
                const size_t o = (size_t)(row0 + ai * 128 + m * 16) * DM + col0;
                float ss = 0.f;
#pragma unroll
                for (int bj = 0; bj < 2; ++bj)
#pragma unroll
                    for (int n = 0; n < 2; ++n) { const f32x4 r = *(const f32x4*)(rb + o + bj * 128 + n * 16); const f32x4 v = r + gv[bj][n] * acc[ai][bj][m][n]; *(f32x4*)(ob + o + bj * 128 + n * 16) = v;
                        if (doxb) { ss += v[0] * v[0] + v[1] * v[1] + v[2] * v[2] + v[3] * v[3]; const f32x4 y = v * gm[bj][n]; u32x2 w; w.x = cvt_pk_bf16(y[0], y[1]); w.y = cvt_pk_bf16(y[2], y[3]); *(u32x2*)(xb + o + bj * 128 + n * 16) = w; } }
                if (doxb) { ss += __shfl_xor(ss, 16); ss += __shfl_xor(ss, 32); if (fq == 0) atomicAdd(rss + row0 + ai * 128 + m * 16, ss); }
            }
    }
};
struct EpiPartial {
    static constexpr bool PERM = false;
    float* P;
    struct Pre {}; __device__ __forceinline__ void prefetch(Pre&, const pg8::Unit&, int, int, int, int) const {}
    __device__ __forceinline__ void operator()(const f32x4 (&acc)[2][2][4][2], const pg8::Unit& u, int wr, int wc, int fr, int fq, const Pre&) const {
        const int row0 = (u.pm - 64) * 256 + wr * 64 + fr, col0 = u.pn * 256 + wc * 32 + 4 * fq;
        float* ob = P + (size_t)u.ks * NCTX * DM;
#pragma unroll
        for (int ai = 0; ai < 2; ++ai)
#pragma unroll
            for (int m = 0; m < 4; ++m) {
                const size_t o = (size_t)(row0 + ai * 128 + m * 16) * DM + col0;
#pragma unroll
                for (int bj = 0; bj < 2; ++bj)
#pragma unroll
                    for (int n = 0; n < 2; ++n) *(f32x4*)(ob + o + bj * 128 + n * 16) = acc[ai][bj][m][n];
            }
    }
};
__device__ __forceinline__ int win_src(int slot) {
    if (slot >= PW) return -1;
    if (slot >= 1280) return slot;
    const int head = slot >> 7, s = slot & 127, wc = s >> 5, n = (s >> 4) & 1, fq = (s >> 2) & 3, j = s & 3;
    return head * 128 + (wc >> 1) * 64 + n * 32 + (wc & 1) * 16 + fq * 4 + j;
}
struct EpiWin {
    static constexpr bool PERM = false;
    bf16_t *Q, *K, *V, *MQK, *MV, *MO; float* GT; const float *qg, *kg, *gb, *rope; LAS float* red;
    __device__ __forceinline__ void st4(bf16_t* p, f32x4 v) const { u32x2 w; w.x = cvt_pk_bf16(v[0], v[1]); w.y = cvt_pk_bf16(v[2], v[3]); *(u32x2*)p = w; }
    struct Pre {}; __device__ __forceinline__ void prefetch(Pre&, const pg8::Unit&, int, int, int, int) const {}
    __device__ __forceinline__ void operator()(const f32x4 (&acc)[2][2][4][2], const pg8::Unit& u, int wr, int wc, int fr, int fq, const Pre&) const {
        asm volatile("" : "+v"(fr), "+v"(fq));
        const int pn = u.pn; const bool isctx = u.pm >= 64;
        const int rt0 = wr * 64 + fr;
        const int grow0 = u.pm * 256 + rt0;
        if (pn <= 4) {
            const float* gain = pn < 4 ? qg : kg;
            const int d1 = (wc >> 1) * 64 + (wc & 1) * 16 + 4 * fq;
            const f32x4 g1 = *(const f32x4*)(gain + d1), g2 = *(const f32x4*)(gain + d1 + 32);
#pragma unroll
            for (int ai = 0; ai < 2; ++ai)
#pragma unroll
                for (int m = 0; m < 4; ++m)
#pragma unroll
                    for (int bj = 0; bj < 2; ++bj) {
                        const f32x4 a = acc[ai][bj][m][0], c = acc[ai][bj][m][1];
                        float ss = a[0] * a[0] + a[1] * a[1] + a[2] * a[2] + a[3] * a[3] + c[0] * c[0] + c[1] * c[1] + c[2] * c[2] + c[3] * c[3];
                        ss += __shfl_xor(ss, 16); ss += __shfl_xor(ss, 32);
                        if (fq == 0) red[((rt0 + ai * 128 + m * 16) * 2 + bj) * 4 + wc] = ss;
                    }
            asm volatile("s_waitcnt lgkmcnt(0)" ::: "memory"); __builtin_amdgcn_s_barrier(); asm volatile("" ::: "memory");
#pragma unroll
            for (int ai = 0; ai < 2; ++ai)
#pragma unroll
                for (int m = 0; m < 4; ++m) {
                    const int rl = rt0 + ai * 128 + m * 16, gr = grow0 + ai * 128 + m * 16;
                    int bidx, tok; if (isctx) { bidx = (gr - NLAT) >> 8; tok = (gr - NLAT) & 255; } else { bidx = gr >> 11; tok = gr & 2047; }
                    f32x4 cs = (f32x4){1.f, 1.f, 1.f, 1.f}, sn = (f32x4){0.f, 0.f, 0.f, 0.f};
                    if (!isctx) { const int pos = (wc >> 1) ? (tok & 63) : (tok >> 6); const int ro = pos * 32 + (wc & 1) * 16 + 4 * fq; cs = *(const f32x4*)(rope + ro); sn = *(const f32x4*)(rope + 2048 + ro); }
#pragma unroll
                    for (int bj = 0; bj < 2; ++bj) {
                        const f32x4 pr = *(const LAS f32x4*)(red + (rl * 2 + bj) * 4);
                        const float rs = __builtin_amdgcn_rsqf((pr[0] + pr[1] + pr[2] + pr[3]) * (1.0f / 128.0f) + RMS_EPS);
                        const f32x4 x1 = acc[ai][bj][m][0] * rs * g1, x2 = acc[ai][bj][m][1] * rs * g2;
                        const f32x4 y1 = x1 * cs - x2 * sn, y2 = x2 * cs + x1 * sn;
                        if (pn < 4) { if (!isctx) { bf16_t* qp = Q + (size_t)gr * 1024 + (pn * 2 + bj) * 128 + d1; st4(qp, y1); st4(qp + 32, y2); } }
                        else { bf16_t* kp = K + ((size_t)bidx * SKV + (isctx ? tok : TCX + tok)) * 256 + bj * 128 + d1; st4(kp, y1); st4(kp + 32, y2); }
                    }
                    __builtin_amdgcn_sched_barrier(0);
                }
        } else {
            const int cc0 = wc * 32 + 4 * fq;
#pragma unroll
            for (int ai = 0; ai < 2; ++ai)
#pragma unroll
                for (int m = 0; m < 4; ++m) {
                    const int gr = grow0 + ai * 128 + m * 16;
                    int bidx, tok; if (isctx) { bidx = (gr - NLAT) >> 8; tok = (gr - NLAT) & 255; } else { bidx = gr >> 11; tok = gr & 2047; }
#pragma unroll
                    for (int bj = 0; bj < 2; ++bj)
#pragma unroll
                        for (int n = 0; n < 2; ++n) {
                            const int cc = cc0 + bj * 128 + n * 16; const f32x4 v = acc[ai][bj][m][n];
                            if (pn == 5) st4(V + ((size_t)bidx * SKV + (isctx ? tok : TCX + tok)) * 256 + cc, v);
                            else if (pn < 14) st4(MQK + (size_t)gr * 2048 + (pn - 6) * 256 + cc, v);
                            else if (pn < 18) st4(MV + (size_t)gr * 1024 + (pn - 14) * 256 + cc, v);
                            else if (pn < 22) { if (!isctx) { f32x4 s; s[0] = sigmoid_f(v[0]); s[1] = sigmoid_f(v[1]); s[2] = sigmoid_f(v[2]); s[3] = sigmoid_f(v[3]); st4(MO + (size_t)gr * 1024 + (pn - 18) * 256 + cc, s); } }
                            else if (cc < 32) {
                                f32x4 t = v + *(const f32x4*)(gb + cc);
                                if (fq >= 2) { t[0] = logsigmoid_f(t[0]); t[1] = logsigmoid_f(t[1]); t[2] = logsigmoid_f(t[2]); t[3] = logsigmoid_f(t[3]); }
                                *(f32x4*)(GT + (size_t)gr * 32 + cc) = t;
                            }
                        }
                    __builtin_amdgcn_sched_barrier(0);
                }
        }
    }
};

__device__ __forceinline__ int up_src(int slot) { const int pn = slot >> 8, r = slot & 255; return (r >> 7) * DFF + pn * 128 + (r & 127); }
template <int MAP  >
__device__ __forceinline__ void prep_tile(const float* __restrict__ W, int Nsrc, bf16_t* __restrict__ Bt, int Kdim, int nt, int kt, LAS float* tl) {
    const int tid = otid();
    { const int n4 = tid & 63, kk = tid >> 6; const int slot = nt * 256 + 4 * n4;
      const int src = MAP == 0 ? slot : (MAP == 1 ? up_src(slot) : win_src(slot));
      f32x4 v[8];
#pragma unroll
      for (int pss = 0; pss < 8; ++pss) { v[pss] = (f32x4){0.f, 0.f, 0.f, 0.f}; if (src >= 0) v[pss] = *(const f32x4*)(W + (size_t)(kt * 64 + kk + pss * 8) * Nsrc + src); }
#pragma unroll
      for (int pss = 0; pss < 8; ++pss) *(LAS f32x4*)(tl + (kk + pss * 8) * 260 + 4 * n4) = v[pss]; }
    __syncthreads();
    { const int n = tid >> 1, kh = (tid & 1) * 32;
#pragma unroll
      for (int q = 0; q < 4; ++q) { float v[8];
#pragma unroll
          for (int e = 0; e < 8; ++e) v[e] = tl[(kh + q * 8 + e) * 260 + n];
          u32x4 w; w.x = cvt_pk_bf16(v[0], v[1]); w.y = cvt_pk_bf16(v[2], v[3]); w.z = cvt_pk_bf16(v[4], v[5]); w.w = cvt_pk_bf16(v[6], v[7]);
          *(u32x4*)(Bt + (size_t)(nt * 256 + n) * Kdim + kt * 64 + kh + q * 8) = w; } }
    __syncthreads();
}
__device__ __forceinline__ void prep_weights(const Params& p, LAS unsigned char* lds, int grp, int idx, int n) {
    LAS float* tl = (LAS float*)lds;
    constexpr int T_UP = (NUP / 256) * (DM / 64), T_DN = (DM / 256) * (DFF / 64), T_IN = (PWP / 256) * (DM / 64), T_OUT = (DM / 256) * (DM / 64);
    const int tot = grp == 0 ? T_UP : (grp == 1 ? T_DN + T_IN + T_OUT : T_UP + T_DN);
    for (int t = idx; t < tot; t += n) {
        int q = t;
        if (grp == 1) {
            if (q < T_DN) { prep_tile<0>(p.w_dn1, DM, (bf16_t*)(p.ws + WS_WDN1), DFF, q % (DM / 256), q / (DM / 256), tl); continue; } q -= T_DN;
            if (q < T_IN) { prep_tile<2>(p.w_in, PW, (bf16_t*)(p.ws + WS_WIN), DM, q % (PWP / 256), q / (PWP / 256), tl); continue; } q -= T_IN;
            prep_tile<0>(p.w_out, DM, (bf16_t*)(p.ws + WS_WOUT), DM, q % (DM / 256), q / (DM / 256), tl);
        } else {
            const float* wu = grp == 0 ? p.w_up1 : p.w_up2;
            if (q < T_UP) { prep_tile<1>(wu, NUP, (bf16_t*)(p.ws + (grp == 0 ? WS_WUP1 : WS_WUP2)), DM, q % (NUP / 256), q / (NUP / 256), tl); continue; } q -= T_UP;
            prep_tile<0>(p.w_dn2, DM, (bf16_t*)(p.ws + WS_WDN2), DFF, q % (DM / 256), q / (DM / 256), tl);
        }
    }
}
__device__ __forceinline__ void phase_prep(const Params& p, LAS unsigned char* lds, bool do_mod) {
    const int tid = otid(), G = gridDim.x, bid = blockIdx.x;
    float* mod = (float*)(p.ws + WS_MOD);
    LAS float* sv = (LAS float*)lds;
    LAS float* red = (LAS float*)(lds + 9 * 512 * 4);
    for (int item = bid; do_mod && item < 576; item += G) {
        const int cb = item >> 2, ks = item & 3;
        for (int i = tid; i < 9 * 512; i += 512) { const int b = i >> 9, k = i & 511; const float cv = b < 8 ? p.c[b * DM + ks * 512 + k] : p.c_ctx[ks * 512 + k]; sv[i] = silu_f(cv); }
        __syncthreads();
        const int c4 = tid & 31, kr = tid >> 5;
        f32x4 a[9];
#pragma unroll
        for (int b = 0; b < 9; ++b) a[b] = (f32x4){0.f, 0.f, 0.f, 0.f};
        for (int kk = kr; kk < 512; kk += 16) {
            const f32x4 w = *(const f32x4*)(p.w_mod + (size_t)(ks * 512 + kk) * MODW + cb * 128 + c4 * 4);
#pragma unroll
            for (int b = 0; b < 9; ++b) a[b] += w * sv[b * 512 + kk];
        }
#pragma unroll
        for (int b = 0; b < 9; ++b) *(LAS f32x4*)(red + (kr * 9 + b) * 128 + c4 * 4) = a[b];
        __syncthreads();
        for (int o = tid; o < 9 * 128; o += 512) { const int b = o >> 7, cidx = o & 127; float s = 0.f;
#pragma unroll
            for (int r = 0; r < 16; ++r) s += red[(r * 9 + b) * 128 + cidx];
            const int col = cb * 128 + cidx; if (ks == 0) s += p.b_mod[col];
            atomicAdd(mod + (size_t)b * MODW + col, s); }
        __syncthreads();
    }
    if (bid == G - 1) { float* rope = (float*)(p.ws + WS_ROPE);
        for (int i = tid; i < 2048; i += 512) { const int pos = i >> 5, idx = i & 31; const float inv = exp2f(-(float)idx * (13.287712379549449f / 32.0f)); const float ang = (float)pos * inv;
            rope[i] = cosf(ang); rope[2048 + i] = sinf(ang); } }
    prep_weights(p, lds, 0, bid, G);
}

template <int MODE>
__device__ __forceinline__ void phase_rows(const float* src_l, const float* src_c, int nrows, const float* g, const float* mod, int midx, bf16_t* outb, float* outf, const float* part) {
    const int wave = otid() >> 6, lane = otid() & 63;
    const int stride = gridDim.x * 8;
    for (int r0 = blockIdx.x * 8 + wave; r0 < nrows; r0 += 2 * stride) {
        f32x4 v[2][8]; float ss[2] = {0.f, 0.f};
#pragma unroll
        for (int q = 0; q < 2; ++q) {
            const int r = r0 + q * stride;
            if (r < nrows) {
                const bool isctx = r >= NLAT; const float* xp = isctx ? src_c + (size_t)(r - NLAT) * DM : src_l + (size_t)r * DM;
#pragma unroll
                for (int k = 0; k < 8; ++k) v[q][k] = *(const f32x4*)(xp + (k * 64 + lane) * 4);
                if (isctx && part) {
                    const float* gt = mod + (size_t)(8 * NMOD + 2) * DM; const float* pp = part + (size_t)(r - NLAT) * DM;
#pragma unroll
                    for (int k = 0; k < 8; ++k) { const int c = (k * 64 + lane) * 4;
                        const f32x4 sum = (*(const f32x4*)(pp + c) + *(const f32x4*)(pp + (size_t)NCTX * DM + c)) + (*(const f32x4*)(pp + (size_t)2 * NCTX * DM + c) + *(const f32x4*)(pp + (size_t)3 * NCTX * DM + c));
                        v[q][k] += *(const f32x4*)(gt + c) * 0.5f * sum; }
                }
#pragma unroll
                for (int k = 0; k < 8; ++k) ss[q] += v[q][k][0] * v[q][k][0] + v[q][k][1] * v[q][k][1] + v[q][k][2] * v[q][k][2] + v[q][k][3] * v[q][k][3];
            }
        }
#pragma unroll
        for (int o = 32; o >= 1; o >>= 1) { ss[0] += __shfl_xor(ss[0], o); ss[1] += __shfl_xor(ss[1], o); }
#pragma unroll
        for (int q = 0; q < 2; ++q) {
            const int r = r0 + q * stride;
            if (r < nrows) {
                const float rs = rsqrtf(ss[q] * (1.0f / DM) + RMS_EPS);
                if (MODE == 0) {
                    const int b = r >= NLAT ? 8 : (r >> 11);
                    const float* sh = mod + (size_t)(b * NMOD + midx) * DM; const float* sc = sh + DM;
#pragma unroll
                    for (int k = 0; k < 8; ++k) { const int c = (k * 64 + lane) * 4; const f32x4 gg = *(const f32x4*)(g + c), s1 = *(const f32x4*)(sc + c), s0 = *(const f32x4*)(sh + c);
                        const f32x4 y = v[q][k] * rs * gg * (s1 + 1.0f) + s0; u32x2 w; w.x = cvt_pk_bf16(y[0], y[1]); w.y = cvt_pk_bf16(y[2], y[3]); *(u32x2*)(outb + (size_t)r * DM + c) = w; }
                } else {
#pragma unroll
                    for (int k = 0; k < 8; ++k) { const int c = (k * 64 + lane) * 4; const f32x4 gg = *(const f32x4*)(g + c); *(f32x4*)(outf + (size_t)r * DM + c) = v[q][k] * rs * gg; }
                }
            }
        }
    }
}

namespace att {
constexpr int D = 128, NW = 8, QBLK = 32, KVBLK = 64;
constexpr float SCALE = 0.088388347648318440f, THR = 8.f;
constexpr int LDQ = 1024, LDK = 256, LDO = 2048;
constexpr size_t SHM_V = KVBLK * D * 2, SHM_K = KVBLK * D * 2, SHM_ATTN = 2 * SHM_V + 2 * SHM_K + NW * 64 * 4;
#define KSWZ(row, colB) ((row) * 256 + ((colB) ^ (((row) & 7) << 4)))
#define SBAR() __builtin_amdgcn_sched_barrier(0)
__device__ __forceinline__ int crow(int r, int hi) { return (r & 3) + 8 * (r >> 2) + 4 * hi; }
__device__ __forceinline__ void partialSM(f32x16& p0, f32x16& p1, float& m_reg, float& mn, float& alpha) {
  constexpr float C = SCALE * 1.4426950408889634f;
  float pmax = p0[0]; for (int r = 1; r < 16; ++r) pmax = fmaxf(pmax, p0[r]); for (int r = 0; r < 16; ++r) pmax = fmaxf(pmax, p1[r]);
  { auto rr = __builtin_amdgcn_permlane32_swap(__float_as_uint(pmax), __float_as_uint(pmax), false, false);
    pmax = fmaxf(__uint_as_float(rr[0]), __uint_as_float(rr[1])); }
  if (__builtin_expect(__all(pmax - m_reg <= THR / SCALE), 1)) { mn = m_reg; alpha = 1.f; }
  else { mn = fmaxf(m_reg, pmax); alpha = __builtin_amdgcn_exp2f((m_reg - mn) * C); m_reg = mn; }
  float mnC = -mn * C;
  for (int r = 0; r < 16; ++r) p0[r] = fmaf(p0[r], C, mnC); for (int r = 0; r < 16; ++r) p1[r] = fmaf(p1[r], C, mnC);
  for (int r = 0; r < 16; ++r) p0[r] = __builtin_amdgcn_exp2f(p0[r]);
}
__device__ __forceinline__ void finishSM(f32x16& p0, f32x16& p1, float alpha, float& l_reg, bf16x8& pa0, bf16x8& pa1, bf16x8& pa2, bf16x8& pa3) {
  for (int r = 0; r < 16; ++r) p1[r] = __builtin_amdgcn_exp2f(p1[r]);
  float ps = 0; for (int r = 0; r < 16; ++r) ps += p0[r]; for (int r = 0; r < 16; ++r) ps += p1[r];
  { auto rr = __builtin_amdgcn_permlane32_swap(__float_as_uint(ps), __float_as_uint(ps), false, false);
    ps = __uint_as_float(rr[0]) + __uint_as_float(rr[1]); }
  l_reg = l_reg * alpha + ps;
#define PK4(P, BASE, OUT) do { unsigned a0 = cvt_pk_bf16(P[BASE + 0], P[BASE + 1]), a1 = cvt_pk_bf16(P[BASE + 2], P[BASE + 3]);   \
    unsigned b0 = cvt_pk_bf16(P[BASE + 4], P[BASE + 5]), b1 = cvt_pk_bf16(P[BASE + 6], P[BASE + 7]);                              \
    auto r0 = __builtin_amdgcn_permlane32_swap(a0, b0, false, false); auto r1 = __builtin_amdgcn_permlane32_swap(a1, b1, false, false); \
    u32x4 w = {r0[0], r1[0], r0[1], r1[1]}; OUT = *reinterpret_cast<bf16x8*>(&w); } while (0)
  PK4(p0, 0, pa0); PK4(p0, 8, pa1); PK4(p1, 0, pa2); PK4(p1, 8, pa3);
#undef PK4
}
__device__ __forceinline__ void qkt(f32x16& p0, f32x16& p1, const bf16_t* Ks, const bf16x8* qr, int r32, int hi) {
  p0 = f32x16{}; p1 = f32x16{};
  for (int d0 = 0; d0 < 8; ++d0) { int cb = (d0 * 16 + hi * 8) * 2;
    bf16x8 b0 = *reinterpret_cast<const bf16x8*>((const char*)Ks + KSWZ(r32, cb));
    bf16x8 b1 = *reinterpret_cast<const bf16x8*>((const char*)Ks + KSWZ(32 + r32, cb));
    p0 = __builtin_amdgcn_mfma_f32_32x32x16_bf16(b0, qr[d0], p0, 0, 0, 0);
    p1 = __builtin_amdgcn_mfma_f32_32x32x16_bf16(b1, qr[d0], p1, 0, 0, 0); }
}
__device__ __forceinline__ int v_st(int k, int c) { const int kk = (k & ~0xC) | ((k & 4) << 1) | ((k & 8) >> 1); return ((kk >> 3) * 4 + (c >> 5)) * 512 + ((kk & 7) * 32 + (c & 31)) * 2; }
__device__ __forceinline__ int v_rd_base(int lane) { return ((lane & 3) << 3) | (((lane >> 2) & 3) << 6) | (((lane >> 4) & 1) << 5) | (((lane >> 5) & 1) << 8); }
constexpr int v_rd_off(int d0, int ks, int half) { return d0 * 512 + ks * 4096 + half * 2048; }
template <int OFF> __device__ __forceinline__ s16x4 tr_read(int vb) {
  s16x4 r; asm volatile("ds_read_b64_tr_b16 %0, %1 offset:%2" : "=&v"(r) : "v"(vb), "i"(OFF) : "memory"); return r;
}
template <int D0> __device__ __forceinline__ void pv_one(f32x16& od, int vb, bf16x8 pa0, bf16x8 pa1, bf16x8 pa2, bf16x8 pa3) {
  const s16x4 l0 = tr_read<v_rd_off(D0, 0, 0)>(vb), h0 = tr_read<v_rd_off(D0, 0, 1)>(vb), l1 = tr_read<v_rd_off(D0, 1, 0)>(vb), h1 = tr_read<v_rd_off(D0, 1, 1)>(vb);
  const s16x4 l2 = tr_read<v_rd_off(D0, 2, 0)>(vb), h2 = tr_read<v_rd_off(D0, 2, 1)>(vb), l3 = tr_read<v_rd_off(D0, 3, 0)>(vb), h3 = tr_read<v_rd_off(D0, 3, 1)>(vb);
  asm volatile("s_waitcnt lgkmcnt(0)" ::: "memory"); SBAR();
#define PK(L, H) (bf16x8){L[0], L[1], L[2], L[3], H[0], H[1], H[2], H[3]}
  od = __builtin_amdgcn_mfma_f32_32x32x16_bf16(pa0, PK(l0, h0), od, 0, 0, 0);
  od = __builtin_amdgcn_mfma_f32_32x32x16_bf16(pa1, PK(l1, h1), od, 0, 0, 0);
  od = __builtin_amdgcn_mfma_f32_32x32x16_bf16(pa2, PK(l2, h2), od, 0, 0, 0);
  od = __builtin_amdgcn_mfma_f32_32x32x16_bf16(pa3, PK(l3, h3), od, 0, 0, 0);
#undef PK
}
__device__ __forceinline__ void pv_d0(f32x16* o, int vb, bf16x8 pa0, bf16x8 pa1, bf16x8 pa2, bf16x8 pa3) {
  pv_one<0>(o[0], vb, pa0, pa1, pa2, pa3); pv_one<1>(o[1], vb, pa0, pa1, pa2, pa3); pv_one<2>(o[2], vb, pa0, pa1, pa2, pa3); pv_one<3>(o[3], vb, pa0, pa1, pa2, pa3);
}
__device__ __forceinline__ void attn_dense_body(const bf16_t* __restrict__ Qb, const bf16_t* __restrict__ Kh, const bf16_t* __restrict__ Vh, bf16_t* __restrict__ Ob, int seq, char* lds) {
  const int tid = otid(), wid = tid >> 6, lane = tid & 63, r32 = lane & 31, hi = lane >> 5;
  bf16_t* V_lds = (bf16_t*)lds; bf16_t* K_lds = (bf16_t*)(lds + 2 * SHM_V);
  float* ws = (float*)(lds + 2 * SHM_V + 2 * SHM_K) + wid * 64; float* li_l = ws; float* al_l = ws + 32;
  float m_reg = -1e30f, l_reg = 0; f32x16 o[4] = {}; bf16x8 qr[8];
  const bf16_t* Qw = Qb + (long)(wid * QBLK + r32) * LDQ + hi * 8;
#pragma unroll
  for (int d0 = 0; d0 < 8; ++d0) qr[d0] = *reinterpret_cast<const bf16x8*>(Qw + d0 * 16);
  const int sr = tid >> 4, sc = (tid & 15) * 8, vst0 = v_st(sr, sc), vst1 = v_st(32 + sr, sc);
  const int vb0 = (int)(uintptr_t)V_lds + v_rd_base(lane);
  struct { bf16x8 vs0, vs1, ks0, ks1; } sr_[2];
#define SLOAD(i, k0) do { sr_[i].vs0 = *reinterpret_cast<const bf16x8*>(&Vh[(long)((k0) + sr) * LDK + sc]); sr_[i].vs1 = *reinterpret_cast<const bf16x8*>(&Vh[(long)((k0) + 32 + sr) * LDK + sc]); \
    sr_[i].ks0 = *reinterpret_cast<const bf16x8*>(&Kh[(long)((k0) + sr) * LDK + sc]); sr_[i].ks1 = *reinterpret_cast<const bf16x8*>(&Kh[(long)((k0) + 32 + sr) * LDK + sc]); } while (0)
#define SWRITE(b, i) do { *(bf16x8*)((char*)V_lds + (b) * SHM_V + vst0) = sr_[i].vs0;          \
    *(bf16x8*)((char*)V_lds + (b) * SHM_V + vst1) = sr_[i].vs1; int kc = sc * 2;               \
    *(bf16x8*)((char*)K_lds + (b) * SHM_K + KSWZ(sr, kc)) = sr_[i].ks0;                       \
    *(bf16x8*)((char*)K_lds + (b) * SHM_K + KSWZ(32 + sr, kc)) = sr_[i].ks1; } while (0)
#define SWAIT() asm volatile("s_waitcnt vmcnt(4)" ::: "memory")
#define RESC(a) do { if (__any((a) < 1.f)) { if (hi == 0) al_l[r32] = (a); asm volatile("s_waitcnt lgkmcnt(0)" ::: "memory"); \
    for (int d = 0; d < 4; ++d) for (int r = 0; r < 16; ++r) o[d][r] *= al_l[crow(r, hi)]; } } while (0)
  f32x16 pA0, pA1, pB0, pB1; float mnA, mnB, alA, alB; bf16x8 pa0, pa1, pa2, pa3; const int NT = seq / KVBLK;
  constexpr int SE = 0, SO = 1;
  SLOAD(SE, 0); asm volatile("s_waitcnt vmcnt(0)" ::: "memory"); SWRITE(0, SE); __syncthreads();
  qkt(pA0, pA1, K_lds, qr, r32, hi); partialSM(pA0, pA1, m_reg, mnA, alA);
  SLOAD(SO, KVBLK); if (2 < NT) SLOAD(SE, 2 * KVBLK);
  SWAIT(); SWRITE(1, SO); __syncthreads();
  for (int j = 1; j + 1 < NT; j += 2) {
    SBAR(); qkt(pB0, pB1, (bf16_t*)((char*)K_lds + SHM_K), qr, r32, hi);
    finishSM(pA0, pA1, alA, l_reg, pa0, pa1, pa2, pa3); SBAR();
    SLOAD(SO, (j + 2) * KVBLK); SBAR();
    pv_d0(o, vb0, pa0, pa1, pa2, pa3); partialSM(pB0, pB1, m_reg, mnB, alB);
    __syncthreads(); SWAIT(); SWRITE(0, SE);
    RESC(alB); __syncthreads();
    SBAR(); qkt(pA0, pA1, K_lds, qr, r32, hi);
    finishSM(pB0, pB1, alB, l_reg, pa0, pa1, pa2, pa3); SBAR();
    if (j + 3 < NT) SLOAD(SE, (j + 3) * KVBLK); SBAR();
    pv_d0(o, vb0 + (int)SHM_V, pa0, pa1, pa2, pa3); partialSM(pA0, pA1, m_reg, mnA, alA);
    __syncthreads(); SWAIT(); SWRITE(1, SO);
    RESC(alA); __syncthreads();
  }
  SBAR(); qkt(pB0, pB1, (bf16_t*)((char*)K_lds + SHM_K), qr, r32, hi);
  finishSM(pA0, pA1, alA, l_reg, pa0, pa1, pa2, pa3); SBAR();
  pv_d0(o, vb0, pa0, pa1, pa2, pa3); partialSM(pB0, pB1, m_reg, mnB, alB);
  __syncthreads(); RESC(alB);
  finishSM(pB0, pB1, alB, l_reg, pa0, pa1, pa2, pa3); SBAR();
  pv_d0(o, vb0 + (int)SHM_V, pa0, pa1, pa2, pa3);
  if (hi == 0) li_l[r32] = l_reg; asm volatile("s_waitcnt lgkmcnt(0)" ::: "memory");
  float rli[16];
#pragma unroll
  for (int r = 0; r < 16; ++r) rli[r] = __builtin_amdgcn_rcpf(li_l[crow(r, hi)]);
  bf16_t* Ow = Ob + (long)(wid * QBLK) * LDO;
#pragma unroll
  for (int r = 0; r < 16; ++r) { int orow = crow(r, hi);
    for (int d0 = 0; d0 < 4; ++d0) Ow[(long)orow * LDO + d0 * 32 + r32] = (bf16_t)(cvt_pk_bf16(o[d0][r] * rli[r], 0.f) & 0xffffu); }
#undef SLOAD
#undef SWRITE
#undef SWAIT
#undef RESC
}
}

__device__ __forceinline__ void attn_unit(const Params& p, unsigned char* lds_generic, int u) {
    const int qb = u & 7, g = (u >> 3) & 3, kvh = (u >> 5) & 1, b = u >> 6, hq = kvh * 4 + g;
    const bf16_t* Q = (const bf16_t*)(p.ws + WS_Q) + ((size_t)(b * TL + qb * 256)) * 1024 + hq * 128;
    const bf16_t* K = (const bf16_t*)(p.ws + WS_K) + (size_t)b * SKV * 256 + kvh * 128;
    const bf16_t* V = (const bf16_t*)(p.ws + WS_V) + (size_t)b * SKV * 256 + kvh * 128;
    bf16_t* O = (bf16_t*)(p.ws + WS_ATT) + ((size_t)(b * TL + qb * 256)) * 2048 + hq * 128;
    __syncthreads();
    att::attn_dense_body(Q, K, V, O, SKV, (char*)lds_generic);
}

__device__ __forceinline__ int jsw(int r, int c) { return r * 64 + ((((c) >> 3) ^ ((r ^ (r >> 3)) & 7)) << 3) + (c & 7); }
__device__ __forceinline__ f32x4 mfma16(bf16x8 a, bf16x8 b, f32x4 c) { return __builtin_amdgcn_mfma_f32_16x16x32_bf16(a, b, c, 0, 0, 0); }
__device__ __forceinline__ void mlstm_stream(const Params& p, LAS unsigned char* lds, int sid) {
    const int tid = otid(), w = __builtin_amdgcn_readfirstlane(tid >> 6), lane = tid & 63, fr = lane & 15, fq = lane >> 4;
    const int dir = sid & 1, h = (sid >> 1) & 7, b = sid >> 4;
    LAS bf16_t* Qs = (LAS bf16_t*)(lds + ML_QS); LAS bf16_t* Ks = (LAS bf16_t*)(lds + ML_KS); LAS bf16_t* KT = (LAS bf16_t*)(lds + ML_KT);
    LAS bf16_t* VT = (LAS bf16_t*)(lds + ML_VT); LAS bf16_t* Ps = (LAS bf16_t*)(lds + ML_PS); LAS bf16_t* C0 = (LAS bf16_t*)(lds + ML_C0);
    LAS float* sc_u = (LAS float*)(lds + ML_SC); LAS float* sc_pm = sc_u + 64; LAS float* sc_a = sc_u + 128; LAS float* sc_e = sc_u + 192;
    LAS float* cw = (LAS float*)(lds + ML_CW); LAS float* cbv = (LAS float*)(lds + ML_CB);
    const bf16_t* MQK = (const bf16_t*)(p.ws + WS_MQK); const bf16_t* MV = (const bf16_t*)(p.ws + WS_MV); const float* GT = (const float*)(p.ws + WS_GT);
    bf16_t* HO = (bf16_t*)(p.ws + WS_H) + (size_t)dir * NLAT * 1024;
    const int cg8 = (tid & 15) * 8, rg = tid >> 4, tl0 = 2 * rg;
    const int i0 = dir ? 63 - tl0 : tl0, i1 = dir ? i0 - 1 : i0 + 1, ie = dir ? i1 : i0;
    __syncthreads();
    for (int i = tid; i < 16 * 64; i += 512) VT[128 * 64 + i] = 0x3F80;
    for (int i = tid; i < 5 * 256; i += 512) { const int j = i >> 8, c = i & 255; cw[i] = p.conv_w[j * 2048 + (c < 128 ? h * 128 + c : 1024 + h * 128 + (c - 128))]; }
    for (int i = tid; i < 256; i += 512) cbv[i] = p.conv_b[i < 128 ? h * 128 + i : 1024 + h * 128 + (i - 128)];
    f32x4 C[9];
#pragma unroll
    for (int i = 0; i < 9; ++i) C[i] = (f32x4){0.f, 0.f, 0.f, 0.f};
    float m0 = 0.f;
    bf16x8 xq[6], xk[6], xv0, xv1; float g_ig, g_lf;
#define ML_CHUNK(ci_, lat_, chunk_, TS_, rbase_, t0_) const bool lat_ = (ci_) >= 4; const int chunk_ = lat_ ? (dir ? 35 - (ci_) : (ci_) - 4) : (dir ? 3 - (ci_) : (ci_)); \
        const int TS_ = lat_ ? TL : TCX; const size_t rbase_ = lat_ ? (size_t)b * TL : (size_t)NLAT + (size_t)b * TCX; const int t0_ = chunk_ * 64;
#define ML_LOAD(ci_) do { ML_CHUNK(ci_, l_, c_, ts_, rb_, t_) \
        { const int tl = dir ? 63 - lane : lane; const size_t row = rb_ + t_ + tl; g_ig = GT[row * 32 + dir * 16 + h]; g_lf = GT[row * 32 + dir * 16 + 8 + h]; } \
        _Pragma("unroll") for (int rr = 0; rr < 6; ++rr) { const int sl = t_ + tl0 - 2 + rr; xq[rr] = (bf16x8){0, 0, 0, 0, 0, 0, 0, 0}; xk[rr] = xq[rr]; \
            if (sl >= 0 && sl < ts_) { const bf16_t* src = MQK + (rb_ + sl) * 2048 + h * 128 + cg8; xq[rr] = *(const bf16x8*)src; xk[rr] = *(const bf16x8*)(src + 1024); } } \
        xv0 = *(const bf16x8*)(MV + (rb_ + t_ + tl0) * 1024 + h * 128 + cg8); xv1 = *(const bf16x8*)(MV + (rb_ + t_ + tl0 + 1) * 1024 + h * 128 + cg8); } while (0)
    ML_LOAD(0);
    __syncthreads();
    for (int ci = 0; ci < 36; ++ci) {
        ML_CHUNK(ci, lat, chunk, TS, rbase, t0)
        (void)TS;
        float wgt, decay, m0n;
        {
            float bc = g_lf;
#pragma unroll
            for (int d = 1; d < 64; d <<= 1) { const float v = __shfl_up(bc, d); if (lane >= d) bc += v; }
            const float uu = g_ig - bc; float px = uu;
#pragma unroll
            for (int d = 1; d < 64; d <<= 1) { const float v = __shfl_up(px, d); if (lane >= d) px = fmaxf(px, v); }
            const float pm = fmaxf(m0, px);
            const float bL = __shfl(bc, 63), pmL = __shfl(pm, 63);
            wgt = __expf(uu - pmL); decay = __expf(m0 - pmL); m0n = bL + pmL;
            if (w == 0) { sc_u[lane] = uu; sc_pm[lane] = pm; sc_a[lane] = __expf(m0 - pm); sc_e[lane] = __expf(-bc - pm); }
        }
        {
            const float w0 = __shfl(wgt, i0), w1 = __shfl(wgt, i1);
#pragma unroll
            for (int qk = 0; qk < 2; ++qk) {
                if (qk == 0 && !lat) continue;
                float y0[8], y1[8];
#pragma unroll
                for (int e = 0; e < 8; ++e) { y0[e] = cbv[qk * 128 + cg8 + e]; y1[e] = y0[e]; }
#pragma unroll
                for (int j = 0; j < 5; ++j) {
                    const f32x4 wa = *(const LAS f32x4*)(cw + j * 256 + qk * 128 + cg8), wb = *(const LAS f32x4*)(cw + j * 256 + qk * 128 + cg8 + 4);
#pragma unroll
                    for (int e = 0; e < 8; ++e) { const float wv = e < 4 ? wa[e] : wb[e - 4]; const bf16x8 xa = qk ? xk[j] : xq[j], xb = qk ? xk[j + 1] : xq[j + 1];
                        y0[e] += wv * bf2f((unsigned short)xa[e]); y1[e] += wv * bf2f((unsigned short)xb[e]); }
                }
                const float ksc = qk ? 0.08838834764831845f : 1.0f;
#pragma unroll
                for (int e = 0; e < 8; ++e) { y0[e] = silu_f(y0[e]) * ksc; y1[e] = silu_f(y1[e]) * ksc; }
                LAS bf16_t* dst = qk ? Ks : Qs;
                u32x4 p0, p1; p0.x = cvt_pk_bf16(y0[0], y0[1]); p0.y = cvt_pk_bf16(y0[2], y0[3]); p0.z = cvt_pk_bf16(y0[4], y0[5]); p0.w = cvt_pk_bf16(y0[6], y0[7]);
                p1.x = cvt_pk_bf16(y1[0], y1[1]); p1.y = cvt_pk_bf16(y1[2], y1[3]); p1.z = cvt_pk_bf16(y1[4], y1[5]); p1.w = cvt_pk_bf16(y1[6], y1[7]);
                *(LAS u32x4*)(dst + i0 * QS_LD + cg8) = p0; *(LAS u32x4*)(dst + i1 * QS_LD + cg8) = p1;
                if (qk) {
#pragma unroll
                    for (int e = 0; e < 8; ++e) { const float a0 = y0[e] * w0, a1 = y1[e] * w1; *(LAS unsigned*)(KT + jsw(cg8 + e, ie)) = dir ? cvt_pk_bf16(a1, a0) : cvt_pk_bf16(a0, a1); }
                }
            }
#pragma unroll
            for (int e = 0; e < 8; ++e) { const unsigned lo = (unsigned short)(dir ? xv1[e] : xv0[e]), hi = (unsigned short)(dir ? xv0[e] : xv1[e]); *(LAS unsigned*)(VT + jsw(cg8 + e, ie)) = lo | (hi << 16); }
        }
        if (ci + 1 < 36) ML_LOAD(ci + 1);
        __syncthreads();
        if (lat) {
            const int it = w >> 1;
#pragma unroll
            for (int jj = 0; jj < 2; ++jj) {
                const int jt = (w & 1) * 2 + jj;
                f32x4 s = (f32x4){0.f, 0.f, 0.f, 0.f};
                if (jt <= it) {
#pragma unroll
                    for (int ks = 0; ks < 4; ++ks) { const bf16x8 a = *(const LAS bf16x8*)(Ks + (jt * 16 + fr) * QS_LD + ks * 32 + fq * 8), bb = *(const LAS bf16x8*)(Qs + (it * 16 + fr) * QS_LD + ks * 32 + fq * 8); s = mfma16(a, bb, s); }
                    const int i = it * 16 + fr, j0 = jt * 16 + 4 * fq; const float pmi = sc_pm[i]; const f32x4 uj = *(const LAS f32x4*)(sc_u + j0);
#pragma unroll
                    for (int r = 0; r < 4; ++r) s[r] = (j0 + r <= i) ? s[r] * __expf(uj[r] - pmi) : 0.f;
                }
                u32x2 pw; pw.x = cvt_pk_bf16(s[0], s[1]); pw.y = cvt_pk_bf16(s[2], s[3]);
                *(LAS u32x2*)(Ps + (it * 16 + fr) * JS_LD + jt * 16 + 4 * fq) = pw;
            }
#pragma unroll
            for (int nt = 0; nt < 9; ++nt) { u32x2 cwd; cwd.x = cvt_pk_bf16(C[nt][0], C[nt][1]); cwd.y = cvt_pk_bf16(C[nt][2], C[nt][3]); *(LAS u32x2*)(C0 + (nt * 16 + fr) * QS_LD + w * 16 + 4 * fq) = cwd; }
        }
        {
            const bf16x8 a0 = *(const LAS bf16x8*)(KT + jsw(w * 16 + fr, fq * 8)), a1 = *(const LAS bf16x8*)(KT + jsw(w * 16 + fr, 32 + fq * 8));
#pragma unroll
            for (int nt = 0; nt < 9; ++nt) { C[nt] *= decay;
                C[nt] = mfma16(a0, *(const LAS bf16x8*)(VT + jsw(nt * 16 + fr, fq * 8)), C[nt]); C[nt] = mfma16(a1, *(const LAS bf16x8*)(VT + jsw(nt * 16 + fr, 32 + fq * 8)), C[nt]); }
        }
        __syncthreads();
        if (lat) {
            const int it = w >> 1, dvh = w & 1, i = it * 16 + fr;
            f32x4 ac[5];
#pragma unroll
            for (int t = 0; t < 5; ++t) ac[t] = (f32x4){0.f, 0.f, 0.f, 0.f};
#pragma unroll
            for (int ks = 0; ks < 4; ++ks) { const bf16x8 bq = *(const LAS bf16x8*)(Qs + i * QS_LD + ks * 32 + fq * 8);
#pragma unroll
                for (int t = 0; t < 5; ++t) { const int row = (t < 4 ? (dvh * 4 + t) * 16 : 128) + fr; ac[t] = mfma16(*(const LAS bf16x8*)(C0 + row * QS_LD + ks * 32 + fq * 8), bq, ac[t]); } }
            const float ai = sc_a[i];
#pragma unroll
            for (int t = 0; t < 5; ++t) ac[t] *= ai;
#pragma unroll
            for (int ks = 0; ks < 2; ++ks) { const bf16x8 bp = *(const LAS bf16x8*)(Ps + i * JS_LD + ks * 32 + fq * 8);
#pragma unroll
                for (int t = 0; t < 5; ++t) { const int row = (t < 4 ? (dvh * 4 + t) * 16 : 128) + fr; ac[t] = mfma16(*(const LAS bf16x8*)(VT + jsw(row, ks * 32 + fq * 8)), bp, ac[t]); } }
            const float den = fmaxf(fabsf(ac[4][0]), sc_e[i]); const float rd = 1.0f / den;
            const size_t row = rbase + t0 + (dir ? 63 - i : i);
#pragma unroll
            for (int t = 0; t < 4; ++t) { u32x2 hw; hw.x = cvt_pk_bf16(ac[t][0] * rd, ac[t][1] * rd); hw.y = cvt_pk_bf16(ac[t][2] * rd, ac[t][3] * rd);
                *(u32x2*)(HO + row * 1024 + h * 128 + (dvh * 4 + t) * 16 + 4 * fq) = hw; }
        }
        m0 = m0n;
        __syncthreads();
    }
#undef ML_LOAD
#undef ML_CHUNK
}

__device__ __forceinline__ void phase_combine(const Params& p) {
    const bf16_t* HF = (const bf16_t*)(p.ws + WS_H); const bf16_t* HB = HF + (size_t)NLAT * 1024; const bf16_t* MO = (const bf16_t*)(p.ws + WS_MO);
    bf16_t* AT = (bf16_t*)(p.ws + WS_ATT);
    const int tid = otid(), c8 = (tid & 127) * 8, rq = tid >> 7;
    f32x4 g0 = *(const f32x4*)(p.m_gain + c8), g1 = *(const f32x4*)(p.m_gain + c8 + 4);
    for (int r = blockIdx.x * 4 + rq; r < NLAT; r += gridDim.x * 4) {
        const bf16x8 a = *(const bf16x8*)(HF + (size_t)r * 1024 + c8), bb = *(const bf16x8*)(HB + (size_t)r * 1024 + c8), mo = *(const bf16x8*)(MO + (size_t)r * 1024 + c8);
        float x[8], ss = 0.f;
#pragma unroll
        for (int e = 0; e < 8; ++e) { x[e] = bf2f((unsigned short)a[e]) + bf2f((unsigned short)bb[e]); ss += x[e] * x[e]; }
        ss += __shfl_xor(ss, 1); ss += __shfl_xor(ss, 2); ss += __shfl_xor(ss, 4); ss += __shfl_xor(ss, 8);
        const float rs = rsqrtf(ss * (1.0f / 128.0f) + RMS_EPS);
        float y[8];
#pragma unroll
        for (int e = 0; e < 8; ++e) y[e] = x[e] * rs * (e < 4 ? g0[e] : g1[e - 4]) * bf2f((unsigned short)mo[e]);
        u32x4 wv; wv.x = cvt_pk_bf16(y[0], y[1]); wv.y = cvt_pk_bf16(y[2], y[3]); wv.z = cvt_pk_bf16(y[4], y[5]); wv.w = cvt_pk_bf16(y[6], y[7]);
        *(u32x4*)(AT + (size_t)r * 2048 + 1024 + c8) = wv;
    }
}

__device__ __forceinline__ void phase_shiftw(const float* mod, int sidx, const bf16_t* Bt, int nslots, bf16_t* sW) {
    const int wave = otid() >> 6, lane = otid() & 63;
    const int per = (nslots + gridDim.x - 1) / gridDim.x, s0 = blockIdx.x * per;
    for (int i0 = wave; i0 < per; i0 += 24) {
        bf16x8 rv[3][4];
#pragma unroll
        for (int j = 0; j < 3; ++j) { const int sl = s0 + i0 + 8 * j; const bool ok = (i0 + 8 * j < per) && sl < nslots;
#pragma unroll
            for (int q = 0; q < 4; ++q) rv[j][q] = ok ? *(const bf16x8*)(Bt + (size_t)sl * DM + (q * 64 + lane) * 8) : (bf16x8){0, 0, 0, 0, 0, 0, 0, 0}; }
        for (int b = 0; b < 8; ++b) {
            const float* sh = mod + (size_t)(b * NMOD + sidx) * DM;
            float a[3] = {0.f, 0.f, 0.f};
#pragma unroll
            for (int q = 0; q < 4; ++q) { const f32x4 sA = *(const f32x4*)(sh + (q * 64 + lane) * 8), sB = *(const f32x4*)(sh + (q * 64 + lane) * 8 + 4);
#pragma unroll
                for (int j = 0; j < 3; ++j)
#pragma unroll
                    for (int e = 0; e < 8; ++e) a[j] += bf2f((unsigned short)rv[j][q][e]) * (e < 4 ? sA[e] : sB[e - 4]); }
#pragma unroll
            for (int j = 0; j < 3; ++j) {
#pragma unroll
                for (int o = 32; o >= 1; o >>= 1) a[j] += __shfl_xor(a[j], o);
                const int sl = s0 + i0 + 8 * j; if (lane == 0 && (i0 + 8 * j < per) && sl < nslots) sW[(size_t)b * nslots + sl] = (bf16_t)(cvt_pk_bf16(a[j], 0.f) & 0xffffu); }
        }
    }
}

#define XB_TMO      128
#define XB_XCNT(j)  (256  + 64 * (j))
#define XB_XSUB(j)  (1280 + 64 * (j))
#define XB_XGEN(j)  (2304 + 64 * (j))
#define XB_TOP      3328
#define XB_TOPGEN   3392
#define XCD_BAR_WORDS 3456
#define XB_SPIN_CAP (1u << 22)
__device__ __forceinline__ unsigned xb_ld(unsigned* p)              { return __hip_atomic_load(p, __ATOMIC_RELAXED, __HIP_MEMORY_SCOPE_AGENT); }
__device__ __forceinline__ unsigned xb_add(unsigned* p, unsigned v) { return __hip_atomic_fetch_add(p, v, __ATOMIC_RELAXED, __HIP_MEMORY_SCOPE_AGENT); }
__device__ __forceinline__ unsigned xb_xcc_id() { return (unsigned)__builtin_amdgcn_s_getreg((3 << 11) | 20) & 0xFu; }
#define XB_SPIN(cond, bar) do { unsigned _sp = 0; while (cond) { __builtin_amdgcn_s_sleep(1); \
    if ((++_sp & 255u) == 0u) { if (xb_ld(&(bar)[XB_TMO])) break; if (_sp > XB_SPIN_CAP) { atomicAdd(&(bar)[XB_TMO], 1u); break; } } } } while (0)
struct XcdBarrier { unsigned* bar; unsigned x; volatile LAS unsigned* st; };
__device__ __forceinline__ XcdBarrier xcd_barrier_post(unsigned* bar, volatile LAS unsigned* st) {
    XcdBarrier b; b.bar = bar; b.x = xb_xcc_id(); b.st = st;
    if (threadIdx.x == 0) (void)xb_add(&bar[XB_XCNT(b.x)], 1u);
    return b;
}
__device__ __forceinline__ void xcd_barrier_complete(unsigned* bar, unsigned x, unsigned& nloc, unsigned& nx) {
    const unsigned G = gridDim.x * gridDim.y * gridDim.z;
    unsigned sum, cnt, mine, sp = 0u;
    for (;;) {
        sum = 0u; cnt = 0u; mine = 0u;
#pragma unroll
        for (unsigned j = 0; j < 16; ++j) { const unsigned c = xb_ld(&bar[XB_XCNT(j)]); sum += c; cnt += (c > 0u) ? 1u : 0u; mine = (j == x) ? c : mine; }
        if (sum == G) break;
        __builtin_amdgcn_s_sleep(1);
        if ((++sp & 255u) == 0u) { if (xb_ld(&bar[XB_TMO])) break; if (sp > XB_SPIN_CAP) { atomicAdd(&bar[XB_TMO], 1u); break; } }
    }
    nloc = mine > 0u ? mine : 1u; nx = cnt > 0u ? cnt : 1u;
}
__device__ __forceinline__ void xcd_barrier(const XcdBarrier& b) {
    asm volatile("s_waitcnt vmcnt(0)" ::: "memory");
    __syncthreads();
    if (threadIdx.x == 0) {
        unsigned* bar = b.bar;
        __builtin_amdgcn_s_waitcnt(0);
        unsigned nloc = b.st[0], nx = b.st[1];
        if (nloc == 0u) { xcd_barrier_complete(bar, b.x, nloc, nx); b.st[0] = nloc; b.st[1] = nx; }
        const unsigned old = xb_add(&bar[XB_XSUB(b.x)], 1u);
        const unsigned gen = old / nloc;
        if (old + 1u == (gen + 1u) * nloc) {
            __builtin_amdgcn_fence(__ATOMIC_RELEASE, "agent");
            asm volatile("s_waitcnt vmcnt(0)" ::: "memory");
            const unsigned og = xb_add(&bar[XB_TOP], 1u);
            const unsigned tg = og / nx;
            if (og + 1u == (tg + 1u) * nx) xb_add(&bar[XB_TOPGEN], 1u);
            else XB_SPIN(xb_ld(&bar[XB_TOPGEN]) == tg, bar);
            __builtin_amdgcn_fence(__ATOMIC_ACQUIRE, "agent");
            xb_add(&bar[XB_XGEN(b.x)], 1u);
            asm volatile("s_waitcnt vmcnt(0)" ::: "memory");
        } else {
            XB_SPIN(xb_ld(&bar[XB_XGEN(b.x)]) == gen, bar);
            __builtin_amdgcn_fence(__ATOMIC_ACQUIRE, "agent");
            asm volatile("s_waitcnt vmcnt(0)" ::: "memory");
        }
    }
    __syncthreads();
}

__global__ void __launch_bounds__(512, 2) fwd_megakernel(Params p0) {
    extern __shared__ __attribute__((aligned(16))) unsigned char lds_raw[];
    LAS unsigned char* lds = (LAS unsigned char*)lds_raw;
    if (threadIdx.x < 16) ((LAS unsigned*)(lds + LDS_CTL))[threadIdx.x] = 0u;
    __syncthreads();
    XcdBarrier xbar; xbar.bar = (unsigned*)(p0.ws + WS_BAR); xbar.x = 0; xbar.st = (volatile LAS unsigned*)(lds + LDS_CTL + 16);
    if (p0.ph_hi - p0.ph_lo > 1) xbar = xcd_barrier_post((unsigned*)(p0.ws + WS_BAR), (volatile LAS unsigned*)(lds + LDS_CTL + 16));
    for (int ph = p0.ph_lo; ph < p0.ph_hi; ++ph) {
#if defined(__HIP_DEVICE_COMPILE__)
        const __attribute__((address_space(4))) Params* pp = (const __attribute__((address_space(4))) Params*)__builtin_amdgcn_kernarg_segment_ptr();
        asm volatile("" : "+s"(pp));
        const Params p = *pp;
        int G = gridDim.x, bid = blockIdx.x; asm volatile("" : "+s"(G), "+s"(bid));
#else
        const Params p = p0; int G = 0, bid = 0;
#endif
        unsigned char* ws = p.ws;
        float* mod = (float*)(ws + WS_MOD);
        if (ph == 9) continue;
        for (int rep = 0; rep < (((DUPMASK >> ph) & 1) ? 2 : 1); ++rep)
        if (HAS(0) && ph == 0) {
            phase_prep(p, lds, rep == 0);
        } else if (HAS(1) && (ph == 1 || ph == 4 || ph == 9)) {
            const float* sl = ph == 1 ? p.x : p.out; const float* scx = p.ctx;
            const int nrows = ph == 9 ? NLAT : MR, midx = ph == 1 ? 0 : (ph == 4 ? 3 : 6);
            phase_rows<0>(sl, scx, nrows, p.g_norm + (ph == 1 ? 0 : (ph == 4 ? 1 : 2)) * DM, mod, midx, (bf16_t*)(ws + WS_H), nullptr, ph == 4 ? (const float*)(ws + WS_PART) : nullptr);
        } else if (HAS(2) && (ph == 2 || ph == 10)) {
            pg8::Gemm g{(const bf16_t*)(ws + WS_H), (const bf16_t*)(ws + (ph == 2 ? WS_WUP1 : WS_WUP2)), ph == 2 ? MR : NLAT, NUP, DM, DM};
            pg8::StaticOrder S; S.init(g.M, g.N, G, bid);
            EpiSwiglu E{(bf16_t*)(ws + WS_HID), ph == 10 ? (const float*)(ws + WS_RSS) : nullptr, (const bf16_t*)(ws + WS_SW3)};
            pg8::gemm_phase<EpiSwiglu>(lds, g, S, E);
            if (ph == 2) { const int busy = S.nwg % G; if (busy != 0 && bid >= busy) prep_weights(p, lds, 1, bid - busy, G - busy); else if (busy == 0) prep_weights(p, lds, 1, bid, G); }
        } else if (HAS(3) && (ph == 3 || ph == 8 || ph == 11)) {
            const bf16_t* gA = (const bf16_t*)(ws + (ph == 8 ? WS_ATT : WS_HID));
            const bf16_t* gB = (const bf16_t*)(ws + (ph == 3 ? WS_WDN1 : (ph == 8 ? WS_WOUT : WS_WDN2)));
            const int gK = ph == 8 ? DM : DFF;
            const pg8::Gemm g{gA, gB, NLAT, DM, gK, gK};
            pg8::StaticOrder S; S.init(g.M, g.N, G, bid);
            EpiResid E{p.x, p.out, ws, p.g_norm, ph};
            pg8::gemm_phase<EpiResid>(lds, g, S, E);
            if (ph == 3) {
                pg8::Gemm g2{(const bf16_t*)(ws + WS_HID), (const bf16_t*)(ws + WS_WDN1), NCTX, DM, DFF / 4, DFF};
                pg8::StaticOrder S2; S2.init(NCTX, DM, G, bid, 64, 4);
                EpiPartial E2{(float*)(ws + WS_PART)};
                pg8::gemm_phase<EpiPartial>(lds, g2, S2, E2);
            }
        } else if (HAS(5) && ph == 5) {
            pg8::Gemm g{(const bf16_t*)(ws + WS_H), (const bf16_t*)(ws + WS_WIN), MR, PWP, DM, DM};
            pg8::StaticOrder S; S.init(g.M, g.N, G, bid);
            EpiWin E{(bf16_t*)(ws + WS_Q), (bf16_t*)(ws + WS_K), (bf16_t*)(ws + WS_V), (bf16_t*)(ws + WS_MQK), (bf16_t*)(ws + WS_MV), (bf16_t*)(ws + WS_MO), (float*)(ws + WS_GT),
                     p.q_gain, p.k_gain, p.gate_b, (const float*)(ws + WS_ROPE), (LAS float*)(lds + LDS_RED)};
            pg8::gemm_phase<EpiWin>(lds, g, S, E);
            { const int busy = S.nwg % G; if (busy != 0 && bid >= busy) prep_weights(p, lds, 2, bid - busy, G - busy); else if (busy == 0) prep_weights(p, lds, 2, bid, G); }
        } else if (HAS(6) && ph == 6) {
#if !defined(NO_MLSTM)
            for (int s = bid; s < 128 && rep == 0; s += G) mlstm_stream(p, lds, s);
#endif
#if !defined(NO_ATTN)
            {
                int* ctr = (int*)(ws + WS_CTR) + rep * 8;
                for (int qi = 0; qi < 8; ++qi) {
                    const int bq = (bid + qi) & 7;
                    for (;;) {
                        __syncthreads();
                        if (otid() == 0) { int v = __hip_atomic_load(ctr + bq, __ATOMIC_RELAXED, __HIP_MEMORY_SCOPE_AGENT); if (v < 64) v = atomicAdd(ctr + bq, 1); *(LAS int*)(lds + LDS_CTL) = v; }
                        __syncthreads();
                        const int u = *(LAS int*)(lds + LDS_CTL);
                        if (u >= 64) break;
                        attn_unit(p, lds_raw, bq * 64 + u);
                    }
                }
            }
#endif
        } else if (HAS(7) && ph == 7) {
            phase_combine(p);
            phase_shiftw(mod, 6, (const bf16_t*)(ws + WS_WUP2), NUP, (bf16_t*)(ws + WS_SW3));
        } else if (HAS(12) && ph == 12) {
            phase_rows<1>(p.out, nullptr, NLAT, p.g_final, nullptr, 0, nullptr, p.out, nullptr);
        }
        if (ph + 1 < p0.ph_hi) {
            if (p0.ph_hi > 1000) cg::this_grid().sync(); else xcd_barrier(xbar);
        }
    }
}

extern "C" void kernel_launch(void* const* d_in, const int* in_sizes, int n_in, void* d_out, int out_size, void* d_ws, size_t ws_size, hipStream_t stream) {
    static int grid = 0;
    if (grid == 0) {
        if (n_in != 20 || out_size != NLAT * DM || ws_size < WS_END) { fprintf(stderr, "kernel_launch: unexpected shapes (n_in %d out %d ws %zu need %zu)\n", n_in, out_size, ws_size, (size_t)WS_END); grid = -1; return; }
        int dev = 0, cus = 0, per_cu = 0;
        hipGetDevice(&dev); hipDeviceGetAttribute(&cus, hipDeviceAttributeMultiprocessorCount, dev);
        if (hipFuncSetAttribute((const void*)fwd_megakernel, hipFuncAttributeMaxDynamicSharedMemorySize, LDS_BYTES) != hipSuccess) { fprintf(stderr, "kernel_launch: hipFuncSetAttribute failed\n"); grid = -1; return; }
        hipOccupancyMaxActiveBlocksPerMultiprocessor(&per_cu, (const void*)fwd_megakernel, 512, LDS_BYTES);
        if (per_cu < 1) { fprintf(stderr, "kernel_launch: occupancy query says %d blocks per CU\n", per_cu); per_cu = 1; }
        (void)hipGetLastError();
        grid = cus * 1;
    }
    if (grid < 0) return;
    (void)hipMemsetAsync((char*)d_ws + WS_MOD, 0, (size_t)(WS_ROPE - WS_MOD), stream);
    Params p{};
    p.x = (const float*)d_in[0]; p.c = (const float*)d_in[1]; p.ctx = (const float*)d_in[2]; p.c_ctx = (const float*)d_in[3]; p.w_mod = (const float*)d_in[4]; p.b_mod = (const float*)d_in[5];
    p.g_norm = (const float*)d_in[6]; p.w_up1 = (const float*)d_in[7]; p.w_dn1 = (const float*)d_in[8]; p.w_up2 = (const float*)d_in[9]; p.w_dn2 = (const float*)d_in[10]; p.w_in = (const float*)d_in[11];
    p.q_gain = (const float*)d_in[12]; p.k_gain = (const float*)d_in[13]; p.conv_w = (const float*)d_in[14]; p.conv_b = (const float*)d_in[15]; p.gate_b = (const float*)d_in[16]; p.m_gain = (const float*)d_in[17];
    p.w_out = (const float*)d_in[18]; p.g_final = (const float*)d_in[19]; p.out = (float*)d_out; p.ws = (unsigned char*)d_ws;
#if MK_MULTI
    for (int ph = 0; ph < NPH; ++ph) { p.ph_lo = ph; p.ph_hi = ph + 1; hipLaunchKernelGGL(fwd_megakernel, dim3(grid), dim3(512), LDS_BYTES, stream, p); }
#else
    p.ph_lo = 0; p.ph_hi = NPH;
    void* args[] = {&p};
    hipError_t e = hipLaunchCooperativeKernel((const void*)fwd_megakernel, dim3(grid), dim3(512), args, LDS_BYTES, stream);
    if (e != hipSuccess) fprintf(stderr, "cooperative launch failed: %s (grid %d)\n", hipGetErrorString(e), grid);
#endif
}
```

```cpp
#include <hip/hip_runtime.h>
#include <hip/hip_cooperative_groups.h>
#include <cstdio>
#include <cstdint>
namespace cg = cooperative_groups;

#define LAS __attribute__((address_space(3)))
typedef unsigned short bf16_t;
typedef short bf16x8 __attribute__((ext_vector_type(8)));
typedef short s16x4 __attribute__((ext_vector_type(4)));
typedef float f32x4 __attribute__((ext_vector_type(4)));
typedef float f32x16 __attribute__((ext_vector_type(16)));
typedef unsigned u32x4 __attribute__((ext_vector_type(4)));
typedef unsigned u32x2 __attribute__((ext_vector_type(2)));

#ifndef PHMASK
#define PHMASK 0x1fff
#endif
#define HAS(k) ((PHMASK >> (k)) & 1)
#ifndef DUPMASK
#define DUPMASK 0
#endif
#ifndef MK_MULTI
#define MK_MULTI 0
#endif

constexpr int DM = 2048, NB = 8, TL = 2048, TCX = 256, NLAT = NB * TL, NCTX = NB * TCX, MR = NLAT + NCTX;
constexpr int DFF = 5632, NUP = 2 * DFF, PW = 5664, PWP = 5888, NMOD = 9, MODW = NMOD * DM;
constexpr int SKV = TCX + TL;
constexpr float RMS_EPS = 1e-6f;
constexpr int NPH = 13;

constexpr size_t al256(size_t x) { return (x + 255) / 256 * 256; }
constexpr size_t WS_MOD = 0;
constexpr size_t WS_CTR = WS_MOD + (size_t)9 * MODW * 4;
constexpr size_t WS_BAR = WS_CTR + 256;
constexpr size_t WS_ROPE = al256(WS_BAR + 3456 * 4);
constexpr size_t WS_WUP1 = al256(WS_ROPE + 4096 * 4);
constexpr size_t WS_WDN1 = WS_WUP1 + (size_t)NUP * DM * 2;
constexpr size_t WS_WIN = WS_WDN1 + (size_t)DM * DFF * 2;
constexpr size_t WS_WOUT = WS_WIN + (size_t)PWP * DM * 2;
constexpr size_t WS_WUP2 = WS_WOUT + (size_t)DM * DM * 2;
constexpr size_t WS_WDN2 = WS_WUP2 + (size_t)NUP * DM * 2;
constexpr size_t WS_H = WS_WDN2 + (size_t)DM * DFF * 2;
constexpr size_t WS_HID = WS_H + (size_t)MR * DM * 2;
constexpr size_t WS_Q = WS_HID;
constexpr size_t WS_K = WS_Q + (size_t)NLAT * 1024 * 2;
constexpr size_t WS_V = WS_K + (size_t)NB * SKV * 256 * 2;
constexpr size_t WS_MQK = WS_V + (size_t)NB * SKV * 256 * 2;
constexpr size_t WS_MV = WS_MQK + (size_t)MR * 2048 * 2;
constexpr size_t WS_MO = WS_MV + (size_t)MR * 1024 * 2;
constexpr size_t WS_PROJ_END = WS_MO + (size_t)NLAT * 1024 * 2;
constexpr size_t WS_ATT = WS_HID + (size_t)MR * DFF * 2;
constexpr size_t WS_PART = WS_ATT;
constexpr size_t WS_XC = WS_ATT + (size_t)NLAT * 2048 * 2;
constexpr size_t WS_GT = WS_XC;
constexpr size_t WS_END = WS_XC + (size_t)NCTX * DM * 4;
static_assert(WS_PROJ_END <= WS_ATT, "projection outputs must fit in the hidden buffer");

constexpr int LDS_STAGE = 131072;
constexpr int LDS_RED = LDS_STAGE;
constexpr int LDS_CTL = LDS_STAGE + 8192;
constexpr int LDS_BYTES = LDS_CTL + 64;
constexpr int QS_LD = 136, JS_LD = 72;
constexpr int ML_QS = 0, ML_KS = ML_QS + 64 * QS_LD * 2, ML_KT = ML_KS + 64 * QS_LD * 2, ML_VT = ML_KT + 128 * 64 * 2, ML_PS = ML_VT + 144 * 64 * 2,
              ML_C0 = ML_PS + 64 * JS_LD * 2, ML_SC = ML_C0 + 144 * QS_LD * 2, ML_CW = ML_SC + 5 * 64 * 4, ML_CB = ML_CW + 5 * 256 * 4, ML_END = ML_CB + 256 * 4;
static_assert(ML_END <= LDS_BYTES, "mLSTM LDS");

struct Params {
    const float *x, *c, *ctx, *c_ctx, *w_mod, *b_mod, *g_norm, *w_up1, *w_dn1, *w_up2, *w_dn2, *w_in, *q_gain, *k_gain, *conv_w, *conv_b, *gate_b, *m_gain, *w_out, *g_final;
    float* out; unsigned char* ws; int ph_lo, ph_hi;
};

__device__ __forceinline__ int otid() { int t = threadIdx.x; asm volatile("" : "+v"(t)); return t; }
__device__ __forceinline__ unsigned cvt_pk_bf16(float lo, float hi) { unsigned r; asm volatile("v_cvt_pk_bf16_f32 %0, %1, %2" : "=v"(r) : "v"(lo), "v"(hi)); return r; }
__device__ __forceinline__ float bf2f(unsigned short v) { return __uint_as_float(((unsigned)v) << 16); }
__device__ __forceinline__ float silu_f(float x) { return x * __builtin_amdgcn_rcpf(1.0f + __expf(-x)); }
__device__ __forceinline__ float sigmoid_f(float x) { return __builtin_amdgcn_rcpf(1.0f + __expf(-x)); }
__device__ __forceinline__ float logsigmoid_f(float x) { return fminf(x, 0.f) - __logf(1.0f + __expf(-fabsf(x))); }

namespace pg8 {
constexpr int BM = 256, BK = 64, HALF = 128, HTB = HALF * BK * 2, NXCD = 8, WGM = 8;
__device__ __forceinline__ int lds_byte(int r, int c) { const int st = (r >> 4) * 2 + (c >> 5), rr = r & 15, cc = c & 31, ob = rr * 64 + cc * 2; return st * 1024 + (ob ^ (((ob >> 9) & 1) << 5)); }
__device__ __forceinline__ void stage_rc(int b, int& R, int& C) { const int st = b / 1024, sb = b % 1024, swz = sb ^ (((sb >> 9) & 1) << 5); R = (st >> 1) * 16 + swz / 64; C = (st & 1) * 32 + (swz % 64) / 2; }
__device__ __forceinline__ int perm32(int rho) { const int n = rho >> 4, i = rho & 15; return 8 * (i >> 2) + 4 * n + (i & 3); }
struct Unit { int pm, pn, ks; };
struct Gemm { const bf16_t* A; const bf16_t* Bt; int M, N, K, ld; };
struct StaticOrder {
    int nM, nN, nwg, G, c, pm0, nNr;
    int n1, x_pm0, x_nm, x_pn0;
    __device__ void init(int M, int N, int G_, int c_, int pm0_ = 0, int ksplit = 1) { nM = M / BM; nNr = N / BM; nN = nNr * ksplit; nwg = nM * nN; G = G_; c = c_; pm0 = pm0_; n1 = nwg; x_pm0 = 0; x_nm = 1; x_pn0 = 0; }
    __device__ void extra(int pm0_, int nm, int pn0, int npn) { x_pm0 = pm0_; x_nm = nm; x_pn0 = pn0; nwg = n1 + nm * npn; }
    __device__ bool next(int i, Unit& u) const {
        const long L = (long)i * G + c; if (L >= nwg) return false;
        int wgid = (int)L; { const int q = nwg / NXCD, r = nwg % NXCD, xcd = wgid % NXCD, off = wgid / NXCD; wgid = (xcd < r ? xcd * (q + 1) : r * (q + 1) + (xcd - r) * q) + off; }
        if (wgid >= n1) { const int e = wgid - n1; u.pm = x_pm0 + e % x_nm; u.pn = x_pn0 + e / x_nm; u.ks = 0; return true; }
        const int nig = WGM * nN, gid = wgid / nig, fm = gid * WGM, gsz = (nM - fm) < WGM ? (nM - fm) : WGM;
        u.pm = pm0 + fm + ((wgid % nig) % gsz); const int pe = (wgid % nig) / gsz; u.pn = pe % nNr; u.ks = pe / nNr; return true;
    }
};

template <class Epi>
__device__ __forceinline__ void gemm_phase(LAS unsigned char* lds, const Gemm g, const StaticOrder& S, const Epi& E) {
    const int tid = otid(), wid = __builtin_amdgcn_readfirstlane(tid >> 6), lane = tid & 63, wr = wid >> 2, wc = wid & 3, fr = lane & 15, fq = lane >> 4;
    const int K = g.K, nt = K / BK;
    unsigned voffA[2], voffB[2];
#pragma unroll
    for (int i = 0; i < 2; ++i) { int R, C; stage_rc(tid * 16 + i * 8192, R, C); const int Rb = Epi::PERM ? ((R & ~31) + perm32(R & 31)) : R;
        voffA[i] = (unsigned)(R * g.ld + C) * 2u; voffB[i] = (unsigned)(Rb * g.ld + C) * 2u; }
    const size_t kstep = (size_t)(BK * 2);
    const size_t hstep = (size_t)HALF * g.ld * 2;
    const size_t ksB = (size_t)K * 2;
    const size_t tstep = 2 * hstep;
    const unsigned ldsw = (unsigned)wid * 1024u;
    const int aoff = lds_byte(wr * 64 + fr, fq * 8), boff = lds_byte(wc * 32 + fr, fq * 8);
#define PG8_SA(b, h) (((b) * 2 + (h)) * HTB)
#define PG8_SB(b, h) ((4 + (b) * 2 + (h)) * HTB)
#define PG8_STAGE(bufoff, gbase, voff) do { _Pragma("unroll") for (int _i = 0; _i < 2; ++_i) \
        __builtin_amdgcn_global_load_lds((const unsigned*)((const char*)(gbase) + (voff)[_i]), (LAS unsigned*)(lds + (bufoff) + ldsw + _i * 8192), 16, 0, 0); } while (0)
#define PG8_LDA(dst, b, h) do { _Pragma("unroll") for (int m = 0; m < 4; ++m) _Pragma("unroll") for (int k = 0; k < 2; ++k) dst[m][k] = *(const LAS bf16x8*)(lds + PG8_SA(b, h) + aoff + m * 2048 + k * 1024); } while (0)
#define PG8_LDB(dst, b, h) do { _Pragma("unroll") for (int n = 0; n < 2; ++n) _Pragma("unroll") for (int k = 0; k < 2; ++k) dst[n][k] = *(const LAS bf16x8*)(lds + PG8_SB(b, h) + boff + n * 2048 + k * 1024); } while (0)
#define PG8_MMA(ai, bj, At, Bt) do { __builtin_amdgcn_s_setprio(1); _Pragma("unroll") for (int m = 0; m < 4; ++m) _Pragma("unroll") for (int n = 0; n < 2; ++n) _Pragma("unroll") for (int k = 0; k < 2; ++k) \
        acc[ai][bj][m][n] = __builtin_amdgcn_mfma_f32_16x16x32_bf16(Bt[n][k], At[m][k], acc[ai][bj][m][n], 0, 0, 0); __builtin_amdgcn_s_setprio(0); } while (0)
#define PG8_WAIT_V(n) asm volatile("s_waitcnt vmcnt(" #n ")" ::: "memory")
#define PG8_WAIT_L(n) asm volatile("s_waitcnt lgkmcnt(" #n ")" ::: "memory")
#define PG8_BAR __builtin_amdgcn_s_barrier()
#define PG8_SCHED __builtin_amdgcn_sched_barrier(0)
    Unit cur, nxt; int ui = 0;
    if (!S.next(0, cur)) return;
    f32x4 acc[2][2][4][2];
#pragma unroll
    for (int a = 0; a < 2; ++a)
#pragma unroll
        for (int b = 0; b < 2; ++b)
#pragma unroll
            for (int m = 0; m < 4; ++m)
#pragma unroll
                for (int n = 0; n < 2; ++n) acc[a][b][m][n] = (f32x4){0.f, 0.f, 0.f, 0.f};
    bf16x8 At[4][2], B0[2][2], B1[2][2];
    const char* cA = (const char*)g.A + (size_t)cur.pm * tstep + cur.ks * ksB; const char* cB = (const char*)g.Bt + (size_t)cur.pn * tstep + cur.ks * ksB;
    PG8_STAGE(PG8_SB(0, 0), cB, voffB); PG8_STAGE(PG8_SA(0, 0), cA, voffA); PG8_STAGE(PG8_SB(0, 1), cB + hstep, voffB); PG8_STAGE(PG8_SA(0, 1), cA + hstep, voffA);
    if (wr == 1) PG8_BAR;
    PG8_WAIT_V(4); PG8_BAR;
    PG8_STAGE(PG8_SB(1, 0), cB + kstep, voffB); PG8_STAGE(PG8_SA(1, 0), cA + kstep, voffA); PG8_STAGE(PG8_SB(1, 1), cB + hstep + kstep, voffB);
    PG8_WAIT_V(6); PG8_BAR;
    for (;;) {
        const bool has_next = S.next(ui + 1, nxt);
        const char* nA = has_next ? (const char*)g.A + (size_t)nxt.pm * tstep + nxt.ks * ksB : cA; const char* nB = has_next ? (const char*)g.Bt + (size_t)nxt.pn * tstep + nxt.ks * ksB : cB;
        for (int t = 0; t < nt; t += 2) {
            const bool last = (t == nt - 2);
            const char* a1 = cA + (size_t)(t + 1) * kstep;
            const char* a2 = last ? nA : cA + (size_t)(t + 2) * kstep; const char* b2 = last ? nB : cB + (size_t)(t + 2) * kstep;
            const char* a3 = a2 + kstep; const char* b3 = b2 + kstep;
            PG8_LDB(B0, 0, 0); PG8_SCHED; PG8_LDA(At, 0, 0); PG8_STAGE(PG8_SA(1, 1), a1 + hstep, voffA);
            PG8_WAIT_L(8); PG8_BAR; PG8_WAIT_L(0); PG8_MMA(0, 0, At, B0); PG8_BAR; PG8_SCHED;
            PG8_LDB(B1, 0, 1); PG8_STAGE(PG8_SB(0, 0), b2, voffB);
            PG8_BAR; PG8_WAIT_L(0); PG8_MMA(0, 1, At, B1); PG8_BAR;
            PG8_LDA(At, 0, 1); PG8_STAGE(PG8_SA(0, 0), a2, voffA);
            PG8_BAR; PG8_WAIT_L(0); PG8_MMA(1, 0, At, B0); PG8_BAR; PG8_SCHED;
            PG8_STAGE(PG8_SB(0, 1), b2 + hstep, voffB);
            PG8_WAIT_V(6); PG8_BAR; PG8_MMA(1, 1, At, B1); PG8_BAR;
            PG8_LDB(B0, 1, 0); PG8_SCHED; PG8_LDA(At, 1, 0); PG8_STAGE(PG8_SA(0, 1), a2 + hstep, voffA);
            PG8_WAIT_L(8); PG8_BAR; PG8_WAIT_L(0); PG8_MMA(0, 0, At, B0); PG8_BAR; PG8_SCHED;
            PG8_LDB(B1, 1, 1); PG8_STAGE(PG8_SB(1, 0), b3, voffB);
            PG8_BAR; PG8_WAIT_L(0); PG8_MMA(0, 1, At, B1); PG8_BAR;
            PG8_LDA(At, 1, 1); PG8_STAGE(PG8_SA(1, 0), a3, voffA);
            PG8_BAR; PG8_WAIT_L(0); PG8_MMA(1, 0, At, B0); PG8_BAR; PG8_SCHED;
            PG8_STAGE(PG8_SB(1, 1), b3 + hstep, voffB);
            PG8_WAIT_V(6); PG8_BAR; PG8_MMA(1, 1, At, B1); PG8_BAR;
        }
        E(acc, cur, wr, wc, fr, fq);
        if (!has_next) break;
#pragma unroll
        for (int a = 0; a < 2; ++a)
#pragma unroll
            for (int b = 0; b < 2; ++b)
#pragma unroll
                for (int m = 0; m < 4; ++m)
#pragma unroll
                    for (int n = 0; n < 2; ++n) acc[a][b][m][n] = (f32x4){0.f, 0.f, 0.f, 0.f};
        cur = nxt; cA = nA; cB = nB; ++ui;
    }
    PG8_WAIT_V(0);
    if (wr == 0) PG8_BAR;
    PG8_BAR;
#undef PG8_SA
#undef PG8_SB
#undef PG8_STAGE
#undef PG8_LDA
#undef PG8_LDB
#undef PG8_MMA
#undef PG8_WAIT_V
#undef PG8_WAIT_L
#undef PG8_BAR
#undef PG8_SCHED
}
}

struct EpiSwiglu {
    static constexpr bool PERM = true;
    bf16_t* H;
    __device__ __forceinline__ void operator()(const f32x4 (&acc)[2][2][4][2], const pg8::Unit& u, int wr, int wc, int fr, int fq) const {
        const int row0 = u.pm * 256 + wr * 64 + fr, col0 = u.pn * 128 + wc * 32 + 8 * fq;
#pragma unroll
        for (int ai = 0; ai < 2; ++ai)
#pragma unroll
            for (int m = 0; m < 4; ++m) {
                bf16_t* rowp = H + (size_t)(row0 + ai * 128 + m * 16) * DFF + col0;
                const f32x4 a0 = acc[ai][0][m][0], a1 = acc[ai][0][m][1], b0 = acc[ai][1][m][0], b1 = acc[ai][1][m][1];
                float v[8];
#pragma unroll
                for (int j = 0; j < 4; ++j) { v[j] = silu_f(a0[j]) * b0[j]; v[4 + j] = silu_f(a1[j]) * b1[j]; }
                u32x4 w; w.x = cvt_pk_bf16(v[0], v[1]); w.y = cvt_pk_bf16(v[2], v[3]); w.z = cvt_pk_bf16(v[4], v[5]); w.w = cvt_pk_bf16(v[6], v[7]);
                *(u32x4*)rowp = w;
            }
    }
};
struct EpiResid {
    static constexpr bool PERM = false;
    const float* resid_l; const float* resid_c; float* out_l; float* out_c; const float* mod; int gidx; float coef;
    __device__ __forceinline__ void operator()(const f32x4 (&acc)[2][2][4][2], const pg8::Unit& u, int wr, int wc, int fr, int fq) const {
        const bool isctx = u.pm >= 64; const int b = isctx ? 8 : (u.pm >> 3);
        const int row0 = (isctx ? (u.pm - 64) : u.pm) * 256 + wr * 64 + fr, col0 = u.pn * 256 + wc * 32 + 4 * fq;
        const float* gp = mod + (size_t)(b * NMOD + gidx) * DM + col0;
        const float* rb = isctx ? resid_c : resid_l; float* ob = isctx ? out_c : out_l;
        f32x4 gv[2][2];
#pragma unroll
        for (int bj = 0; bj < 2; ++bj)
#pragma unroll
            for (int n = 0; n < 2; ++n) gv[bj][n] = *(const f32x4*)(gp + bj * 128 + n * 16) * coef;
#pragma unroll
        for (int ai = 0; ai < 2; ++ai)
#pragma unroll
            for (int m = 0; m < 4; ++m) {
                const size_t o = (size_t)(row0 + ai * 128 + m * 16) * DM + col0;
#pragma unroll
                for (int bj = 0; bj < 2; ++bj)
#pragma unroll
                    for (int n = 0; n < 2; ++n) { const f32x4 r = *(const f32x4*)(rb + o + bj * 128 + n * 16); *(f32x4*)(ob + o + bj * 128 + n * 16) = r + gv[bj][n] * acc[ai][bj][m][n]; }
            }
    }
};
struct EpiPartial {
    static constexpr bool PERM = false;
    float* P;
    __device__ __forceinline__ void operator()(const f32x4 (&acc)[2][2][4][2], const pg8::Unit& u, int wr, int wc, int fr, int fq) const {
        const int row0 = (u.pm - 64) * 256 + wr * 64 + fr, col0 = u.pn * 256 + wc * 32 + 4 * fq;
        float* ob = P + (size_t)u.ks * NCTX * DM;
#pragma unroll
        for (int ai = 0; ai < 2; ++ai)
#pragma unroll
            for (int m = 0; m < 4; ++m) {
                const size_t o = (size_t)(row0 + ai * 128 + m * 16) * DM + col0;
#pragma unroll
                for (int bj = 0; bj < 2; ++bj)
#pragma unroll
                    for (int n = 0; n < 2; ++n) *(f32x4*)(ob + o + bj * 128 + n * 16) = acc[ai][bj][m][n];
            }
    }
};
__device__ __forceinline__ int win_src(int slot) {
    if (slot >= PW) return -1;
    if (slot >= 1280) return slot;
    const int head = slot >> 7, s = slot & 127, wc = s >> 5, n = (s >> 4) & 1, fq = (s >> 2) & 3, j = s & 3;
    return head * 128 + (wc >> 1) * 64 + n * 32 + (wc & 1) * 16 + fq * 4 + j;
}
struct EpiWin {
    static constexpr bool PERM = false;
    bf16_t *Q, *K, *V, *MQK, *MV, *MO; float* GT; const float *qg, *kg, *gb, *rope; LAS float* red;
    __device__ __forceinline__ void st4(bf16_t* p, f32x4 v) const { u32x2 w; w.x = cvt_pk_bf16(v[0], v[1]); w.y = cvt_pk_bf16(v[2], v[3]); *(u32x2*)p = w; }
    __device__ __forceinline__ void operator()(const f32x4 (&acc)[2][2][4][2], const pg8::Unit& u, int wr, int wc, int fr, int fq) const {
        asm volatile("" : "+v"(fr), "+v"(fq));
        const int pn = u.pn; const bool isctx = u.pm >= 64;
        const int rt0 = wr * 64 + fr;
        const int grow0 = u.pm * 256 + rt0;
        if (pn <= 4) {
            const float* gain = pn < 4 ? qg : kg;
            const int d1 = (wc >> 1) * 64 + (wc & 1) * 16 + 4 * fq;
            const f32x4 g1 = *(const f32x4*)(gain + d1), g2 = *(const f32x4*)(gain + d1 + 32);
#pragma unroll
            for (int ai = 0; ai < 2; ++ai)
#pragma unroll
                for (int m = 0; m < 4; ++m)
#pragma unroll
                    for (int bj = 0; bj < 2; ++bj) {
                        const f32x4 a = acc[ai][bj][m][0], c = acc[ai][bj][m][1];
                        float ss = a[0] * a[0] + a[1] * a[1] + a[2] * a[2] + a[3] * a[3] + c[0] * c[0] + c[1] * c[1] + c[2] * c[2] + c[3] * c[3];
                        ss += __shfl_xor(ss, 16); ss += __shfl_xor(ss, 32);
                        if (fq == 0) red[((rt0 + ai * 128 + m * 16) * 2 + bj) * 4 + wc] = ss;
                    }
            asm volatile("s_waitcnt lgkmcnt(0)" ::: "memory"); __builtin_amdgcn_s_barrier(); asm volatile("" ::: "memory");
#pragma unroll
            for (int ai = 0; ai < 2; ++ai)
#pragma unroll
                for (int m = 0; m < 4; ++m) {
                    const int rl = rt0 + ai * 128 + m * 16, gr = grow0 + ai * 128 + m * 16;
                    int bidx, tok; if (isctx) { bidx = (gr - NLAT) >> 8; tok = (gr - NLAT) & 255; } else { bidx = gr >> 11; tok = gr & 2047; }
                    f32x4 cs = (f32x4){1.f, 1.f, 1.f, 1.f}, sn = (f32x4){0.f, 0.f, 0.f, 0.f};
                    if (!isctx) { const int pos = (wc >> 1) ? (tok & 63) : (tok >> 6); const int ro = pos * 32 + (wc & 1) * 16 + 4 * fq; cs = *(const f32x4*)(rope + ro); sn = *(const f32x4*)(rope + 2048 + ro); }
#pragma unroll
                    for (int bj = 0; bj < 2; ++bj) {
                        const f32x4 pr = *(const LAS f32x4*)(red + (rl * 2 + bj) * 4);
                        const float rs = __builtin_amdgcn_rsqf((pr[0] + pr[1] + pr[2] + pr[3]) * (1.0f / 128.0f) + RMS_EPS);
                        const f32x4 x1 = acc[ai][bj][m][0] * rs * g1, x2 = acc[ai][bj][m][1] * rs * g2;
                        const f32x4 y1 = x1 * cs - x2 * sn, y2 = x2 * cs + x1 * sn;
                        if (pn < 4) { if (!isctx) { bf16_t* qp = Q + (size_t)gr * 1024 + (pn * 2 + bj) * 128 + d1; st4(qp, y1); st4(qp + 32, y2); } }
                        else { bf16_t* kp = K + ((size_t)bidx * SKV + (isctx ? tok : TCX + tok)) * 256 + bj * 128 + d1; st4(kp, y1); st4(kp + 32, y2); }
                    }
                    __builtin_amdgcn_sched_barrier(0);
                }
        } else {
            const int cc0 = wc * 32 + 4 * fq;
#pragma unroll
            for (int ai = 0; ai < 2; ++ai)
#pragma unroll
                for (int m = 0; m < 4; ++m) {
                    const int gr = grow0 + ai * 128 + m * 16;
                    int bidx, tok; if (isctx) { bidx = (gr - NLAT) >> 8; tok = (gr - NLAT) & 255; } else { bidx = gr >> 11; tok = gr & 2047; }
#pragma unroll
                    for (int bj = 0; bj < 2; ++bj)
#pragma unroll
                        for (int n = 0; n < 2; ++n) {
                            const int cc = cc0 + bj * 128 + n * 16; const f32x4 v = acc[ai][bj][m][n];
                            if (pn == 5) st4(V + ((size_t)bidx * SKV + (isctx ? tok : TCX + tok)) * 256 + cc, v);
                            else if (pn < 14) st4(MQK + (size_t)gr * 2048 + (pn - 6) * 256 + cc, v);
                            else if (pn < 18) st4(MV + (size_t)gr * 1024 + (pn - 14) * 256 + cc, v);
                            else if (pn < 22) { if (!isctx) { f32x4 s; s[0] = sigmoid_f(v[0]); s[1] = sigmoid_f(v[1]); s[2] = sigmoid_f(v[2]); s[3] = sigmoid_f(v[3]); st4(MO + (size_t)gr * 1024 + (pn - 18) * 256 + cc, s); } }
                            else if (cc < 32) {
                                f32x4 t = v + *(const f32x4*)(gb + cc);
                                if (fq >= 2) { t[0] = logsigmoid_f(t[0]); t[1] = logsigmoid_f(t[1]); t[2] = logsigmoid_f(t[2]); t[3] = logsigmoid_f(t[3]); }
                                *(f32x4*)(GT + (size_t)MR * 32 + (size_t)gr * 32 + cc) = t;
                            }
                        }
                    __builtin_amdgcn_sched_barrier(0);
                }
        }
    }
};

__device__ __forceinline__ int up_src(int slot) { const int pn = slot >> 8, r = slot & 255; return (r >> 7) * DFF + pn * 128 + (r & 127); }
template <int MAP  >
__device__ __forceinline__ void prep_tile(const float* __restrict__ W, int Nsrc, bf16_t* __restrict__ Bt, int Kdim, int nt, int kt, LAS float* tl) {
    const int tid = otid();
    { const int n4 = tid & 63, kk = tid >> 6; const int slot = nt * 256 + 4 * n4;
      const int src = MAP == 0 ? slot : (MAP == 1 ? up_src(slot) : win_src(slot));
      f32x4 v[8];
#pragma unroll
      for (int pss = 0; pss < 8; ++pss) { v[pss] = (f32x4){0.f, 0.f, 0.f, 0.f}; if (src >= 0) v[pss] = *(const f32x4*)(W + (size_t)(kt * 64 + kk + pss * 8) * Nsrc + src); }
#pragma unroll
      for (int pss = 0; pss < 8; ++pss) *(LAS f32x4*)(tl + (kk + pss * 8) * 260 + 4 * n4) = v[pss]; }
    __syncthreads();
    { const int n = tid >> 1, kh = (tid & 1) * 32;
#pragma unroll
      for (int q = 0; q < 4; ++q) { float v[8];
#pragma unroll
          for (int e = 0; e < 8; ++e) v[e] = tl[(kh + q * 8 + e) * 260 + n];
          u32x4 w; w.x = cvt_pk_bf16(v[0], v[1]); w.y = cvt_pk_bf16(v[2], v[3]); w.z = cvt_pk_bf16(v[4], v[5]); w.w = cvt_pk_bf16(v[6], v[7]);
          *(u32x4*)(Bt + (size_t)(nt * 256 + n) * Kdim + kt * 64 + kh + q * 8) = w; } }
    __syncthreads();
}
__device__ __forceinline__ void prep_weights(const Params& p, LAS unsigned char* lds, int grp, int idx, int n) {
    LAS float* tl = (LAS float*)lds;
    constexpr int T_UP = (NUP / 256) * (DM / 64), T_DN = (DM / 256) * (DFF / 64), T_IN = (PWP / 256) * (DM / 64), T_OUT = (DM / 256) * (DM / 64);
    const int tot = grp == 1 ? T_IN + T_OUT : T_UP + T_DN;
    for (int t = idx; t < tot; t += n) {
        int q = t;
        if (grp == 1) {
            if (q < T_IN) { prep_tile<2>(p.w_in, PW, (bf16_t*)(p.ws + WS_WIN), DM, q % (PWP / 256), q / (PWP / 256), tl); continue; } q -= T_IN;
            prep_tile<0>(p.w_out, DM, (bf16_t*)(p.ws + WS_WOUT), DM, q % (DM / 256), q / (DM / 256), tl);
        } else {
            const float* wu = grp == 0 ? p.w_up1 : p.w_up2; const float* wd = grp == 0 ? p.w_dn1 : p.w_dn2;
            if (q < T_UP) { prep_tile<1>(wu, NUP, (bf16_t*)(p.ws + (grp == 0 ? WS_WUP1 : WS_WUP2)), DM, q % (NUP / 256), q / (NUP / 256), tl); continue; } q -= T_UP;
            prep_tile<0>(wd, DM, (bf16_t*)(p.ws + (grp == 0 ? WS_WDN1 : WS_WDN2)), DFF, q % (DM / 256), q / (DM / 256), tl);
        }
    }
}
__device__ __forceinline__ void phase_prep(const Params& p, LAS unsigned char* lds, bool do_mod) {
    const int tid = otid(), G = gridDim.x, bid = blockIdx.x;
    float* mod = (float*)(p.ws + WS_MOD);
    LAS float* sv = (LAS float*)lds;
    LAS float* red = (LAS float*)(lds + 9 * 512 * 4);
    for (int item = bid; do_mod && item < 576; item += G) {
        const int cb = item >> 2, ks = item & 3;
        for (int i = tid; i < 9 * 512; i += 512) { const int b = i >> 9, k = i & 511; const float cv = b < 8 ? p.c[b * DM + ks * 512 + k] : p.c_ctx[ks * 512 + k]; sv[i] = silu_f(cv); }
        __syncthreads();
        const int c4 = tid & 31, kr = tid >> 5;
        f32x4 a[9];
#pragma unroll
        for (int b = 0; b < 9; ++b) a[b] = (f32x4){0.f, 0.f, 0.f, 0.f};
        for (int kk = kr; kk < 512; kk += 16) {
            const f32x4 w = *(const f32x4*)(p.w_mod + (size_t)(ks * 512 + kk) * MODW + cb * 128 + c4 * 4);
#pragma unroll
            for (int b = 0; b < 9; ++b) a[b] += w * sv[b * 512 + kk];
        }
#pragma unroll
        for (int b = 0; b < 9; ++b) *(LAS f32x4*)(red + (kr * 9 + b) * 128 + c4 * 4) = a[b];
        __syncthreads();
        for (int o = tid; o < 9 * 128; o += 512) { const int b = o >> 7, cidx = o & 127; float s = 0.f;
#pragma unroll
            for (int r = 0; r < 16; ++r) s += red[(r * 9 + b) * 128 + cidx];
            const int col = cb * 128 + cidx; if (ks == 0) s += p.b_mod[col];
            atomicAdd(mod + (size_t)b * MODW + col, s); }
        __syncthreads();
    }
    if (bid == G - 1) { float* rope = (float*)(p.ws + WS_ROPE);
        for (int i = tid; i < 2048; i += 512) { const int pos = i >> 5, idx = i & 31; const float inv = exp2f(-(float)idx * (13.287712379549449f / 32.0f)); const float ang = (float)pos * inv;
            rope[i] = cosf(ang); rope[2048 + i] = sinf(ang); } }
    prep_weights(p, lds, 0, bid, G);
}

template <int MODE>
__device__ __forceinline__ void phase_rows(const float* src_l, const float* src_c, int nrows, const float* g, const float* mod, int midx, bf16_t* outb, float* outf, const float* part) {
    const int wave = otid() >> 6, lane = otid() & 63;
    const int stride = gridDim.x * 8;
    for (int r0 = blockIdx.x * 8 + wave; r0 < nrows; r0 += 2 * stride) {
        f32x4 v[2][8]; float ss[2] = {0.f, 0.f};
#pragma unroll
        for (int q = 0; q < 2; ++q) {
            const int r = r0 + q * stride;
            if (r < nrows) {
                const bool isctx = r >= NLAT; const float* xp = isctx ? src_c + (size_t)(r - NLAT) * DM : src_l + (size_t)r * DM;
#pragma unroll
                for (int k = 0; k < 8; ++k) v[q][k] = *(const f32x4*)(xp + (k * 64 + lane) * 4);
                if (isctx && part) {
                    const float* gt = mod + (size_t)(8 * NMOD + 2) * DM; const float* pp = part + (size_t)(r - NLAT) * DM;
#pragma unroll
                    for (int k = 0; k < 8; ++k) { const int c = (k * 64 + lane) * 4;
                        const f32x4 sum = (*(const f32x4*)(pp + c) + *(const f32x4*)(pp + (size_t)NCTX * DM + c)) + (*(const f32x4*)(pp + (size_t)2 * NCTX * DM + c) + *(const f32x4*)(pp + (size_t)3 * NCTX * DM + c));
                        v[q][k] += *(const f32x4*)(gt + c) * 0.5f * sum; }
                }
#pragma unroll
                for (int k = 0; k < 8; ++k) ss[q] += v[q][k][0] * v[q][k][0] + v[q][k][1] * v[q][k][1] + v[q][k][2] * v[q][k][2] + v[q][k][3] * v[q][k][3];
            }
        }
#pragma unroll
        for (int o = 32; o >= 1; o >>= 1) { ss[0] += __shfl_xor(ss[0], o); ss[1] += __shfl_xor(ss[1], o); }
#pragma unroll
        for (int q = 0; q < 2; ++q) {
            const int r = r0 + q * stride;
            if (r < nrows) {
                const float rs = rsqrtf(ss[q] * (1.0f / DM) + RMS_EPS);
                if (MODE == 0) {
                    const int b = r >= NLAT ? 8 : (r >> 11);
                    const float* sh = mod + (size_t)(b * NMOD + midx) * DM; const float* sc = sh + DM;
#pragma unroll
                    for (int k = 0; k < 8; ++k) { const int c = (k * 64 + lane) * 4; const f32x4 gg = *(const f32x4*)(g + c), s1 = *(const f32x4*)(sc + c), s0 = *(const f32x4*)(sh + c);
                        const f32x4 y = v[q][k] * rs * gg * (s1 + 1.0f) + s0; u32x2 w; w.x = cvt_pk_bf16(y[0], y[1]); w.y = cvt_pk_bf16(y[2], y[3]); *(u32x2*)(outb + (size_t)r * DM + c) = w; }
                } else {
#pragma unroll
                    for (int k = 0; k < 8; ++k) { const int c = (k * 64 + lane) * 4; const f32x4 gg = *(const f32x4*)(g + c); *(f32x4*)(outf + (size_t)r * DM + c) = v[q][k] * rs * gg; }
                }
            }
        }
    }
}

__device__ __forceinline__ f32x4 mfma16g(bf16x8 a, bf16x8 b, f32x4 c) { return __builtin_amdgcn_mfma_f32_16x16x32_bf16(a, b, c, 0, 0, 0); }
__device__ __forceinline__ void phase_gates(const Params& p, unsigned char* ws, LAS unsigned char* lds) {
    const int tid = otid(), wave = tid >> 6, lane = tid & 63, fr = lane & 15, fq = lane >> 4;
    const bf16_t* H = (const bf16_t*)(ws + WS_H); const bf16_t* Wg = (const bf16_t*)(ws + WS_WIN) + (size_t)5632 * DM; float* GT = (float*)(ws + WS_GT);
    asm volatile("s_waitcnt vmcnt(0)" ::: "memory"); __syncthreads();
    const int stride = gridDim.x * 8, nit = (MR + stride - 1) / stride, nloc = nit * 8;
    f32x4 acc[5][2];
#pragma unroll
    for (int mt = 0; mt < 5; ++mt) { acc[mt][0] = (f32x4){0.f, 0.f, 0.f, 0.f}; acc[mt][1] = acc[mt][0]; }
    size_t aoffs[5]; bool ok[5];
#pragma unroll
    for (int mt = 0; mt < 5; ++mt) { const int lid = mt * 16 + fr; const int row = blockIdx.x * 8 + (lid & 7) + (lid >> 3) * stride; ok[mt] = lid < nloc && row < MR; aoffs[mt] = (size_t)(ok[mt] ? row : 0) * DM; }
    if (nloc <= 80) {
#pragma unroll 2
        for (int ks = 0; ks < 8; ++ks) {
            const int k = wave * 256 + ks * 32 + fq * 8;
            const bf16x8 b0 = *(const bf16x8*)(Wg + (size_t)fr * DM + k), b1 = *(const bf16x8*)(Wg + (size_t)(16 + fr) * DM + k);
#pragma unroll
            for (int mt = 0; mt < 5; ++mt) { bf16x8 a = *(const bf16x8*)(H + aoffs[mt] + k); if (!ok[mt]) a = (bf16x8){0, 0, 0, 0, 0, 0, 0, 0};
                acc[mt][0] = mfma16g(a, b0, acc[mt][0]); acc[mt][1] = mfma16g(a, b1, acc[mt][1]); }
        }
        LAS f32x4* part = (LAS f32x4*)lds;
#pragma unroll
        for (int mt = 0; mt < 5; ++mt) { part[((wave * 5 + mt) * 2 + 0) * 64 + lane] = acc[mt][0]; part[((wave * 5 + mt) * 2 + 1) * 64 + lane] = acc[mt][1]; }
        __syncthreads();
        LAS float* pf = (LAS float*)lds;
        for (int o = tid; o < 80 * 32; o += 512) {
            const int rl = o >> 5, col = o & 31, mt = rl >> 4, rr = rl & 15, ln = (rr >> 2) * 16 + (col & 15), j = rr & 3, nt = col >> 4;
            float sum = 0.f;
#pragma unroll
            for (int w = 0; w < 8; ++w) sum += pf[((((w * 5 + mt) * 2 + nt) * 64 + ln) << 2) + j];
            const int row = blockIdx.x * 8 + (rl & 7) + (rl >> 3) * stride;
            if (rl < nloc && row < MR) { float v = sum + p.gate_b[col]; if ((col >> 3) & 1) v = logsigmoid_f(v); GT[(size_t)row * 32 + col] = v; }
        }
        __syncthreads();
    }
}

namespace att {
constexpr int D = 128, NW = 8, QBLK = 32, KVBLK = 64;
constexpr float SCALE = 0.088388347648318440f, THR = 8.f;
constexpr int LDQ = 1024, LDK = 256, LDO = 2048;
constexpr size_t SHM_V = KVBLK * D * 2, SHM_K = KVBLK * D * 2, SHM_ATTN = 2 * SHM_V + 2 * SHM_K + NW * 64 * 4;
#define KSWZ(row, colB) ((row) * 256 + ((colB) ^ (((row) & 7) << 4)))
#define SBAR() __builtin_amdgcn_sched_barrier(0)
__device__ __forceinline__ int crow(int r, int hi) { return (r & 3) + 8 * (r >> 2) + 4 * hi; }
__device__ __forceinline__ void partialSM(f32x16& p0, f32x16& p1, float& m_reg, float& mn, float& alpha) {
  constexpr float C = SCALE * 1.4426950408889634f;
  float pmax = p0[0]; for (int r = 1; r < 16; ++r) pmax = fmaxf(pmax, p0[r]); for (int r = 0; r < 16; ++r) pmax = fmaxf(pmax, p1[r]);
  { auto rr = __builtin_amdgcn_permlane32_swap(__float_as_uint(pmax), __float_as_uint(pmax), false, false);
    pmax = fmaxf(__uint_as_float(rr[0]), __uint_as_float(rr[1])); }
  if (__builtin_expect(__all(pmax - m_reg <= THR / SCALE), 1)) { mn = m_reg; alpha = 1.f; }
  else { mn = fmaxf(m_reg, pmax); alpha = __builtin_amdgcn_exp2f((m_reg - mn) * C); m_reg = mn; }
  float mnC = -mn * C;
  for (int r = 0; r < 16; ++r) p0[r] = fmaf(p0[r], C, mnC); for (int r = 0; r < 16; ++r) p1[r] = fmaf(p1[r], C, mnC);
  for (int r = 0; r < 16; ++r) p0[r] = __builtin_amdgcn_exp2f(p0[r]);
}
__device__ __forceinline__ void finishSM(f32x16& p0, f32x16& p1, float alpha, float& l_reg, bf16x8& pa0, bf16x8& pa1, bf16x8& pa2, bf16x8& pa3) {
  for (int r = 0; r < 16; ++r) p1[r] = __builtin_amdgcn_exp2f(p1[r]);
  float ps = 0; for (int r = 0; r < 16; ++r) ps += p0[r]; for (int r = 0; r < 16; ++r) ps += p1[r];
  { auto rr = __builtin_amdgcn_permlane32_swap(__float_as_uint(ps), __float_as_uint(ps), false, false);
    ps = __uint_as_float(rr[0]) + __uint_as_float(rr[1]); }
  l_reg = l_reg * alpha + ps;
#define PK4(P, BASE, OUT) do { unsigned a0 = cvt_pk_bf16(P[BASE + 0], P[BASE + 1]), a1 = cvt_pk_bf16(P[BASE + 2], P[BASE + 3]);   \
    unsigned b0 = cvt_pk_bf16(P[BASE + 4], P[BASE + 5]), b1 = cvt_pk_bf16(P[BASE + 6], P[BASE + 7]);                              \
    auto r0 = __builtin_amdgcn_permlane32_swap(a0, b0, false, false); auto r1 = __builtin_amdgcn_permlane32_swap(a1, b1, false, false); \
    u32x4 w = {r0[0], r1[0], r0[1], r1[1]}; OUT = *reinterpret_cast<bf16x8*>(&w); } while (0)
  PK4(p0, 0, pa0); PK4(p0, 8, pa1); PK4(p1, 0, pa2); PK4(p1, 8, pa3);
#undef PK4
}
__device__ __forceinline__ void qkt(f32x16& p0, f32x16& p1, const bf16_t* Ks, const bf16x8* qr, int r32, int hi) {
  p0 = f32x16{}; p1 = f32x16{};
  for (int d0 = 0; d0 < 8; ++d0) { int cb = (d0 * 16 + hi * 8) * 2;
    bf16x8 b0 = *reinterpret_cast<const bf16x8*>((const char*)Ks + KSWZ(r32, cb));
    bf16x8 b1 = *reinterpret_cast<const bf16x8*>((const char*)Ks + KSWZ(32 + r32, cb));
    p0 = __builtin_amdgcn_mfma_f32_32x32x16_bf16(b0, qr[d0], p0, 0, 0, 0);
    p1 = __builtin_amdgcn_mfma_f32_32x32x16_bf16(b1, qr[d0], p1, 0, 0, 0); }
}
__device__ __forceinline__ int v_st(int k, int c) { const int kk = (k & ~0xC) | ((k & 4) << 1) | ((k & 8) >> 1); return ((kk >> 3) * 4 + (c >> 5)) * 512 + ((kk & 7) * 32 + (c & 31)) * 2; }
__device__ __forceinline__ int v_rd_base(int lane) { return ((lane & 3) << 3) | (((lane >> 2) & 3) << 6) | (((lane >> 4) & 1) << 5) | (((lane >> 5) & 1) << 8); }
constexpr int v_rd_off(int d0, int ks, int half) { return d0 * 512 + ks * 4096 + half * 2048; }
template <int OFF> __device__ __forceinline__ s16x4 tr_read(int vb) {
  s16x4 r; asm volatile("ds_read_b64_tr_b16 %0, %1 offset:%2" : "=&v"(r) : "v"(vb), "i"(OFF) : "memory"); return r;
}
template <int D0> __device__ __forceinline__ void pv_one(f32x16& od, int vb, bf16x8 pa0, bf16x8 pa1, bf16x8 pa2, bf16x8 pa3) {
  const s16x4 l0 = tr_read<v_rd_off(D0, 0, 0)>(vb), h0 = tr_read<v_rd_off(D0, 0, 1)>(vb), l1 = tr_read<v_rd_off(D0, 1, 0)>(vb), h1 = tr_read<v_rd_off(D0, 1, 1)>(vb);
  const s16x4 l2 = tr_read<v_rd_off(D0, 2, 0)>(vb), h2 = tr_read<v_rd_off(D0, 2, 1)>(vb), l3 = tr_read<v_rd_off(D0, 3, 0)>(vb), h3 = tr_read<v_rd_off(D0, 3, 1)>(vb);
  asm volatile("s_waitcnt lgkmcnt(0)" ::: "memory"); SBAR();
#define PK(L, H) (bf16x8){L[0], L[1], L[2], L[3], H[0], H[1], H[2], H[3]}
  od = __builtin_amdgcn_mfma_f32_32x32x16_bf16(pa0, PK(l0, h0), od, 0, 0, 0);
  od = __builtin_amdgcn_mfma_f32_32x32x16_bf16(pa1, PK(l1, h1), od, 0, 0, 0);
  od = __builtin_amdgcn_mfma_f32_32x32x16_bf16(pa2, PK(l2, h2), od, 0, 0, 0);
  od = __builtin_amdgcn_mfma_f32_32x32x16_bf16(pa3, PK(l3, h3), od, 0, 0, 0);
#undef PK
}
__device__ __forceinline__ void pv_d0(f32x16* o, int vb, bf16x8 pa0, bf16x8 pa1, bf16x8 pa2, bf16x8 pa3) {
  pv_one<0>(o[0], vb, pa0, pa1, pa2, pa3); pv_one<1>(o[1], vb, pa0, pa1, pa2, pa3); pv_one<2>(o[2], vb, pa0, pa1, pa2, pa3); pv_one<3>(o[3], vb, pa0, pa1, pa2, pa3);
}
__device__ __forceinline__ void attn_dense_body(const bf16_t* __restrict__ Qb, const bf16_t* __restrict__ Kh, const bf16_t* __restrict__ Vh, bf16_t* __restrict__ Ob, int seq, char* lds) {
  const int tid = otid(), wid = tid >> 6, lane = tid & 63, r32 = lane & 31, hi = lane >> 5;
  bf16_t* V_lds = (bf16_t*)lds; bf16_t* K_lds = (bf16_t*)(lds + 2 * SHM_V);
  float* ws = (float*)(lds + 2 * SHM_V + 2 * SHM_K) + wid * 64; float* li_l = ws; float* al_l = ws + 32;
  float m_reg = -1e30f, l_reg = 0; f32x16 o[4] = {}; bf16x8 qr[8];
  const bf16_t* Qw = Qb + (long)(wid * QBLK + r32) * LDQ + hi * 8;
#pragma unroll
  for (int d0 = 0; d0 < 8; ++d0) qr[d0] = *reinterpret_cast<const bf16x8*>(Qw + d0 * 16);
  const int sr = tid >> 4, sc = (tid & 15) * 8, vst0 = v_st(sr, sc), vst1 = v_st(32 + sr, sc);
  const int vb0 = (int)(uintptr_t)V_lds + v_rd_base(lane);
  struct { bf16x8 vs0, vs1, ks0, ks1; } sr_[2];
#define SLOAD(i, k0) do { sr_[i].vs0 = *reinterpret_cast<const bf16x8*>(&Vh[(long)((k0) + sr) * LDK + sc]); sr_[i].vs1 = *reinterpret_cast<const bf16x8*>(&Vh[(long)((k0) + 32 + sr) * LDK + sc]); \
    sr_[i].ks0 = *reinterpret_cast<const bf16x8*>(&Kh[(long)((k0) + sr) * LDK + sc]); sr_[i].ks1 = *reinterpret_cast<const bf16x8*>(&Kh[(long)((k0) + 32 + sr) * LDK + sc]); } while (0)
#define SWRITE(b, i) do { *(bf16x8*)((char*)V_lds + (b) * SHM_V + vst0) = sr_[i].vs0;          \
    *(bf16x8*)((char*)V_lds + (b) * SHM_V + vst1) = sr_[i].vs1; int kc = sc * 2;               \
    *(bf16x8*)((char*)K_lds + (b) * SHM_K + KSWZ(sr, kc)) = sr_[i].ks0;                       \
    *(bf16x8*)((char*)K_lds + (b) * SHM_K + KSWZ(32 + sr, kc)) = sr_[i].ks1; } while (0)
#define SWAIT() asm volatile("s_waitcnt vmcnt(4)" ::: "memory")
#define RESC(a) do { if (__any((a) < 1.f)) { if (hi == 0) al_l[r32] = (a); asm volatile("s_waitcnt lgkmcnt(0)" ::: "memory"); \
    for (int d = 0; d < 4; ++d) for (int r = 0; r < 16; ++r) o[d][r] *= al_l[crow(r, hi)]; } } while (0)
  f32x16 pA0, pA1, pB0, pB1; float mnA, mnB, alA, alB; bf16x8 pa0, pa1, pa2, pa3; const int NT = seq / KVBLK;
  constexpr int SE = 0, SO = 1;
  SLOAD(SE, 0); asm volatile("s_waitcnt vmcnt(0)" ::: "memory"); SWRITE(0, SE); __syncthreads();
  qkt(pA0, pA1, K_lds, qr, r32, hi); partialSM(pA0, pA1, m_reg, mnA, alA);
  SLOAD(SO, KVBLK); if (2 < NT) SLOAD(SE, 2 * KVBLK);
  SWAIT(); SWRITE(1, SO); __syncthreads();
  for (int j = 1; j + 1 < NT; j += 2) {
    SBAR(); qkt(pB0, pB1, (bf16_t*)((char*)K_lds + SHM_K), qr, r32, hi);
    finishSM(pA0, pA1, alA, l_reg, pa0, pa1, pa2, pa3); SBAR();
    SLOAD(SO, (j + 2) * KVBLK); SBAR();
    pv_d0(o, vb0, pa0, pa1, pa2, pa3); partialSM(pB0, pB1, m_reg, mnB, alB);
    __syncthreads(); SWAIT(); SWRITE(0, SE);
    RESC(alB); __syncthreads();
    SBAR(); qkt(pA0, pA1, K_lds, qr, r32, hi);
    finishSM(pB0, pB1, alB, l_reg, pa0, pa1, pa2, pa3); SBAR();
    if (j + 3 < NT) SLOAD(SE, (j + 3) * KVBLK); SBAR();
    pv_d0(o, vb0 + (int)SHM_V, pa0, pa1, pa2, pa3); partialSM(pA0, pA1, m_reg, mnA, alA);
    __syncthreads(); SWAIT(); SWRITE(1, SO);
    RESC(alA); __syncthreads();
  }
  SBAR(); qkt(pB0, pB1, (bf16_t*)((char*)K_lds + SHM_K), qr, r32, hi);
  finishSM(pA0, pA1, alA, l_reg, pa0, pa1, pa2, pa3); SBAR();
  pv_d0(o, vb0, pa0, pa1, pa2, pa3); partialSM(pB0, pB1, m_reg, mnB, alB);
  __syncthreads(); RESC(alB);
  finishSM(pB0, pB1, alB, l_reg, pa0, pa1, pa2, pa3); SBAR();
  pv_d0(o, vb0 + (int)SHM_V, pa0, pa1, pa2, pa3);
  if (hi == 0) li_l[r32] = l_reg; asm volatile("s_waitcnt lgkmcnt(0)" ::: "memory");
  float rli[16];
#pragma unroll
  for (int r = 0; r < 16; ++r) rli[r] = __builtin_amdgcn_rcpf(li_l[crow(r, hi)]);
  bf16_t* Ow = Ob + (long)(wid * QBLK) * LDO;
#pragma unroll
  for (int r = 0; r < 16; ++r) { int orow = crow(r, hi);
    for (int d0 = 0; d0 < 4; ++d0) Ow[(long)orow * LDO + d0 * 32 + r32] = (bf16_t)(cvt_pk_bf16(o[d0][r] * rli[r], 0.f) & 0xffffu); }
#undef SLOAD
#undef SWRITE
#undef SWAIT
#undef RESC
}
}

__device__ __forceinline__ void attn_unit(const Params& p, unsigned char* lds_generic, int u) {
    const int qb = u & 7, g = (u >> 3) & 3, kvh = (u >> 5) & 1, b = u >> 6, hq = kvh * 4 + g;
    const bf16_t* Q = (const bf16_t*)(p.ws + WS_Q) + ((size_t)(b * TL + qb * 256)) * 1024 + hq * 128;
    const bf16_t* K = (const bf16_t*)(p.ws + WS_K) + (size_t)b * SKV * 256 + kvh * 128;
    const bf16_t* V = (const bf16_t*)(p.ws + WS_V) + (size_t)b * SKV * 256 + kvh * 128;
    bf16_t* O = (bf16_t*)(p.ws + WS_ATT) + ((size_t)(b * TL + qb * 256)) * 2048 + hq * 128;
    __syncthreads();
    att::attn_dense_body(Q, K, V, O, SKV, (char*)lds_generic);
}

__device__ __forceinline__ int jsw(int r, int c) { return r * 64 + ((((c) >> 3) ^ ((r ^ (r >> 3)) & 7)) << 3) + (c & 7); }
__device__ __forceinline__ f32x4 mfma16(bf16x8 a, bf16x8 b, f32x4 c) { return __builtin_amdgcn_mfma_f32_16x16x32_bf16(a, b, c, 0, 0, 0); }
__device__ __forceinline__ void mlstm_stream(const Params& p, LAS unsigned char* lds, int sid) {
    const int tid = otid(), w = __builtin_amdgcn_readfirstlane(tid >> 6), lane = tid & 63, fr = lane & 15, fq = lane >> 4;
    const int dir = sid & 1, h = (sid >> 1) & 7, b = sid >> 4;
    LAS bf16_t* Qs = (LAS bf16_t*)(lds + ML_QS); LAS bf16_t* Ks = (LAS bf16_t*)(lds + ML_KS); LAS bf16_t* KT = (LAS bf16_t*)(lds + ML_KT);
    LAS bf16_t* VT = (LAS bf16_t*)(lds + ML_VT); LAS bf16_t* Ps = (LAS bf16_t*)(lds + ML_PS); LAS bf16_t* C0 = (LAS bf16_t*)(lds + ML_C0);
    LAS float* sc_u = (LAS float*)(lds + ML_SC); LAS float* sc_pm = sc_u + 64; LAS float* sc_a = sc_u + 128; LAS float* sc_e = sc_u + 192;
    LAS float* cw = (LAS float*)(lds + ML_CW); LAS float* cbv = (LAS float*)(lds + ML_CB);
    const bf16_t* MQK = (const bf16_t*)(p.ws + WS_MQK); const bf16_t* MV = (const bf16_t*)(p.ws + WS_MV); const float* GT = (const float*)(p.ws + WS_GT);
    bf16_t* HO = (bf16_t*)(p.ws + WS_H) + (size_t)dir * NLAT * 1024;
    const int cg8 = (tid & 15) * 8, rg = tid >> 4, tl0 = 2 * rg;
    const int i0 = dir ? 63 - tl0 : tl0, i1 = dir ? i0 - 1 : i0 + 1, ie = dir ? i1 : i0;
    __syncthreads();
    for (int i = tid; i < 16 * 64; i += 512) VT[128 * 64 + i] = 0x3F80;
    for (int i = tid; i < 5 * 256; i += 512) { const int j = i >> 8, c = i & 255; cw[i] = p.conv_w[j * 2048 + (c < 128 ? h * 128 + c : 1024 + h * 128 + (c - 128))]; }
    for (int i = tid; i < 256; i += 512) cbv[i] = p.conv_b[i < 128 ? h * 128 + i : 1024 + h * 128 + (i - 128)];
    f32x4 C[9];
#pragma unroll
    for (int i = 0; i < 9; ++i) C[i] = (f32x4){0.f, 0.f, 0.f, 0.f};
    float m0 = 0.f;
    bf16x8 xq[6], xk[6], xv0, xv1; float g_ig, g_lf;
#define ML_CHUNK(ci_, lat_, chunk_, TS_, rbase_, t0_) const bool lat_ = (ci_) >= 4; const int chunk_ = lat_ ? (dir ? 35 - (ci_) : (ci_) - 4) : (dir ? 3 - (ci_) : (ci_)); \
        const int TS_ = lat_ ? TL : TCX; const size_t rbase_ = lat_ ? (size_t)b * TL : (size_t)NLAT + (size_t)b * TCX; const int t0_ = chunk_ * 64;
#define ML_LOAD(ci_) do { ML_CHUNK(ci_, l_, c_, ts_, rb_, t_) \
        { const int tl = dir ? 63 - lane : lane; const size_t row = rb_ + t_ + tl; g_ig = GT[row * 32 + dir * 16 + h]; g_lf = GT[row * 32 + dir * 16 + 8 + h]; } \
        _Pragma("unroll") for (int rr = 0; rr < 6; ++rr) { const int sl = t_ + tl0 - 2 + rr; xq[rr] = (bf16x8){0, 0, 0, 0, 0, 0, 0, 0}; xk[rr] = xq[rr]; \
            if (sl >= 0 && sl < ts_) { const bf16_t* src = MQK + (rb_ + sl) * 2048 + h * 128 + cg8; xq[rr] = *(const bf16x8*)src; xk[rr] = *(const bf16x8*)(src + 1024); } } \
        xv0 = *(const bf16x8*)(MV + (rb_ + t_ + tl0) * 1024 + h * 128 + cg8); xv1 = *(const bf16x8*)(MV + (rb_ + t_ + tl0 + 1) * 1024 + h * 128 + cg8); } while (0)
    ML_LOAD(0);
    __syncthreads();
    for (int ci = 0; ci < 36; ++ci) {
        ML_CHUNK(ci, lat, chunk, TS, rbase, t0)
        (void)TS;
        float wgt, decay, m0n;
        {
            float bc = g_lf;
#pragma unroll
            for (int d = 1; d < 64; d <<= 1) { const float v = __shfl_up(bc, d); if (lane >= d) bc += v; }
            const float uu = g_ig - bc; float px = uu;
#pragma unroll
            for (int d = 1; d < 64; d <<= 1) { const float v = __shfl_up(px, d); if (lane >= d) px = fmaxf(px, v); }
            const float pm = fmaxf(m0, px);
            const float bL = __shfl(bc, 63), pmL = __shfl(pm, 63);
            wgt = __expf(uu - pmL); decay = __expf(m0 - pmL); m0n = bL + pmL;
            if (w == 0) { sc_u[lane] = uu; sc_pm[lane] = pm; sc_a[lane] = __expf(m0 - pm); sc_e[lane] = __expf(-bc - pm); }
        }
        {
            const float w0 = __shfl(wgt, i0), w1 = __shfl(wgt, i1);
#pragma unroll
            for (int qk = 0; qk < 2; ++qk) {
                float y0[8], y1[8];
#pragma unroll
                for (int e = 0; e < 8; ++e) { y0[e] = cbv[qk * 128 + cg8 + e]; y1[e] = y0[e]; }
#pragma unroll
                for (int j = 0; j < 5; ++j) {
                    const f32x4 wa = *(const LAS f32x4*)(cw + j * 256 + qk * 128 + cg8), wb = *(const LAS f32x4*)(cw + j * 256 + qk * 128 + cg8 + 4);
#pragma unroll
                    for (int e = 0; e < 8; ++e) { const float wv = e < 4 ? wa[e] : wb[e - 4]; const bf16x8 xa = qk ? xk[j] : xq[j], xb = qk ? xk[j + 1] : xq[j + 1];
                        y0[e] += wv * bf2f((unsigned short)xa[e]); y1[e] += wv * bf2f((unsigned short)xb[e]); }
                }
                const float ksc = qk ? 0.08838834764831845f : 1.0f;
#pragma unroll
                for (int e = 0; e < 8; ++e) { y0[e] = silu_f(y0[e]) * ksc; y1[e] = silu_f(y1[e]) * ksc; }
                LAS bf16_t* dst = qk ? Ks : Qs;
                u32x4 p0, p1; p0.x = cvt_pk_bf16(y0[0], y0[1]); p0.y = cvt_pk_bf16(y0[2], y0[3]); p0.z = cvt_pk_bf16(y0[4], y0[5]); p0.w = cvt_pk_bf16(y0[6], y0[7]);
                p1.x = cvt_pk_bf16(y1[0], y1[1]); p1.y = cvt_pk_bf16(y1[2], y1[3]); p1.z = cvt_pk_bf16(y1[4], y1[5]); p1.w = cvt_pk_bf16(y1[6], y1[7]);
                *(LAS u32x4*)(dst + i0 * QS_LD + cg8) = p0; *(LAS u32x4*)(dst + i1 * QS_LD + cg8) = p1;
                if (qk) {
#pragma unroll
                    for (int e = 0; e < 8; ++e) { const float a0 = y0[e] * w0, a1 = y1[e] * w1; *(LAS unsigned*)(KT + jsw(cg8 + e, ie)) = dir ? cvt_pk_bf16(a1, a0) : cvt_pk_bf16(a0, a1); }
                }
            }
#pragma unroll
            for (int e = 0; e < 8; ++e) { const unsigned lo = (unsigned short)(dir ? xv1[e] : xv0[e]), hi = (unsigned short)(dir ? xv0[e] : xv1[e]); *(LAS unsigned*)(VT + jsw(cg8 + e, ie)) = lo | (hi << 16); }
        }
        if (ci + 1 < 36) ML_LOAD(ci + 1);
        __syncthreads();
        if (lat) {
            const int it = w >> 1;
#pragma unroll
            for (int jj = 0; jj < 2; ++jj) {
                const int jt = (w & 1) * 2 + jj;
                f32x4 s = (f32x4){0.f, 0.f, 0.f, 0.f};
                if (jt <= it) {
#pragma unroll
                    for (int ks = 0; ks < 4; ++ks) { const bf16x8 a = *(const LAS bf16x8*)(Ks + (jt * 16 + fr) * QS_LD + ks * 32 + fq * 8), bb = *(const LAS bf16x8*)(Qs + (it * 16 + fr) * QS_LD + ks * 32 + fq * 8); s = mfma16(a, bb, s); }
                    const int i = it * 16 + fr, j0 = jt * 16 + 4 * fq; const float pmi = sc_pm[i]; const f32x4 uj = *(const LAS f32x4*)(sc_u + j0);
#pragma unroll
                    for (int r = 0; r < 4; ++r) s[r] = (j0 + r <= i) ? s[r] * __expf(uj[r] - pmi) : 0.f;
                }
                u32x2 pw; pw.x = cvt_pk_bf16(s[0], s[1]); pw.y = cvt_pk_bf16(s[2], s[3]);
                *(LAS u32x2*)(Ps + (it * 16 + fr) * JS_LD + jt * 16 + 4 * fq) = pw;
            }
#pragma unroll
            for (int nt = 0; nt < 9; ++nt) { u32x2 cwd; cwd.x = cvt_pk_bf16(C[nt][0], C[nt][1]); cwd.y = cvt_pk_bf16(C[nt][2], C[nt][3]); *(LAS u32x2*)(C0 + (nt * 16 + fr) * QS_LD + w * 16 + 4 * fq) = cwd; }
        }
        {
            const bf16x8 a0 = *(const LAS bf16x8*)(KT + jsw(w * 16 + fr, fq * 8)), a1 = *(const LAS bf16x8*)(KT + jsw(w * 16 + fr, 32 + fq * 8));
#pragma unroll
            for (int nt = 0; nt < 9; ++nt) { C[nt] *= decay;
                C[nt] = mfma16(a0, *(const LAS bf16x8*)(VT + jsw(nt * 16 + fr, fq * 8)), C[nt]); C[nt] = mfma16(a1, *(const LAS bf16x8*)(VT + jsw(nt * 16 + fr, 32 + fq * 8)), C[nt]); }
        }
        __syncthreads();
        if (lat) {
            const int it = w >> 1, dvh = w & 1, i = it * 16 + fr;
            f32x4 ac[5];
#pragma unroll
            for (int t = 0; t < 5; ++t) ac[t] = (f32x4){0.f, 0.f, 0.f, 0.f};
#pragma unroll
            for (int ks = 0; ks < 4; ++ks) { const bf16x8 bq = *(const LAS bf16x8*)(Qs + i * QS_LD + ks * 32 + fq * 8);
#pragma unroll
                for (int t = 0; t < 5; ++t) { const int row = (t < 4 ? (dvh * 4 + t) * 16 : 128) + fr; ac[t] = mfma16(*(const LAS bf16x8*)(C0 + row * QS_LD + ks * 32 + fq * 8), bq, ac[t]); } }
            const float ai = sc_a[i];
#pragma unroll
            for (int t = 0; t < 5; ++t) ac[t] *= ai;
#pragma unroll
            for (int ks = 0; ks < 2; ++ks) { const bf16x8 bp = *(const LAS bf16x8*)(Ps + i * JS_LD + ks * 32 + fq * 8);
#pragma unroll
                for (int t = 0; t < 5; ++t) { const int row = (t < 4 ? (dvh * 4 + t) * 16 : 128) + fr; ac[t] = mfma16(*(const LAS bf16x8*)(VT + jsw(row, ks * 32 + fq * 8)), bp, ac[t]); } }
            const float den = fmaxf(fabsf(ac[4][0]), sc_e[i]); const float rd = 1.0f / den;
            const size_t row = rbase + t0 + (dir ? 63 - i : i);
#pragma unroll
            for (int t = 0; t < 4; ++t) { u32x2 hw; hw.x = cvt_pk_bf16(ac[t][0] * rd, ac[t][1] * rd); hw.y = cvt_pk_bf16(ac[t][2] * rd, ac[t][3] * rd);
                *(u32x2*)(HO + row * 1024 + h * 128 + (dvh * 4 + t) * 16 + 4 * fq) = hw; }
        }
        m0 = m0n;
        __syncthreads();
    }
#undef ML_LOAD
#undef ML_CHUNK
}

__device__ __forceinline__ void phase_combine(const Params& p) {
    const bf16_t* HF = (const bf16_t*)(p.ws + WS_H); const bf16_t* HB = HF + (size_t)NLAT * 1024; const bf16_t* MO = (const bf16_t*)(p.ws + WS_MO);
    bf16_t* AT = (bf16_t*)(p.ws + WS_ATT);
    const int tid = otid(), c8 = (tid & 127) * 8, rq = tid >> 7;
    f32x4 g0 = *(const f32x4*)(p.m_gain + c8), g1 = *(const f32x4*)(p.m_gain + c8 + 4);
    for (int r = blockIdx.x * 4 + rq; r < NLAT; r += gridDim.x * 4) {
        const bf16x8 a = *(const bf16x8*)(HF + (size_t)r * 1024 + c8), bb = *(const bf16x8*)(HB + (size_t)r * 1024 + c8), mo = *(const bf16x8*)(MO + (size_t)r * 1024 + c8);
        float x[8], ss = 0.f;
#pragma unroll
        for (int e = 0; e < 8; ++e) { x[e] = bf2f((unsigned short)a[e]) + bf2f((unsigned short)bb[e]); ss += x[e] * x[e]; }
        ss += __shfl_xor(ss, 1); ss += __shfl_xor(ss, 2); ss += __shfl_xor(ss, 4); ss += __shfl_xor(ss, 8);
        const float rs = rsqrtf(ss * (1.0f / 128.0f) + RMS_EPS);
        float y[8];
#pragma unroll
        for (int e = 0; e < 8; ++e) y[e] = x[e] * rs * (e < 4 ? g0[e] : g1[e - 4]) * bf2f((unsigned short)mo[e]);
        u32x4 wv; wv.x = cvt_pk_bf16(y[0], y[1]); wv.y = cvt_pk_bf16(y[2], y[3]); wv.z = cvt_pk_bf16(y[4], y[5]); wv.w = cvt_pk_bf16(y[6], y[7]);
        *(u32x4*)(AT + (size_t)r * 2048 + 1024 + c8) = wv;
    }
}

#define XB_TMO      128
#define XB_XCNT(j)  (256  + 64 * (j))
#define XB_XSUB(j)  (1280 + 64 * (j))
#define XB_XGEN(j)  (2304 + 64 * (j))
#define XB_TOP      3328
#define XB_TOPGEN   3392
#define XCD_BAR_WORDS 3456
#define XB_SPIN_CAP (1u << 22)
__device__ __forceinline__ unsigned xb_ld(unsigned* p)              { return __hip_atomic_load(p, __ATOMIC_RELAXED, __HIP_MEMORY_SCOPE_AGENT); }
__device__ __forceinline__ unsigned xb_add(unsigned* p, unsigned v) { return __hip_atomic_fetch_add(p, v, __ATOMIC_RELAXED, __HIP_MEMORY_SCOPE_AGENT); }
__device__ __forceinline__ unsigned xb_xcc_id() { return (unsigned)__builtin_amdgcn_s_getreg((3 << 11) | 20) & 0xFu; }
#define XB_SPIN(cond, bar) do { unsigned _sp = 0; while (cond) { __builtin_amdgcn_s_sleep(1); \
    if ((++_sp & 255u) == 0u) { if (xb_ld(&(bar)[XB_TMO])) break; if (_sp > XB_SPIN_CAP) { atomicAdd(&(bar)[XB_TMO], 1u); break; } } } } while (0)
struct XcdBarrier { unsigned* bar; unsigned x; volatile LAS unsigned* st; };
__device__ __forceinline__ XcdBarrier xcd_barrier_post(unsigned* bar, volatile LAS unsigned* st) {
    XcdBarrier b; b.bar = bar; b.x = xb_xcc_id(); b.st = st;
    if (threadIdx.x == 0) (void)xb_add(&bar[XB_XCNT(b.x)], 1u);
    return b;
}
__device__ __forceinline__ void xcd_barrier_complete(unsigned* bar, unsigned x, unsigned& nloc, unsigned& nx) {
    const unsigned G = gridDim.x * gridDim.y * gridDim.z;
    unsigned sum, cnt, mine, sp = 0u;
    for (;;) {
        sum = 0u; cnt = 0u; mine = 0u;
#pragma unroll
        for (unsigned j = 0; j < 16; ++j) { const unsigned c = xb_ld(&bar[XB_XCNT(j)]); sum += c; cnt += (c > 0u) ? 1u : 0u; mine = (j == x) ? c : mine; }
        if (sum == G) break;
        __builtin_amdgcn_s_sleep(1);
        if ((++sp & 255u) == 0u) { if (xb_ld(&bar[XB_TMO])) break; if (sp > XB_SPIN_CAP) { atomicAdd(&bar[XB_TMO], 1u); break; } }
    }
    nloc = mine > 0u ? mine : 1u; nx = cnt > 0u ? cnt : 1u;
}
__device__ __forceinline__ void xcd_barrier(const XcdBarrier& b) {
    asm volatile("s_waitcnt vmcnt(0)" ::: "memory");
    __syncthreads();
    if (threadIdx.x == 0) {
        unsigned* bar = b.bar;
        __builtin_amdgcn_s_waitcnt(0);
        unsigned nloc = b.st[0], nx = b.st[1];
        if (nloc == 0u) { xcd_barrier_complete(bar, b.x, nloc, nx); b.st[0] = nloc; b.st[1] = nx; }
        const unsigned old = xb_add(&bar[XB_XSUB(b.x)], 1u);
        const unsigned gen = old / nloc;
        if (old + 1u == (gen + 1u) * nloc) {
            __builtin_amdgcn_fence(__ATOMIC_RELEASE, "agent");
            asm volatile("s_waitcnt vmcnt(0)" ::: "memory");
            const unsigned og = xb_add(&bar[XB_TOP], 1u);
            const unsigned tg = og / nx;
            if (og + 1u == (tg + 1u) * nx) xb_add(&bar[XB_TOPGEN], 1u);
            else XB_SPIN(xb_ld(&bar[XB_TOPGEN]) == tg, bar);
            __builtin_amdgcn_fence(__ATOMIC_ACQUIRE, "agent");
            xb_add(&bar[XB_XGEN(b.x)], 1u);
            asm volatile("s_waitcnt vmcnt(0)" ::: "memory");
        } else {
            XB_SPIN(xb_ld(&bar[XB_XGEN(b.x)]) == gen, bar);
            __builtin_amdgcn_fence(__ATOMIC_ACQUIRE, "agent");
            asm volatile("s_waitcnt vmcnt(0)" ::: "memory");
        }
    }
    __syncthreads();
}

__global__ void __launch_bounds__(512, 2) fwd_megakernel(Params p0) {
    extern __shared__ __attribute__((aligned(16))) unsigned char lds_raw[];
    LAS unsigned char* lds = (LAS unsigned char*)lds_raw;
    if (threadIdx.x < 16) ((LAS unsigned*)(lds + LDS_CTL))[threadIdx.x] = 0u;
    __syncthreads();
    XcdBarrier xbar; xbar.bar = (unsigned*)(p0.ws + WS_BAR); xbar.x = 0; xbar.st = (volatile LAS unsigned*)(lds + LDS_CTL + 16);
    if (p0.ph_hi - p0.ph_lo > 1) xbar = xcd_barrier_post((unsigned*)(p0.ws + WS_BAR), (volatile LAS unsigned*)(lds + LDS_CTL + 16));
    for (int ph = p0.ph_lo; ph < p0.ph_hi; ++ph) {
#if defined(__HIP_DEVICE_COMPILE__)
        const __attribute__((address_space(4))) Params* pp = (const __attribute__((address_space(4))) Params*)__builtin_amdgcn_kernarg_segment_ptr();
        asm volatile("" : "+s"(pp));
        const Params p = *pp;
        int G = gridDim.x, bid = blockIdx.x; asm volatile("" : "+s"(G), "+s"(bid));
#else
        const Params p = p0; int G = 0, bid = 0;
#endif
        unsigned char* ws = p.ws;
        float* mod = (float*)(ws + WS_MOD);
        for (int rep = 0; rep < (((DUPMASK >> ph) & 1) ? 2 : 1); ++rep)
        if (HAS(0) && ph == 0) {
            phase_prep(p, lds, rep == 0);
        } else if (HAS(1) && (ph == 1 || ph == 4 || ph == 9)) {
            const float* sl = ph == 1 ? p.x : p.out; const float* scx = p.ctx;
            const int nrows = ph == 9 ? NLAT : MR, midx = ph == 1 ? 0 : (ph == 4 ? 3 : 6);
            phase_rows<0>(sl, scx, nrows, p.g_norm + (ph == 1 ? 0 : (ph == 4 ? 1 : 2)) * DM, mod, midx, (bf16_t*)(ws + WS_H), nullptr, ph == 4 ? (const float*)(ws + WS_PART) : nullptr);
            if (ph == 4) phase_gates(p, ws, lds);
        } else if (HAS(2) && (ph == 2 || ph == 10)) {
            pg8::Gemm g{(const bf16_t*)(ws + WS_H), (const bf16_t*)(ws + (ph == 2 ? WS_WUP1 : WS_WUP2)), ph == 2 ? MR : NLAT, NUP, DM, DM};
            pg8::StaticOrder S; S.init(g.M, g.N, G, bid);
            EpiSwiglu E{(bf16_t*)(ws + WS_HID)};
            pg8::gemm_phase<EpiSwiglu>(lds, g, S, E);
            if (ph == 2) { const int busy = S.nwg % G; const int i0 = busy != 0 ? bid - busy : bid, nn = busy != 0 ? G - busy : G;
                if (i0 >= 0) { prep_weights(p, lds, 1, i0, nn); prep_weights(p, lds, 2, i0, nn); } }
        } else if (HAS(3) && (ph == 3 || ph == 8 || ph == 11)) {
            pg8::Gemm g;
            if (ph == 3) g = pg8::Gemm{(const bf16_t*)(ws + WS_HID), (const bf16_t*)(ws + WS_WDN1), NLAT, DM, DFF, DFF};
            else if (ph == 8) g = pg8::Gemm{(const bf16_t*)(ws + WS_ATT), (const bf16_t*)(ws + WS_WOUT), NLAT, DM, DM, DM};
            else g = pg8::Gemm{(const bf16_t*)(ws + WS_HID), (const bf16_t*)(ws + WS_WDN2), NLAT, DM, DFF, DFF};
            pg8::StaticOrder S; S.init(g.M, g.N, G, bid);
            EpiResid E{ph == 3 ? p.x : p.out, p.ctx, p.out, nullptr, mod, ph == 3 ? 2 : (ph == 8 ? 5 : 8), ph == 8 ? 1.0f : 0.5f};
            pg8::gemm_phase<EpiResid>(lds, g, S, E);
            if (ph == 3) {
                pg8::Gemm g2{(const bf16_t*)(ws + WS_HID), (const bf16_t*)(ws + WS_WDN1), NCTX, DM, DFF / 4, DFF};
                pg8::StaticOrder S2; S2.init(NCTX, DM, G, bid, 64, 4);
                EpiPartial E2{(float*)(ws + WS_PART)};
                pg8::gemm_phase<EpiPartial>(lds, g2, S2, E2);
            }
        } else if (HAS(5) && ph == 5) {
            pg8::Gemm g{(const bf16_t*)(ws + WS_H), (const bf16_t*)(ws + WS_WIN), NLAT, 5632, DM, DM};
            pg8::StaticOrder S; S.init(g.M, g.N, G, bid); S.extra(64, 8, 4, 14);
            EpiWin E{(bf16_t*)(ws + WS_Q), (bf16_t*)(ws + WS_K), (bf16_t*)(ws + WS_V), (bf16_t*)(ws + WS_MQK), (bf16_t*)(ws + WS_MV), (bf16_t*)(ws + WS_MO), (float*)(ws + WS_GT),
                     p.q_gain, p.k_gain, p.gate_b, (const float*)(ws + WS_ROPE), (LAS float*)(lds + LDS_RED)};
            pg8::gemm_phase<EpiWin>(lds, g, S, E);
        } else if (HAS(6) && ph == 6) {
#if !defined(NO_MLSTM)
            for (int s = bid; s < 128 && rep == 0; s += G) mlstm_stream(p, lds, s);
#endif
#if !defined(NO_ATTN)
            {
                int* ctr = (int*)(ws + WS_CTR) + rep * 8;
                for (int qi = 0; qi < 8; ++qi) {
                    const int bq = (bid + qi) & 7;
                    for (;;) {
                        __syncthreads();
                        if (otid() == 0) { int v = __hip_atomic_load(ctr + bq, __ATOMIC_RELAXED, __HIP_MEMORY_SCOPE_AGENT); if (v < 64) v = atomicAdd(ctr + bq, 1); *(LAS int*)(lds + LDS_CTL) = v; }
                        __syncthreads();
                        const int u = *(LAS int*)(lds + LDS_CTL);
                        if (u >= 64) break;
                        attn_unit(p, lds_raw, bq * 64 + u);
                    }
                }
            }
#endif
        } else if (HAS(7) && ph == 7) {
            phase_combine(p);
        } else if (HAS(12) && ph == 12) {
            phase_rows<1>(p.out, nullptr, NLAT, p.g_final, nullptr, 0, nullptr, p.out, nullptr);
        }
        if (ph + 1 < p0.ph_hi) {
            if (p0.ph_hi > 1000) cg::this_grid().sync(); else xcd_barrier(xbar);
        }
    }
}

extern "C" void kernel_launch(void* const* d_in, const int* in_sizes, int n_in, void* d_out, int out_size, void* d_ws, size_t ws_size, hipStream_t stream) {
    static int grid = 0;
    if (grid == 0) {
        if (n_in != 20 || out_size != NLAT * DM || ws_size < WS_END) { fprintf(stderr, "kernel_launch: unexpected shapes (n_in %d out %d ws %zu need %zu)\n", n_in, out_size, ws_size, (size_t)WS_END); grid = -1; return; }
        int dev = 0, cus = 0, per_cu = 0;
        hipGetDevice(&dev); hipDeviceGetAttribute(&cus, hipDeviceAttributeMultiprocessorCount, dev);
        if (hipFuncSetAttribute((const void*)fwd_megakernel, hipFuncAttributeMaxDynamicSharedMemorySize, LDS_BYTES) != hipSuccess) { fprintf(stderr, "kernel_launch: hipFuncSetAttribute failed\n"); grid = -1; return; }
        hipOccupancyMaxActiveBlocksPerMultiprocessor(&per_cu, (const void*)fwd_megakernel, 512, LDS_BYTES);
        if (per_cu < 1) { fprintf(stderr, "kernel_launch: occupancy query says %d blocks per CU\n", per_cu); per_cu = 1; }
        (void)hipGetLastError();
        grid = cus * 1;
    }
    if (grid < 0) return;
    (void)hipMemsetAsync((char*)d_ws + WS_MOD, 0, (size_t)(WS_ROPE - WS_MOD), stream);
    Params p{};
    p.x = (const float*)d_in[0]; p.c = (const float*)d_in[1]; p.ctx = (const float*)d_in[2]; p.c_ctx = (const float*)d_in[3]; p.w_mod = (const float*)d_in[4]; p.b_mod = (const float*)d_in[5];
    p.g_norm = (const float*)d_in[6]; p.w_up1 = (const float*)d_in[7]; p.w_dn1 = (const float*)d_in[8]; p.w_up2 = (const float*)d_in[9]; p.w_dn2 = (const float*)d_in[10]; p.w_in = (const float*)d_in[11];
    p.q_gain = (const float*)d_in[12]; p.k_gain = (const float*)d_in[13]; p.conv_w = (const float*)d_in[14]; p.conv_b = (const float*)d_in[15]; p.gate_b = (const float*)d_in[16]; p.m_gain = (const float*)d_in[17];
    p.w_out = (const float*)d_in[18]; p.g_final = (const float*)d_in[19]; p.out = (float*)d_out; p.ws = (unsigned char*)d_ws;
#if MK_MULTI
    for (int ph = 0; ph < NPH; ++ph) { p.ph_lo = ph; p.ph_hi = ph + 1; hipLaunchKernelGGL(fwd_megakernel, dim3(grid), dim3(512), LDS_BYTES, stream, p); }
#else
    p.ph_lo = 0; p.ph_hi = NPH;
    void* args[] = {&p};
    hipError_t e = hipLaunchCooperativeKernel((const void*)fwd_megakernel, dim3(grid), dim3(512), args, LDS_BYTES, stream);
    if (e != hipSuccess) fprintf(stderr, "cooperative launch failed: %s (grid %d)\n", hipGetErrorString(e), grid);
#endif
}
```

```cpp
#include <hip/hip_runtime.h>
#include <hip/hip_cooperative_groups.h>
#include <cstdio>
#include <cstdint>
namespace cg = cooperative_groups;

#define LAS __attribute__((address_space(3)))
typedef unsigned short bf16_t;
typedef short bf16x8 __attribute__((ext_vector_type(8)));
typedef short s16x4 __attribute__((ext_vector_type(4)));
typedef float f32x4 __attribute__((ext_vector_type(4)));
typedef float f32x16 __attribute__((ext_vector_type(16)));
typedef unsigned u32x4 __attribute__((ext_vector_type(4)));
typedef unsigned u32x2 __attribute__((ext_vector_type(2)));

#ifndef PHMASK
#define PHMASK 0x1fff
#endif
#define HAS(k) ((PHMASK >> (k)) & 1)
#ifndef DUPMASK
#define DUPMASK 0
#endif
#ifndef MK_MULTI
#define MK_MULTI 0
#endif

constexpr int DM = 2048, NB = 8, TL = 2048, TCX = 256, NLAT = NB * TL, NCTX = NB * TCX, MR = NLAT + NCTX;
constexpr int DFF = 5632, NUP = 2 * DFF, PW = 5664, PWP = 5888, NMOD = 9, MODW = NMOD * DM;
constexpr int SKV = TCX + TL;
constexpr float RMS_EPS = 1e-6f;
constexpr int NPH = 13;

constexpr size_t al256(size_t x) { return (x + 255) / 256 * 256; }
constexpr size_t WS_MOD = 0;
constexpr size_t WS_CTR = WS_MOD + (size_t)9 * MODW * 4;
constexpr size_t WS_BAR = WS_CTR + 256;
constexpr size_t WS_PCNT = al256(WS_BAR + 3456 * 4);
constexpr size_t WS_ROPE = WS_PCNT + (size_t)3 * 64 * 256;
constexpr size_t WS_WUP1 = al256(WS_ROPE + 4096 * 4);
constexpr size_t WS_WDN1 = WS_WUP1 + (size_t)NUP * DM * 2;
constexpr size_t WS_WIN = WS_WDN1 + (size_t)DM * DFF * 2;
constexpr size_t WS_WOUT = WS_WIN + (size_t)PWP * DM * 2;
constexpr size_t WS_WUP2 = WS_WOUT + (size_t)DM * DM * 2;
constexpr size_t WS_WDN2 = WS_WUP2 + (size_t)NUP * DM * 2;
constexpr size_t WS_H = WS_WDN2 + (size_t)DM * DFF * 2;
constexpr size_t WS_HID = WS_H + (size_t)MR * DM * 2;
constexpr size_t WS_Q = WS_HID;
constexpr size_t WS_K = WS_Q + (size_t)NLAT * 1024 * 2;
constexpr size_t WS_V = WS_K + (size_t)NB * SKV * 256 * 2;
constexpr size_t WS_MQK = WS_V + (size_t)NB * SKV * 256 * 2;
constexpr size_t WS_MV = WS_MQK + (size_t)MR * 2048 * 2;
constexpr size_t WS_MO = WS_MV + (size_t)MR * 1024 * 2;
constexpr size_t WS_GT = WS_MO + (size_t)NLAT * 1024 * 2;
constexpr size_t WS_PROJ_END = WS_GT + (size_t)MR * 32 * 4;
constexpr size_t WS_ATT = WS_HID + (size_t)MR * DFF * 2;
constexpr size_t WS_PART = WS_ATT;
constexpr size_t WS_XC = WS_ATT + (size_t)NLAT * 2048 * 2;
constexpr size_t WS_END = WS_XC + (size_t)NCTX * DM * 4;
static_assert(WS_PROJ_END <= WS_ATT, "projection outputs must fit in the hidden buffer");

constexpr int LDS_STAGE = 131072;
constexpr int LDS_RED = LDS_STAGE;
constexpr int LDS_CTL = LDS_STAGE + 8192;
constexpr int LDS_BYTES = LDS_CTL + 64;
constexpr int QS_LD = 136, JS_LD = 72;
constexpr int ML_QS = 0, ML_KS = ML_QS + 64 * QS_LD * 2, ML_KT = ML_KS + 64 * QS_LD * 2, ML_VT = ML_KT + 128 * 64 * 2, ML_PS = ML_VT + 144 * 64 * 2,
              ML_C0 = ML_PS + 64 * JS_LD * 2, ML_SC = ML_C0 + 144 * QS_LD * 2, ML_CW = ML_SC + 5 * 64 * 4, ML_CB = ML_CW + 5 * 256 * 4, ML_END = ML_CB + 256 * 4;
static_assert(ML_END <= LDS_BYTES, "mLSTM LDS");

struct Params {
    const float *x, *c, *ctx, *c_ctx, *w_mod, *b_mod, *g_norm, *w_up1, *w_dn1, *w_up2, *w_dn2, *w_in, *q_gain, *k_gain, *conv_w, *conv_b, *gate_b, *m_gain, *w_out, *g_final;
    float* out; unsigned char* ws; int ph_lo, ph_hi;
};

__device__ __forceinline__ int otid() { int t = threadIdx.x; asm volatile("" : "+v"(t)); return t; }
__device__ __forceinline__ unsigned cvt_pk_bf16(float lo, float hi) { unsigned r; asm volatile("v_cvt_pk_bf16_f32 %0, %1, %2" : "=v"(r) : "v"(lo), "v"(hi)); return r; }
__device__ __forceinline__ float bf2f(unsigned short v) { return __uint_as_float(((unsigned)v) << 16); }
__device__ __forceinline__ float silu_f(float x) { return x * __builtin_amdgcn_rcpf(1.0f + __expf(-x)); }
__device__ __forceinline__ float sigmoid_f(float x) { return __builtin_amdgcn_rcpf(1.0f + __expf(-x)); }
__device__ __forceinline__ float logsigmoid_f(float x) { return fminf(x, 0.f) - __logf(1.0f + __expf(-fabsf(x))); }

namespace pg8 {
constexpr int BM = 256, BK = 64, HALF = 128, HTB = HALF * BK * 2, NXCD = 8, WGM = 8;
__device__ __forceinline__ int lds_byte(int r, int c) { const int st = (r >> 4) * 2 + (c >> 5), rr = r & 15, cc = c & 31, ob = rr * 64 + cc * 2; return st * 1024 + (ob ^ (((ob >> 9) & 1) << 5)); }
__device__ __forceinline__ void stage_rc(int b, int& R, int& C) { const int st = b / 1024, sb = b % 1024, swz = sb ^ (((sb >> 9) & 1) << 5); R = (st >> 1) * 16 + swz / 64; C = (st & 1) * 32 + (swz % 64) / 2; }
__device__ __forceinline__ int perm32(int rho) { const int n = rho >> 4, i = rho & 15; return 8 * (i >> 2) + 4 * n + (i & 3); }
struct Unit { int pm, pn, ks; };
struct Gemm { const bf16_t* A; const bf16_t* Bt; int M, N, K, ld; };
struct StaticOrder {
    int nM, nN, nwg, G, c, pm0, nNr;
    __device__ void init(int M, int N, int G_, int c_, int pm0_ = 0, int ksplit = 1) { nM = M / BM; nNr = N / BM; nN = nNr * ksplit; nwg = nM * nN; G = G_; c = c_; pm0 = pm0_; }
    __device__ bool next(int i, Unit& u) const {
        const long L = (long)i * G + c; if (L >= nwg) return false;
        int wgid = (int)L; { const int q = nwg / NXCD, r = nwg % NXCD, xcd = wgid % NXCD, off = wgid / NXCD; wgid = (xcd < r ? xcd * (q + 1) : r * (q + 1) + (xcd - r) * q) + off; }
        const int nig = WGM * nN, gid = wgid / nig, fm = gid * WGM, gsz = (nM - fm) < WGM ? (nM - fm) : WGM;
        u.pm = pm0 + fm + ((wgid % nig) % gsz); const int pe = (wgid % nig) / gsz; u.pn = pe % nNr; u.ks = pe / nNr; return true;
    }
};

template <class Epi>
__device__ __forceinline__ void gemm_phase(LAS unsigned char* lds, const Gemm g, const StaticOrder& S, const Epi& E) {
    const int tid = otid(), wid = __builtin_amdgcn_readfirstlane(tid >> 6), lane = tid & 63, wr = wid >> 2, wc = wid & 3, fr = lane & 15, fq = lane >> 4;
    const int K = g.K, nt = K / BK;
    unsigned voffA[2], voffB[2];
#pragma unroll
    for (int i = 0; i < 2; ++i) { int R, C; stage_rc(tid * 16 + i * 8192, R, C); const int Rb = Epi::PERM ? ((R & ~31) + perm32(R & 31)) : R;
        voffA[i] = (unsigned)(R * g.ld + C) * 2u; voffB[i] = (unsigned)(Rb * g.ld + C) * 2u; }
    const size_t kstep = (size_t)(BK * 2);
    const size_t hstep = (size_t)HALF * g.ld * 2;
    const size_t ksB = (size_t)K * 2;
    const size_t tstep = 2 * hstep;
    const unsigned ldsw = (unsigned)wid * 1024u;
    const int aoff = lds_byte(wr * 64 + fr, fq * 8), boff = lds_byte(wc * 32 + fr, fq * 8);
#define PG8_SA(b, h) (((b) * 2 + (h)) * HTB)
#define PG8_SB(b, h) ((4 + (b) * 2 + (h)) * HTB)
#define PG8_STAGE(bufoff, gbase, voff) do { _Pragma("unroll") for (int _i = 0; _i < 2; ++_i) \
        __builtin_amdgcn_global_load_lds((const unsigned*)((const char*)(gbase) + (voff)[_i]), (LAS unsigned*)(lds + (bufoff) + ldsw + _i * 8192), 16, 0, 0); } while (0)
#define PG8_LDA(dst, b, h) do { _Pragma("unroll") for (int m = 0; m < 4; ++m) _Pragma("unroll") for (int k = 0; k < 2; ++k) dst[m][k] = *(const LAS bf16x8*)(lds + PG8_SA(b, h) + aoff + m * 2048 + k * 1024); } while (0)
#define PG8_LDB(dst, b, h) do { _Pragma("unroll") for (int n = 0; n < 2; ++n) _Pragma("unroll") for (int k = 0; k < 2; ++k) dst[n][k] = *(const LAS bf16x8*)(lds + PG8_SB(b, h) + boff + n * 2048 + k * 1024); } while (0)
#define PG8_MMA(ai, bj, At, Bt) do { __builtin_amdgcn_s_setprio(1); _Pragma("unroll") for (int m = 0; m < 4; ++m) _Pragma("unroll") for (int n = 0; n < 2; ++n) _Pragma("unroll") for (int k = 0; k < 2; ++k) \
        acc[ai][bj][m][n] = __builtin_amdgcn_mfma_f32_16x16x32_bf16(Bt[n][k], At[m][k], acc[ai][bj][m][n], 0, 0, 0); __builtin_amdgcn_s_setprio(0); } while (0)
#define PG8_WAIT_V(n) asm volatile("s_waitcnt vmcnt(" #n ")" ::: "memory")
#define PG8_WAIT_L(n) asm volatile("s_waitcnt lgkmcnt(" #n ")" ::: "memory")
#define PG8_BAR __builtin_amdgcn_s_barrier()
#define PG8_SCHED __builtin_amdgcn_sched_barrier(0)
    Unit cur, nxt; int ui = 0;
    if (!S.next(0, cur)) return;
    f32x4 acc[2][2][4][2];
#pragma unroll
    for (int a = 0; a < 2; ++a)
#pragma unroll
        for (int b = 0; b < 2; ++b)
#pragma unroll
            for (int m = 0; m < 4; ++m)
#pragma unroll
                for (int n = 0; n < 2; ++n) acc[a][b][m][n] = (f32x4){0.f, 0.f, 0.f, 0.f};
    bf16x8 At[4][2], B0[2][2], B1[2][2];
    const char* cA = (const char*)g.A + (size_t)cur.pm * tstep + cur.ks * ksB; const char* cB = (const char*)g.Bt + (size_t)cur.pn * tstep + cur.ks * ksB;
    PG8_STAGE(PG8_SB(0, 0), cB, voffB); PG8_STAGE(PG8_SA(0, 0), cA, voffA); PG8_STAGE(PG8_SB(0, 1), cB + hstep, voffB); PG8_STAGE(PG8_SA(0, 1), cA + hstep, voffA);
    if (wr == 1) PG8_BAR;
    PG8_WAIT_V(4); PG8_BAR;
    PG8_STAGE(PG8_SB(1, 0), cB + kstep, voffB); PG8_STAGE(PG8_SA(1, 0), cA + kstep, voffA); PG8_STAGE(PG8_SB(1, 1), cB + hstep + kstep, voffB);
    PG8_WAIT_V(6); PG8_BAR;
    for (;;) {
        const bool has_next = S.next(ui + 1, nxt);
        const char* nA = has_next ? (const char*)g.A + (size_t)nxt.pm * tstep + nxt.ks * ksB : cA; const char* nB = has_next ? (const char*)g.Bt + (size_t)nxt.pn * tstep + nxt.ks * ksB : cB;
        for (int t = 0; t < nt; t += 2) {
            const bool last = (t == nt - 2);
            const char* a1 = cA + (size_t)(t + 1) * kstep;
            const char* a2 = last ? nA : cA + (size_t)(t + 2) * kstep; const char* b2 = last ? nB : cB + (size_t)(t + 2) * kstep;
            const char* a3 = a2 + kstep; const char* b3 = b2 + kstep;
            PG8_LDB(B0, 0, 0); PG8_SCHED; PG8_LDA(At, 0, 0); PG8_STAGE(PG8_SA(1, 1), a1 + hstep, voffA);
            PG8_WAIT_L(8); PG8_BAR; PG8_WAIT_L(0); PG8_MMA(0, 0, At, B0); PG8_BAR; PG8_SCHED;
            PG8_LDB(B1, 0, 1); PG8_STAGE(PG8_SB(0, 0), b2, voffB);
            PG8_BAR; PG8_WAIT_L(0); PG8_MMA(0, 1, At, B1); PG8_BAR;
            PG8_LDA(At, 0, 1); PG8_STAGE(PG8_SA(0, 0), a2, voffA);
            PG8_BAR; PG8_WAIT_L(0); PG8_MMA(1, 0, At, B0); PG8_BAR; PG8_SCHED;
            PG8_STAGE(PG8_SB(0, 1), b2 + hstep, voffB);
            PG8_WAIT_V(6); PG8_BAR; PG8_MMA(1, 1, At, B1); PG8_BAR;
            PG8_LDB(B0, 1, 0); PG8_SCHED; PG8_LDA(At, 1, 0); PG8_STAGE(PG8_SA(0, 1), a2 + hstep, voffA);
            PG8_WAIT_L(8); PG8_BAR; PG8_WAIT_L(0); PG8_MMA(0, 0, At, B0); PG8_BAR; PG8_SCHED;
            PG8_LDB(B1, 1, 1); PG8_STAGE(PG8_SB(1, 0), b3, voffB);
            PG8_BAR; PG8_WAIT_L(0); PG8_MMA(0, 1, At, B1); PG8_BAR;
            PG8_LDA(At, 1, 1); PG8_STAGE(PG8_SA(1, 0), a3, voffA);
            PG8_BAR; PG8_WAIT_L(0); PG8_MMA(1, 0, At, B0); PG8_BAR; PG8_SCHED;
            PG8_STAGE(PG8_SB(1, 1), b3 + hstep, voffB);
            PG8_WAIT_V(6); PG8_BAR; PG8_MMA(1, 1, At, B1); PG8_BAR;
        }
        E(acc, cur, wr, wc, fr, fq);
        if (!has_next) break;
#pragma unroll
        for (int a = 0; a < 2; ++a)
#pragma unroll
            for (int b = 0; b < 2; ++b)
#pragma unroll
                for (int m = 0; m < 4; ++m)
#pragma unroll
                    for (int n = 0; n < 2; ++n) acc[a][b][m][n] = (f32x4){0.f, 0.f, 0.f, 0.f};
        cur = nxt; cA = nA; cB = nB; ++ui;
    }
    PG8_WAIT_V(0);
    if (wr == 0) PG8_BAR;
    PG8_BAR;
#undef PG8_SA
#undef PG8_SB
#undef PG8_STAGE
#undef PG8_LDA
#undef PG8_LDB
#undef PG8_MMA
#undef PG8_WAIT_V
#undef PG8_WAIT_L
#undef PG8_BAR
#undef PG8_SCHED
}
}

struct EpiSwiglu {
    static constexpr bool PERM = true;
    bf16_t* H;
    __device__ __forceinline__ void operator()(const f32x4 (&acc)[2][2][4][2], const pg8::Unit& u, int wr, int wc, int fr, int fq) const {
        const int row0 = u.pm * 256 + wr * 64 + fr, col0 = u.pn * 128 + wc * 32 + 8 * fq;
#pragma unroll
        for (int ai = 0; ai < 2; ++ai)
#pragma unroll
            for (int m = 0; m < 4; ++m) {
                bf16_t* rowp = H + (size_t)(row0 + ai * 128 + m * 16) * DFF + col0;
                const f32x4 a0 = acc[ai][0][m][0], a1 = acc[ai][0][m][1], b0 = acc[ai][1][m][0], b1 = acc[ai][1][m][1];
                float v[8];
#pragma unroll
                for (int j = 0; j < 4; ++j) { v[j] = silu_f(a0[j]) * b0[j]; v[4 + j] = silu_f(a1[j]) * b1[j]; }
                u32x4 w; w.x = cvt_pk_bf16(v[0], v[1]); w.y = cvt_pk_bf16(v[2], v[3]); w.z = cvt_pk_bf16(v[4], v[5]); w.w = cvt_pk_bf16(v[6], v[7]);
                *(u32x4*)rowp = w;
            }
    }
};
struct EpiResid {
    static constexpr bool PERM = false;
    const float* resid_l; const float* resid_c; float* out_l; float* out_c; const float* mod; int gidx; float coef;
    __device__ __forceinline__ void operator()(const f32x4 (&acc)[2][2][4][2], const pg8::Unit& u, int wr, int wc, int fr, int fq) const {
        const bool isctx = u.pm >= 64; const int b = isctx ? 8 : (u.pm >> 3);
        const int row0 = (isctx ? (u.pm - 64) : u.pm) * 256 + wr * 64 + fr, col0 = u.pn * 256 + wc * 32 + 4 * fq;
        const float* gp = mod + (size_t)(b * NMOD + gidx) * DM + col0;
        const float* rb = isctx ? resid_c : resid_l; float* ob = isctx ? out_c : out_l;
        f32x4 gv[2][2];
#pragma unroll
        for (int bj = 0; bj < 2; ++bj)
#pragma unroll
            for (int n = 0; n < 2; ++n) gv[bj][n] = *(const f32x4*)(gp + bj * 128 + n * 16) * coef;
#pragma unroll
        for (int ai = 0; ai < 2; ++ai)
#pragma unroll
            for (int m = 0; m < 4; ++m) {
                const size_t o = (size_t)(row0 + ai * 128 + m * 16) * DM + col0;
#pragma unroll
                for (int bj = 0; bj < 2; ++bj)
#pragma unroll
                    for (int n = 0; n < 2; ++n) { const f32x4 r = *(const f32x4*)(rb + o + bj * 128 + n * 16); *(f32x4*)(ob + o + bj * 128 + n * 16) = r + gv[bj][n] * acc[ai][bj][m][n]; }
            }
    }
};
struct EpiPartial {
    static constexpr bool PERM = false;
    float* P;
    __device__ __forceinline__ void operator()(const f32x4 (&acc)[2][2][4][2], const pg8::Unit& u, int wr, int wc, int fr, int fq) const {
        const int row0 = (u.pm - 64) * 256 + wr * 64 + fr, col0 = u.pn * 256 + wc * 32 + 4 * fq;
        float* ob = P + (size_t)u.ks * NCTX * DM;
#pragma unroll
        for (int ai = 0; ai < 2; ++ai)
#pragma unroll
            for (int m = 0; m < 4; ++m) {
                const size_t o = (size_t)(row0 + ai * 128 + m * 16) * DM + col0;
#pragma unroll
                for (int bj = 0; bj < 2; ++bj)
#pragma unroll
                    for (int n = 0; n < 2; ++n) *(f32x4*)(ob + o + bj * 128 + n * 16) = acc[ai][bj][m][n];
            }
    }
};
__device__ __forceinline__ int win_src(int slot) {
    if (slot >= PW) return -1;
    if (slot >= 1280) return slot;
    const int head = slot >> 7, s = slot & 127, wc = s >> 5, n = (s >> 4) & 1, fq = (s >> 2) & 3, j = s & 3;
    return head * 128 + (wc >> 1) * 64 + n * 32 + (wc & 1) * 16 + fq * 4 + j;
}
struct EpiWin {
    static constexpr bool PERM = false;
    bf16_t *Q, *K, *V, *MQK, *MV, *MO; float* GT; const float *qg, *kg, *gb, *rope; LAS float* red;
    __device__ __forceinline__ void st4(bf16_t* p, f32x4 v) const { u32x2 w; w.x = cvt_pk_bf16(v[0], v[1]); w.y = cvt_pk_bf16(v[2], v[3]); *(u32x2*)p = w; }
    __device__ __forceinline__ void operator()(const f32x4 (&acc)[2][2][4][2], const pg8::Unit& u, int wr, int wc, int fr, int fq) const {
        asm volatile("" : "+v"(fr), "+v"(fq));
        const int pn = u.pn; const bool isctx = u.pm >= 64;
        const int rt0 = wr * 64 + fr;
        const int grow0 = u.pm * 256 + rt0;
        if (pn <= 4) {
            const float* gain = pn < 4 ? qg : kg;
            const int d1 = (wc >> 1) * 64 + (wc & 1) * 16 + 4 * fq;
            const f32x4 g1 = *(const f32x4*)(gain + d1), g2 = *(const f32x4*)(gain + d1 + 32);
#pragma unroll
            for (int ai = 0; ai < 2; ++ai)
#pragma unroll
                for (int m = 0; m < 4; ++m)
#pragma unroll
                    for (int bj = 0; bj < 2; ++bj) {
                        const f32x4 a = acc[ai][bj][m][0], c = acc[ai][bj][m][1];
                        float ss = a[0] * a[0] + a[1] * a[1] + a[2] * a[2] + a[3] * a[3] + c[0] * c[0] + c[1] * c[1] + c[2] * c[2] + c[3] * c[3];
                        ss += __shfl_xor(ss, 16); ss += __shfl_xor(ss, 32);
                        if (fq == 0) red[((rt0 + ai * 128 + m * 16) * 2 + bj) * 4 + wc] = ss;
                    }
            asm volatile("s_waitcnt lgkmcnt(0)" ::: "memory"); __builtin_amdgcn_s_barrier(); asm volatile("" ::: "memory");
#pragma unroll
            for (int ai = 0; ai < 2; ++ai)
#pragma unroll
                for (int m = 0; m < 4; ++m) {
                    const int rl = rt0 + ai * 128 + m * 16, gr = grow0 + ai * 128 + m * 16;
                    int bidx, tok; if (isctx) { bidx = (gr - NLAT) >> 8; tok = (gr - NLAT) & 255; } else { bidx = gr >> 11; tok = gr & 2047; }
                    f32x4 cs = (f32x4){1.f, 1.f, 1.f, 1.f}, sn = (f32x4){0.f, 0.f, 0.f, 0.f};
                    if (!isctx) { const int pos = (wc >> 1) ? (tok & 63) : (tok >> 6); const int ro = pos * 32 + (wc & 1) * 16 + 4 * fq; cs = *(const f32x4*)(rope + ro); sn = *(const f32x4*)(rope + 2048 + ro); }
#pragma unroll
                    for (int bj = 0; bj < 2; ++bj) {
                        const f32x4 pr = *(const LAS f32x4*)(red + (rl * 2 + bj) * 4);
                        const float rs = __builtin_amdgcn_rsqf((pr[0] + pr[1] + pr[2] + pr[3]) * (1.0f / 128.0f) + RMS_EPS);
                        const f32x4 x1 = acc[ai][bj][m][0] * rs * g1, x2 = acc[ai][bj][m][1] * rs * g2;
                        const f32x4 y1 = x1 * cs - x2 * sn, y2 = x2 * cs + x1 * sn;
                        if (pn < 4) { if (!isctx) { bf16_t* qp = Q + (size_t)gr * 1024 + (pn * 2 + bj) * 128 + d1; st4(qp, y1); st4(qp + 32, y2); } }
                        else { bf16_t* kp = K + ((size_t)bidx * SKV + (isctx ? tok : TCX + tok)) * 256 + bj * 128 + d1; st4(kp, y1); st4(kp + 32, y2); }
                    }
                    __builtin_amdgcn_sched_barrier(0);
                }
        } else {
            const int cc0 = wc * 32 + 4 * fq;
#pragma unroll
            for (int ai = 0; ai < 2; ++ai)
#pragma unroll
                for (int m = 0; m < 4; ++m) {
                    const int gr = grow0 + ai * 128 + m * 16;
                    int bidx, tok; if (isctx) { bidx = (gr - NLAT) >> 8; tok = (gr - NLAT) & 255; } else { bidx = gr >> 11; tok = gr & 2047; }
#pragma unroll
                    for (int bj = 0; bj < 2; ++bj)
#pragma unroll
                        for (int n = 0; n < 2; ++n) {
                            const int cc = cc0 + bj * 128 + n * 16; const f32x4 v = acc[ai][bj][m][n];
                            if (pn == 5) st4(V + ((size_t)bidx * SKV + (isctx ? tok : TCX + tok)) * 256 + cc, v);
                            else if (pn < 14) st4(MQK + (size_t)gr * 2048 + (pn - 6) * 256 + cc, v);
                            else if (pn < 18) st4(MV + (size_t)gr * 1024 + (pn - 14) * 256 + cc, v);
                            else if (pn < 22) { if (!isctx) { f32x4 s; s[0] = sigmoid_f(v[0]); s[1] = sigmoid_f(v[1]); s[2] = sigmoid_f(v[2]); s[3] = sigmoid_f(v[3]); st4(MO + (size_t)gr * 1024 + (pn - 18) * 256 + cc, s); } }
                            else if (cc < 32) {
                                f32x4 t = v + *(const f32x4*)(gb + cc);
                                if (fq >= 2) { t[0] = logsigmoid_f(t[0]); t[1] = logsigmoid_f(t[1]); t[2] = logsigmoid_f(t[2]); t[3] = logsigmoid_f(t[3]); }
                                *(f32x4*)(GT + (size_t)gr * 32 + cc) = t;
                            }
                        }
                    __builtin_amdgcn_sched_barrier(0);
                }
        }
    }
};

__device__ __forceinline__ int up_src(int slot) { const int pn = slot >> 8, r = slot & 255; return (r >> 7) * DFF + pn * 128 + (r & 127); }
template <int MAP  >
__device__ __forceinline__ void prep_tile(const float* __restrict__ W, int Nsrc, bf16_t* __restrict__ Bt, int Kdim, int nt, int kt, LAS float* tl) {
    const int tid = otid();
    { const int n4 = tid & 63, kk = tid >> 6; const int slot = nt * 256 + 4 * n4;
      const int src = MAP == 0 ? slot : (MAP == 1 ? up_src(slot) : win_src(slot));
      f32x4 v[8];
#pragma unroll
      for (int pss = 0; pss < 8; ++pss) { v[pss] = (f32x4){0.f, 0.f, 0.f, 0.f}; if (src >= 0) v[pss] = *(const f32x4*)(W + (size_t)(kt * 64 + kk + pss * 8) * Nsrc + src); }
#pragma unroll
      for (int pss = 0; pss < 8; ++pss) *(LAS f32x4*)(tl + (kk + pss * 8) * 260 + 4 * n4) = v[pss]; }
    __syncthreads();
    { const int n = tid >> 1, kh = (tid & 1) * 32;
#pragma unroll
      for (int q = 0; q < 4; ++q) { float v[8];
#pragma unroll
          for (int e = 0; e < 8; ++e) v[e] = tl[(kh + q * 8 + e) * 260 + n];
          u32x4 w; w.x = cvt_pk_bf16(v[0], v[1]); w.y = cvt_pk_bf16(v[2], v[3]); w.z = cvt_pk_bf16(v[4], v[5]); w.w = cvt_pk_bf16(v[6], v[7]);
          *(u32x4*)(Bt + (size_t)(nt * 256 + n) * Kdim + kt * 64 + kh + q * 8) = w; } }
    __syncthreads();
}
__device__ __forceinline__ void prep_weights(const Params& p, LAS unsigned char* lds, int grp, int idx, int n) {
    LAS float* tl = (LAS float*)lds;
    constexpr int T_UP = (NUP / 256) * (DM / 64), T_DN = (DM / 256) * (DFF / 64), T_IN = (PWP / 256) * (DM / 64), T_OUT = (DM / 256) * (DM / 64);
    const int tot = grp == 1 ? T_IN + T_OUT : T_UP + T_DN;
    for (int t = idx; t < tot; t += n) {
        int q = t;
        if (grp == 1) {
            if (q < T_IN) { prep_tile<2>(p.w_in, PW, (bf16_t*)(p.ws + WS_WIN), DM, q % (PWP / 256), q / (PWP / 256), tl); continue; } q -= T_IN;
            prep_tile<0>(p.w_out, DM, (bf16_t*)(p.ws + WS_WOUT), DM, q % (DM / 256), q / (DM / 256), tl);
        } else {
            const float* wu = grp == 0 ? p.w_up1 : p.w_up2; const float* wd = grp == 0 ? p.w_dn1 : p.w_dn2;
            if (q < T_UP) { prep_tile<1>(wu, NUP, (bf16_t*)(p.ws + (grp == 0 ? WS_WUP1 : WS_WUP2)), DM, q % (NUP / 256), q / (NUP / 256), tl); continue; } q -= T_UP;
            prep_tile<0>(wd, DM, (bf16_t*)(p.ws + (grp == 0 ? WS_WDN1 : WS_WDN2)), DFF, q % (DM / 256), q / (DM / 256), tl);
        }
    }
}
__device__ __forceinline__ void phase_prep(const Params& p, LAS unsigned char* lds, bool do_mod) {
    const int tid = otid(), G = gridDim.x, bid = blockIdx.x;
    float* mod = (float*)(p.ws + WS_MOD);
    LAS float* sv = (LAS float*)lds;
    LAS float* red = (LAS float*)(lds + 9 * 512 * 4);
    for (int item = bid; do_mod && item < 576; item += G) {
        const int cb = item >> 2, ks = item & 3;
        for (int i = tid; i < 9 * 512; i += 512) { const int b = i >> 9, k = i & 511; const float cv = b < 8 ? p.c[b * DM + ks * 512 + k] : p.c_ctx[ks * 512 + k]; sv[i] = silu_f(cv); }
        __syncthreads();
        const int c4 = tid & 31, kr = tid >> 5;
        f32x4 a[9];
#pragma unroll
        for (int b = 0; b < 9; ++b) a[b] = (f32x4){0.f, 0.f, 0.f, 0.f};
        for (int kk = kr; kk < 512; kk += 16) {
            const f32x4 w = *(const f32x4*)(p.w_mod + (size_t)(ks * 512 + kk) * MODW + cb * 128 + c4 * 4);
#pragma unroll
            for (int b = 0; b < 9; ++b) a[b] += w * sv[b * 512 + kk];
        }
#pragma unroll
        for (int b = 0; b < 9; ++b) *(LAS f32x4*)(red + (kr * 9 + b) * 128 + c4 * 4) = a[b];
        __syncthreads();
        for (int o = tid; o < 9 * 128; o += 512) { const int b = o >> 7, cidx = o & 127; float s = 0.f;
#pragma unroll
            for (int r = 0; r < 16; ++r) s += red[(r * 9 + b) * 128 + cidx];
            const int col = cb * 128 + cidx; if (ks == 0) s += p.b_mod[col];
            atomicAdd(mod + (size_t)b * MODW + col, s); }
        __syncthreads();
    }
    if (bid == G - 1) { float* rope = (float*)(p.ws + WS_ROPE);
        for (int i = tid; i < 2048; i += 512) { const int pos = i >> 5, idx = i & 31; const float inv = exp2f(-(float)idx * (13.287712379549449f / 32.0f)); const float ang = (float)pos * inv;
            rope[i] = cosf(ang); rope[2048 + i] = sinf(ang); } }
    prep_weights(p, lds, 0, bid, G);
}

template <int MODE>
__device__ __forceinline__ void phase_rows(const float* src_l, const float* src_c, int nrows, const float* g, const float* mod, int midx, bf16_t* outb, float* outf, const float* part,
                                           int rbase = -1, int rstride = 0) {
    const int wave = otid() >> 6, lane = otid() & 63;
    const int stride = rbase < 0 ? gridDim.x * 8 : rstride;
    for (int r0 = (rbase < 0 ? blockIdx.x * 8 : rbase) + wave; r0 < nrows; r0 += 2 * stride) {
        f32x4 v[2][8]; float ss[2] = {0.f, 0.f};
#pragma unroll
        for (int q = 0; q < 2; ++q) {
            const int r = r0 + q * stride;
            if (r < nrows) {
                const bool isctx = r >= NLAT; const float* xp = isctx ? src_c + (size_t)(r - NLAT) * DM : src_l + (size_t)r * DM;
#pragma unroll
                for (int k = 0; k < 8; ++k) v[q][k] = *(const f32x4*)(xp + (k * 64 + lane) * 4);
                if (isctx && part) {
                    const float* gt = mod + (size_t)(8 * NMOD + 2) * DM; const float* pp = part + (size_t)(r - NLAT) * DM;
#pragma unroll
                    for (int k = 0; k < 8; ++k) { const int c = (k * 64 + lane) * 4;
                        const f32x4 sum = (*(const f32x4*)(pp + c) + *(const f32x4*)(pp + (size_t)NCTX * DM + c)) + (*(const f32x4*)(pp + (size_t)2 * NCTX * DM + c) + *(const f32x4*)(pp + (size_t)3 * NCTX * DM + c));
                        v[q][k] += *(const f32x4*)(gt + c) * 0.5f * sum; }
                }
#pragma unroll
                for (int k = 0; k < 8; ++k) ss[q] += v[q][k][0] * v[q][k][0] + v[q][k][1] * v[q][k][1] + v[q][k][2] * v[q][k][2] + v[q][k][3] * v[q][k][3];
            }
        }
#pragma unroll
        for (int o = 32; o >= 1; o >>= 1) { ss[0] += __shfl_xor(ss[0], o); ss[1] += __shfl_xor(ss[1], o); }
#pragma unroll
        for (int q = 0; q < 2; ++q) {
            const int r = r0 + q * stride;
            if (r < nrows) {
                const float rs = rsqrtf(ss[q] * (1.0f / DM) + RMS_EPS);
                if (MODE == 0) {
                    const int b = r >= NLAT ? 8 : (r >> 11);
                    const float* sh = mod + (size_t)(b * NMOD + midx) * DM; const float* sc = sh + DM;
#pragma unroll
                    for (int k = 0; k < 8; ++k) { const int c = (k * 64 + lane) * 4; const f32x4 gg = *(const f32x4*)(g + c), s1 = *(const f32x4*)(sc + c), s0 = *(const f32x4*)(sh + c);
                        const f32x4 y = v[q][k] * rs * gg * (s1 + 1.0f) + s0; u32x2 w; w.x = cvt_pk_bf16(y[0], y[1]); w.y = cvt_pk_bf16(y[2], y[3]); *(u32x2*)(outb + (size_t)r * DM + c) = w; }
                } else {
#pragma unroll
                    for (int k = 0; k < 8; ++k) { const int c = (k * 64 + lane) * 4; const f32x4 gg = *(const f32x4*)(g + c); *(f32x4*)(outf + (size_t)r * DM + c) = v[q][k] * rs * gg; }
                }
            }
        }
    }
}

namespace att {
constexpr int D = 128, NW = 8, QBLK = 32, KVBLK = 64;
constexpr float SCALE = 0.088388347648318440f, THR = 8.f;
constexpr int LDQ = 1024, LDK = 256, LDO = 2048;
constexpr size_t SHM_V = KVBLK * D * 2, SHM_K = KVBLK * D * 2, SHM_ATTN = 2 * SHM_V + 2 * SHM_K + NW * 64 * 4;
#define KSWZ(row, colB) ((row) * 256 + ((colB) ^ (((row) & 7) << 4)))
#define SBAR() __builtin_amdgcn_sched_barrier(0)
__device__ __forceinline__ int crow(int r, int hi) { return (r & 3) + 8 * (r >> 2) + 4 * hi; }
__device__ __forceinline__ void partialSM(f32x16& p0, f32x16& p1, float& m_reg, float& mn, float& alpha) {
  constexpr float C = SCALE * 1.4426950408889634f;
  float pmax = p0[0]; for (int r = 1; r < 16; ++r) pmax = fmaxf(pmax, p0[r]); for (int r = 0; r < 16; ++r) pmax = fmaxf(pmax, p1[r]);
  { auto rr = __builtin_amdgcn_permlane32_swap(__float_as_uint(pmax), __float_as_uint(pmax), false, false);
    pmax = fmaxf(__uint_as_float(rr[0]), __uint_as_float(rr[1])); }
  if (__builtin_expect(__all(pmax - m_reg <= THR / SCALE), 1)) { mn = m_reg; alpha = 1.f; }
  else { mn = fmaxf(m_reg, pmax); alpha = __builtin_amdgcn_exp2f((m_reg - mn) * C); m_reg = mn; }
  float mnC = -mn * C;
  for (int r = 0; r < 16; ++r) p0[r] = fmaf(p0[r], C, mnC); for (int r = 0; r < 16; ++r) p1[r] = fmaf(p1[r], C, mnC);
  for (int r = 0; r < 16; ++r) p0[r] = __builtin_amdgcn_exp2f(p0[r]);
}
__device__ __forceinline__ void finishSM(f32x16& p0, f32x16& p1, float alpha, float& l_reg, bf16x8& pa0, bf16x8& pa1, bf16x8& pa2, bf16x8& pa3) {
  for (int r = 0; r < 16; ++r) p1[r] = __builtin_amdgcn_exp2f(p1[r]);
  float ps = 0; for (int r = 0; r < 16; ++r) ps += p0[r]; for (int r = 0; r < 16; ++r) ps += p1[r];
  { auto rr = __builtin_amdgcn_permlane32_swap(__float_as_uint(ps), __float_as_uint(ps), false, false);
    ps = __uint_as_float(rr[0]) + __uint_as_float(rr[1]); }
  l_reg = l_reg * alpha + ps;
#define PK4(P, BASE, OUT) do { unsigned a0 = cvt_pk_bf16(P[BASE + 0], P[BASE + 1]), a1 = cvt_pk_bf16(P[BASE + 2], P[BASE + 3]);   \
    unsigned b0 = cvt_pk_bf16(P[BASE + 4], P[BASE + 5]), b1 = cvt_pk_bf16(P[BASE + 6], P[BASE + 7]);                              \
    auto r0 = __builtin_amdgcn_permlane32_swap(a0, b0, false, false); auto r1 = __builtin_amdgcn_permlane32_swap(a1, b1, false, false); \
    u32x4 w = {r0[0], r1[0], r0[1], r1[1]}; OUT = *reinterpret_cast<bf16x8*>(&w); } while (0)
  PK4(p0, 0, pa0); PK4(p0, 8, pa1); PK4(p1, 0, pa2); PK4(p1, 8, pa3);
#undef PK4
}
__device__ __forceinline__ void qkt(f32x16& p0, f32x16& p1, const bf16_t* Ks, const bf16x8* qr, int r32, int hi) {
  p0 = f32x16{}; p1 = f32x16{};
  for (int d0 = 0; d0 < 8; ++d0) { int cb = (d0 * 16 + hi * 8) * 2;
    bf16x8 b0 = *reinterpret_cast<const bf16x8*>((const char*)Ks + KSWZ(r32, cb));
    bf16x8 b1 = *reinterpret_cast<const bf16x8*>((const char*)Ks + KSWZ(32 + r32, cb));
    p0 = __builtin_amdgcn_mfma_f32_32x32x16_bf16(b0, qr[d0], p0, 0, 0, 0);
    p1 = __builtin_amdgcn_mfma_f32_32x32x16_bf16(b1, qr[d0], p1, 0, 0, 0); }
}
__device__ __forceinline__ int v_st(int k, int c) { const int kk = (k & ~0xC) | ((k & 4) << 1) | ((k & 8) >> 1); return ((kk >> 3) * 4 + (c >> 5)) * 512 + ((kk & 7) * 32 + (c & 31)) * 2; }
__device__ __forceinline__ int v_rd_base(int lane) { return ((lane & 3) << 3) | (((lane >> 2) & 3) << 6) | (((lane >> 4) & 1) << 5) | (((lane >> 5) & 1) << 8); }
constexpr int v_rd_off(int d0, int ks, int half) { return d0 * 512 + ks * 4096 + half * 2048; }
template <int OFF> __device__ __forceinline__ s16x4 tr_read(int vb) {
  s16x4 r; asm volatile("ds_read_b64_tr_b16 %0, %1 offset:%2" : "=&v"(r) : "v"(vb), "i"(OFF) : "memory"); return r;
}
template <int D0> __device__ __forceinline__ void pv_one(f32x16& od, int vb, bf16x8 pa0, bf16x8 pa1, bf16x8 pa2, bf16x8 pa3) {
  const s16x4 l0 = tr_read<v_rd_off(D0, 0, 0)>(vb), h0 = tr_read<v_rd_off(D0, 0, 1)>(vb), l1 = tr_read<v_rd_off(D0, 1, 0)>(vb), h1 = tr_read<v_rd_off(D0, 1, 1)>(vb);
  const s16x4 l2 = tr_read<v_rd_off(D0, 2, 0)>(vb), h2 = tr_read<v_rd_off(D0, 2, 1)>(vb), l3 = tr_read<v_rd_off(D0, 3, 0)>(vb), h3 = tr_read<v_rd_off(D0, 3, 1)>(vb);
  asm volatile("s_waitcnt lgkmcnt(0)" ::: "memory"); SBAR();
#define PK(L, H) (bf16x8){L[0], L[1], L[2], L[3], H[0], H[1], H[2], H[3]}
  od = __builtin_amdgcn_mfma_f32_32x32x16_bf16(pa0, PK(l0, h0), od, 0, 0, 0);
  od = __builtin_amdgcn_mfma_f32_32x32x16_bf16(pa1, PK(l1, h1), od, 0, 0, 0);
  od = __builtin_amdgcn_mfma_f32_32x32x16_bf16(pa2, PK(l2, h2), od, 0, 0, 0);
  od = __builtin_amdgcn_mfma_f32_32x32x16_bf16(pa3, PK(l3, h3), od, 0, 0, 0);
#undef PK
}
__device__ __forceinline__ void pv_d0(f32x16* o, int vb, bf16x8 pa0, bf16x8 pa1, bf16x8 pa2, bf16x8 pa3) {
  pv_one<0>(o[0], vb, pa0, pa1, pa2, pa3); pv_one<1>(o[1], vb, pa0, pa1, pa2, pa3); pv_one<2>(o[2], vb, pa0, pa1, pa2, pa3); pv_one<3>(o[3], vb, pa0, pa1, pa2, pa3);
}
__device__ __forceinline__ void attn_dense_body(const bf16_t* __restrict__ Qb, const bf16_t* __restrict__ Kh, const bf16_t* __restrict__ Vh, bf16_t* __restrict__ Ob, int seq, char* lds) {
  const int tid = otid(), wid = tid >> 6, lane = tid & 63, r32 = lane & 31, hi = lane >> 5;
  bf16_t* V_lds = (bf16_t*)lds; bf16_t* K_lds = (bf16_t*)(lds + 2 * SHM_V);
  float* ws = (float*)(lds + 2 * SHM_V + 2 * SHM_K) + wid * 64; float* li_l = ws; float* al_l = ws + 32;
  float m_reg = -1e30f, l_reg = 0; f32x16 o[4] = {}; bf16x8 qr[8];
  const bf16_t* Qw = Qb + (long)(wid * QBLK + r32) * LDQ + hi * 8;
#pragma unroll
  for (int d0 = 0; d0 < 8; ++d0) qr[d0] = *reinterpret_cast<const bf16x8*>(Qw + d0 * 16);
  const int sr = tid >> 4, sc = (tid & 15) * 8, vst0 = v_st(sr, sc), vst1 = v_st(32 + sr, sc);
  const int vb0 = (int)(uintptr_t)V_lds + v_rd_base(lane);
  struct { bf16x8 vs0, vs1, ks0, ks1; } sr_[2];
#define SLOAD(i, k0) do { sr_[i].vs0 = *reinterpret_cast<const bf16x8*>(&Vh[(long)((k0) + sr) * LDK + sc]); sr_[i].vs1 = *reinterpret_cast<const bf16x8*>(&Vh[(long)((k0) + 32 + sr) * LDK + sc]); \
    sr_[i].ks0 = *reinterpret_cast<const bf16x8*>(&Kh[(long)((k0) + sr) * LDK + sc]); sr_[i].ks1 = *reinterpret_cast<const bf16x8*>(&Kh[(long)((k0) + 32 + sr) * LDK + sc]); } while (0)
#define SWRITE(b, i) do { *(bf16x8*)((char*)V_lds + (b) * SHM_V + vst0) = sr_[i].vs0;          \
    *(bf16x8*)((char*)V_lds + (b) * SHM_V + vst1) = sr_[i].vs1; int kc = sc * 2;               \
    *(bf16x8*)((char*)K_lds + (b) * SHM_K + KSWZ(sr, kc)) = sr_[i].ks0;                       \
    *(bf16x8*)((char*)K_lds + (b) * SHM_K + KSWZ(32 + sr, kc)) = sr_[i].ks1; } while (0)
#define SWAIT() asm volatile("s_waitcnt vmcnt(4)" ::: "memory")
#define RESC(a) do { if (__any((a) < 1.f)) { if (hi == 0) al_l[r32] = (a); asm volatile("s_waitcnt lgkmcnt(0)" ::: "memory"); \
    for (int d = 0; d < 4; ++d) for (int r = 0; r < 16; ++r) o[d][r] *= al_l[crow(r, hi)]; } } while (0)
  f32x16 pA0, pA1, pB0, pB1; float mnA, mnB, alA, alB; bf16x8 pa0, pa1, pa2, pa3; const int NT = seq / KVBLK;
  constexpr int SE = 0, SO = 1;
  SLOAD(SE, 0); asm volatile("s_waitcnt vmcnt(0)" ::: "memory"); SWRITE(0, SE); __syncthreads();
  qkt(pA0, pA1, K_lds, qr, r32, hi); partialSM(pA0, pA1, m_reg, mnA, alA);
  SLOAD(SO, KVBLK); if (2 < NT) SLOAD(SE, 2 * KVBLK);
  SWAIT(); SWRITE(1, SO); __syncthreads();
  for (int j = 1; j + 1 < NT; j += 2) {
    SBAR(); qkt(pB0, pB1, (bf16_t*)((char*)K_lds + SHM_K), qr, r32, hi);
    finishSM(pA0, pA1, alA, l_reg, pa0, pa1, pa2, pa3); SBAR();
    SLOAD(SO, (j + 2) * KVBLK); SBAR();
    pv_d0(o, vb0, pa0, pa1, pa2, pa3); partialSM(pB0, pB1, m_reg, mnB, alB);
    __syncthreads(); SWAIT(); SWRITE(0, SE);
    RESC(alB); __syncthreads();
    SBAR(); qkt(pA0, pA1, K_lds, qr, r32, hi);
    finishSM(pB0, pB1, alB, l_reg, pa0, pa1, pa2, pa3); SBAR();
    if (j + 3 < NT) SLOAD(SE, (j + 3) * KVBLK); SBAR();
    pv_d0(o, vb0 + (int)SHM_V, pa0, pa1, pa2, pa3); partialSM(pA0, pA1, m_reg, mnA, alA);
    __syncthreads(); SWAIT(); SWRITE(1, SO);
    RESC(alA); __syncthreads();
  }
  SBAR(); qkt(pB0, pB1, (bf16_t*)((char*)K_lds + SHM_K), qr, r32, hi);
  finishSM(pA0, pA1, alA, l_reg, pa0, pa1, pa2, pa3); SBAR();
  pv_d0(o, vb0, pa0, pa1, pa2, pa3); partialSM(pB0, pB1, m_reg, mnB, alB);
  __syncthreads(); RESC(alB);
  finishSM(pB0, pB1, alB, l_reg, pa0, pa1, pa2, pa3); SBAR();
  pv_d0(o, vb0 + (int)SHM_V, pa0, pa1, pa2, pa3);
  if (hi == 0) li_l[r32] = l_reg; asm volatile("s_waitcnt lgkmcnt(0)" ::: "memory");
  float rli[16];
#pragma unroll
  for (int r = 0; r < 16; ++r) rli[r] = __builtin_amdgcn_rcpf(li_l[crow(r, hi)]);
  bf16_t* Ow = Ob + (long)(wid * QBLK) * LDO;
#pragma unroll
  for (int r = 0; r < 16; ++r) { int orow = crow(r, hi);
    for (int d0 = 0; d0 < 4; ++d0) Ow[(long)orow * LDO + d0 * 32 + r32] = (bf16_t)(cvt_pk_bf16(o[d0][r] * rli[r], 0.f) & 0xffffu); }
#undef SLOAD
#undef SWRITE
#undef SWAIT
#undef RESC
}
}

__device__ __forceinline__ void attn_unit(const Params& p, unsigned char* lds_generic, int u) {
    const int qb = u & 7, g = (u >> 3) & 3, kvh = (u >> 5) & 1, b = u >> 6, hq = kvh * 4 + g;
    const bf16_t* Q = (const bf16_t*)(p.ws + WS_Q) + ((size_t)(b * TL + qb * 256)) * 1024 + hq * 128;
    const bf16_t* K = (const bf16_t*)(p.ws + WS_K) + (size_t)b * SKV * 256 + kvh * 128;
    const bf16_t* V = (const bf16_t*)(p.ws + WS_V) + (size_t)b * SKV * 256 + kvh * 128;
    bf16_t* O = (bf16_t*)(p.ws + WS_ATT) + ((size_t)(b * TL + qb * 256)) * 2048 + hq * 128;
    __syncthreads();
    att::attn_dense_body(Q, K, V, O, SKV, (char*)lds_generic);
}

__device__ __forceinline__ int jsw(int r, int c) { return r * 64 + ((((c) >> 3) ^ ((r ^ (r >> 3)) & 7)) << 3) + (c & 7); }
__device__ __forceinline__ f32x4 mfma16(bf16x8 a, bf16x8 b, f32x4 c) { return __builtin_amdgcn_mfma_f32_16x16x32_bf16(a, b, c, 0, 0, 0); }
__device__ __forceinline__ void mlstm_stream(const Params& p, LAS unsigned char* lds, int sid) {
    const int tid = otid(), w = __builtin_amdgcn_readfirstlane(tid >> 6), lane = tid & 63, fr = lane & 15, fq = lane >> 4;
    const int dir = sid & 1, h = (sid >> 1) & 7, b = sid >> 4;
    LAS bf16_t* Qs = (LAS bf16_t*)(lds + ML_QS); LAS bf16_t* Ks = (LAS bf16_t*)(lds + ML_KS); LAS bf16_t* KT = (LAS bf16_t*)(lds + ML_KT);
    LAS bf16_t* VT = (LAS bf16_t*)(lds + ML_VT); LAS bf16_t* Ps = (LAS bf16_t*)(lds + ML_PS); LAS bf16_t* C0 = (LAS bf16_t*)(lds + ML_C0);
    LAS float* sc_u = (LAS float*)(lds + ML_SC); LAS float* sc_pm = sc_u + 64; LAS float* sc_a = sc_u + 128; LAS float* sc_e = sc_u + 192;
    LAS float* cw = (LAS float*)(lds + ML_CW); LAS float* cbv = (LAS float*)(lds + ML_CB);
    const bf16_t* MQK = (const bf16_t*)(p.ws + WS_MQK); const bf16_t* MV = (const bf16_t*)(p.ws + WS_MV); const float* GT = (const float*)(p.ws + WS_GT);
    bf16_t* HO = (bf16_t*)(p.ws + WS_H) + (size_t)dir * NLAT * 1024;
    const int cg8 = (tid & 15) * 8, rg = tid >> 4, tl0 = 2 * rg;
    const int i0 = dir ? 63 - tl0 : tl0, i1 = dir ? i0 - 1 : i0 + 1, ie = dir ? i1 : i0;
    __syncthreads();
    for (int i = tid; i < 16 * 64; i += 512) VT[128 * 64 + i] = 0x3F80;
    for (int i = tid; i < 5 * 256; i += 512) { const int j = i >> 8, c = i & 255; cw[i] = p.conv_w[j * 2048 + (c < 128 ? h * 128 + c : 1024 + h * 128 + (c - 128))]; }
    for (int i = tid; i < 256; i += 512) cbv[i] = p.conv_b[i < 128 ? h * 128 + i : 1024 + h * 128 + (i - 128)];
    f32x4 C[9];
#pragma unroll
    for (int i = 0; i < 9; ++i) C[i] = (f32x4){0.f, 0.f, 0.f, 0.f};
    float m0 = 0.f;
    bf16x8 xq[6], xk[6], xv0, xv1; float g_ig, g_lf;
#define ML_CHUNK(ci_, lat_, chunk_, TS_, rbase_, t0_) const bool lat_ = (ci_) >= 4; const int chunk_ = lat_ ? (dir ? 35 - (ci_) : (ci_) - 4) : (dir ? 3 - (ci_) : (ci_)); \
        const int TS_ = lat_ ? TL : TCX; const size_t rbase_ = lat_ ? (size_t)b * TL : (size_t)NLAT + (size_t)b * TCX; const int t0_ = chunk_ * 64;
#define ML_LOAD(ci_) do { ML_CHUNK(ci_, l_, c_, ts_, rb_, t_) \
        { const int tl = dir ? 63 - lane : lane; const size_t row = rb_ + t_ + tl; g_ig = GT[row * 32 + dir * 16 + h]; g_lf = GT[row * 32 + dir * 16 + 8 + h]; } \
        _Pragma("unroll") for (int rr = 0; rr < 6; ++rr) { const int sl = t_ + tl0 - 2 + rr; xq[rr] = (bf16x8){0, 0, 0, 0, 0, 0, 0, 0}; xk[rr] = xq[rr]; \
            if (sl >= 0 && sl < ts_) { const bf16_t* src = MQK + (rb_ + sl) * 2048 + h * 128 + cg8; xq[rr] = *(const bf16x8*)src; xk[rr] = *(const bf16x8*)(src + 1024); } } \
        xv0 = *(const bf16x8*)(MV + (rb_ + t_ + tl0) * 1024 + h * 128 + cg8); xv1 = *(const bf16x8*)(MV + (rb_ + t_ + tl0 + 1) * 1024 + h * 128 + cg8); } while (0)
    ML_LOAD(0);
    __syncthreads();
    for (int ci = 0; ci < 36; ++ci) {
        ML_CHUNK(ci, lat, chunk, TS, rbase, t0)
        (void)TS;
        float wgt, decay, m0n;
        {
            float bc = g_lf;
#pragma unroll
            for (int d = 1; d < 64; d <<= 1) { const float v = __shfl_up(bc, d); if (lane >= d) bc += v; }
            const float uu = g_ig - bc; float px = uu;
#pragma unroll
            for (int d = 1; d < 64; d <<= 1) { const float v = __shfl_up(px, d); if (lane >= d) px = fmaxf(px, v); }
            const float pm = fmaxf(m0, px);
            const float bL = __shfl(bc, 63), pmL = __shfl(pm, 63);
            wgt = __expf(uu - pmL); decay = __expf(m0 - pmL); m0n = bL + pmL;
            if (w == 0) { sc_u[lane] = uu; sc_pm[lane] = pm; sc_a[lane] = __expf(m0 - pm); sc_e[lane] = __expf(-bc - pm); }
        }
        {
            const float w0 = __shfl(wgt, i0), w1 = __shfl(wgt, i1);
#pragma unroll
            for (int qk = 0; qk < 2; ++qk) {
                float y0[8], y1[8];
#pragma unroll
                for (int e = 0; e < 8; ++e) { y0[e] = cbv[qk * 128 + cg8 + e]; y1[e] = y0[e]; }
#pragma unroll
                for (int j = 0; j < 5; ++j) {
                    const f32x4 wa = *(const LAS f32x4*)(cw + j * 256 + qk * 128 + cg8), wb = *(const LAS f32x4*)(cw + j * 256 + qk * 128 + cg8 + 4);
#pragma unroll
                    for (int e = 0; e < 8; ++e) { const float wv = e < 4 ? wa[e] : wb[e - 4]; const bf16x8 xa = qk ? xk[j] : xq[j], xb = qk ? xk[j + 1] : xq[j + 1];
                        y0[e] += wv * bf2f((unsigned short)xa[e]); y1[e] += wv * bf2f((unsigned short)xb[e]); }
                }
                const float ksc = qk ? 0.08838834764831845f : 1.0f;
#pragma unroll
                for (int e = 0; e < 8; ++e) { y0[e] = silu_f(y0[e]) * ksc; y1[e] = silu_f(y1[e]) * ksc; }
                LAS bf16_t* dst = qk ? Ks : Qs;
                u32x4 p0, p1; p0.x = cvt_pk_bf16(y0[0], y0[1]); p0.y = cvt_pk_bf16(y0[2], y0[3]); p0.z = cvt_pk_bf16(y0[4], y0[5]); p0.w = cvt_pk_bf16(y0[6], y0[7]);
                p1.x = cvt_pk_bf16(y1[0], y1[1]); p1.y = cvt_pk_bf16(y1[2], y1[3]); p1.z = cvt_pk_bf16(y1[4], y1[5]); p1.w = cvt_pk_bf16(y1[6], y1[7]);
                *(LAS u32x4*)(dst + i0 * QS_LD + cg8) = p0; *(LAS u32x4*)(dst + i1 * QS_LD + cg8) = p1;
                if (qk) {
#pragma unroll
                    for (int e = 0; e < 8; ++e) { const float a0 = y0[e] * w0, a1 = y1[e] * w1; *(LAS unsigned*)(KT + jsw(cg8 + e, ie)) = dir ? cvt_pk_bf16(a1, a0) : cvt_pk_bf16(a0, a1); }
                }
            }
#pragma unroll
            for (int e = 0; e < 8; ++e) { const unsigned lo = (unsigned short)(dir ? xv1[e] : xv0[e]), hi = (unsigned short)(dir ? xv0[e] : xv1[e]); *(LAS unsigned*)(VT + jsw(cg8 + e, ie)) = lo | (hi << 16); }
        }
        if (ci + 1 < 36) ML_LOAD(ci + 1);
        __syncthreads();
        if (lat) {
            const int it = w >> 1;
#pragma unroll
            for (int jj = 0; jj < 2; ++jj) {
                const int jt = (w & 1) * 2 + jj;
                f32x4 s = (f32x4){0.f, 0.f, 0.f, 0.f};
                if (jt <= it) {
#pragma unroll
                    for (int ks = 0; ks < 4; ++ks) { const bf16x8 a = *(const LAS bf16x8*)(Ks + (jt * 16 + fr) * QS_LD + ks * 32 + fq * 8), bb = *(const LAS bf16x8*)(Qs + (it * 16 + fr) * QS_LD + ks * 32 + fq * 8); s = mfma16(a, bb, s); }
                    const int i = it * 16 + fr, j0 = jt * 16 + 4 * fq; const float pmi = sc_pm[i]; const f32x4 uj = *(const LAS f32x4*)(sc_u + j0);
#pragma unroll
                    for (int r = 0; r < 4; ++r) s[r] = (j0 + r <= i) ? s[r] * __expf(uj[r] - pmi) : 0.f;
                }
                u32x2 pw; pw.x = cvt_pk_bf16(s[0], s[1]); pw.y = cvt_pk_bf16(s[2], s[3]);
                *(LAS u32x2*)(Ps + (it * 16 + fr) * JS_LD + jt * 16 + 4 * fq) = pw;
            }
#pragma unroll
            for (int nt = 0; nt < 9; ++nt) { u32x2 cwd; cwd.x = cvt_pk_bf16(C[nt][0], C[nt][1]); cwd.y = cvt_pk_bf16(C[nt][2], C[nt][3]); *(LAS u32x2*)(C0 + (nt * 16 + fr) * QS_LD + w * 16 + 4 * fq) = cwd; }
        }
        {
            const bf16x8 a0 = *(const LAS bf16x8*)(KT + jsw(w * 16 + fr, fq * 8)), a1 = *(const LAS bf16x8*)(KT + jsw(w * 16 + fr, 32 + fq * 8));
#pragma unroll
            for (int nt = 0; nt < 9; ++nt) { C[nt] *= decay;
                C[nt] = mfma16(a0, *(const LAS bf16x8*)(VT + jsw(nt * 16 + fr, fq * 8)), C[nt]); C[nt] = mfma16(a1, *(const LAS bf16x8*)(VT + jsw(nt * 16 + fr, 32 + fq * 8)), C[nt]); }
        }
        __syncthreads();
        if (lat) {
            const int it = w >> 1, dvh = w & 1, i = it * 16 + fr;
            f32x4 ac[5];
#pragma unroll
            for (int t = 0; t < 5; ++t) ac[t] = (f32x4){0.f, 0.f, 0.f, 0.f};
#pragma unroll
            for (int ks = 0; ks < 4; ++ks) { const bf16x8 bq = *(const LAS bf16x8*)(Qs + i * QS_LD + ks * 32 + fq * 8);
#pragma unroll
                for (int t = 0; t < 5; ++t) { const int row = (t < 4 ? (dvh * 4 + t) * 16 : 128) + fr; ac[t] = mfma16(*(const LAS bf16x8*)(C0 + row * QS_LD + ks * 32 + fq * 8), bq, ac[t]); } }
            const float ai = sc_a[i];
#pragma unroll
            for (int t = 0; t < 5; ++t) ac[t] *= ai;
#pragma unroll
            for (int ks = 0; ks < 2; ++ks) { const bf16x8 bp = *(const LAS bf16x8*)(Ps + i * JS_LD + ks * 32 + fq * 8);
#pragma unroll
                for (int t = 0; t < 5; ++t) { const int row = (t < 4 ? (dvh * 4 + t) * 16 : 128) + fr; ac[t] = mfma16(*(const LAS bf16x8*)(VT + jsw(row, ks * 32 + fq * 8)), bp, ac[t]); } }
            const float den = fmaxf(fabsf(ac[4][0]), sc_e[i]); const float rd = 1.0f / den;
            const size_t row = rbase + t0 + (dir ? 63 - i : i);
#pragma unroll
            for (int t = 0; t < 4; ++t) { u32x2 hw; hw.x = cvt_pk_bf16(ac[t][0] * rd, ac[t][1] * rd); hw.y = cvt_pk_bf16(ac[t][2] * rd, ac[t][3] * rd);
                *(u32x2*)(HO + row * 1024 + h * 128 + (dvh * 4 + t) * 16 + 4 * fq) = hw; }
        }
        m0 = m0n;
        __syncthreads();
    }
#undef ML_LOAD
#undef ML_CHUNK
}

__device__ __forceinline__ void phase_combine(const Params& p) {
    const bf16_t* HF = (const bf16_t*)(p.ws + WS_H); const bf16_t* HB = HF + (size_t)NLAT * 1024; const bf16_t* MO = (const bf16_t*)(p.ws + WS_MO);
    bf16_t* AT = (bf16_t*)(p.ws + WS_ATT);
    const int tid = otid(), c8 = (tid & 127) * 8, rq = tid >> 7;
    f32x4 g0 = *(const f32x4*)(p.m_gain + c8), g1 = *(const f32x4*)(p.m_gain + c8 + 4);
    for (int r = blockIdx.x * 4 + rq; r < NLAT; r += gridDim.x * 4) {
        const bf16x8 a = *(const bf16x8*)(HF + (size_t)r * 1024 + c8), bb = *(const bf16x8*)(HB + (size_t)r * 1024 + c8), mo = *(const bf16x8*)(MO + (size_t)r * 1024 + c8);
        float x[8], ss = 0.f;
#pragma unroll
        for (int e = 0; e < 8; ++e) { x[e] = bf2f((unsigned short)a[e]) + bf2f((unsigned short)bb[e]); ss += x[e] * x[e]; }
        ss += __shfl_xor(ss, 1); ss += __shfl_xor(ss, 2); ss += __shfl_xor(ss, 4); ss += __shfl_xor(ss, 8);
        const float rs = rsqrtf(ss * (1.0f / 128.0f) + RMS_EPS);
        float y[8];
#pragma unroll
        for (int e = 0; e < 8; ++e) y[e] = x[e] * rs * (e < 4 ? g0[e] : g1[e - 4]) * bf2f((unsigned short)mo[e]);
        u32x4 wv; wv.x = cvt_pk_bf16(y[0], y[1]); wv.y = cvt_pk_bf16(y[2], y[3]); wv.z = cvt_pk_bf16(y[4], y[5]); wv.w = cvt_pk_bf16(y[6], y[7]);
        *(u32x4*)(AT + (size_t)r * 2048 + 1024 + c8) = wv;
    }
}

#define XB_TMO      128
#define XB_XCNT(j)  (256  + 64 * (j))
#define XB_XSUB(j)  (1280 + 64 * (j))
#define XB_XGEN(j)  (2304 + 64 * (j))
#define XB_TOP      3328
#define XB_TOPGEN   3392
#define XCD_BAR_WORDS 3456
#define XB_SPIN_CAP (1u << 22)
__device__ __forceinline__ unsigned xb_ld(unsigned* p)              { return __hip_atomic_load(p, __ATOMIC_RELAXED, __HIP_MEMORY_SCOPE_AGENT); }
__device__ __forceinline__ unsigned xb_add(unsigned* p, unsigned v) { return __hip_atomic_fetch_add(p, v, __ATOMIC_RELAXED, __HIP_MEMORY_SCOPE_AGENT); }
__device__ __forceinline__ unsigned xb_xcc_id() { return (unsigned)__builtin_amdgcn_s_getreg((3 << 11) | 20) & 0xFu; }
#define XB_SPIN(cond, bar) do { unsigned _sp = 0; while (cond) { __builtin_amdgcn_s_sleep(1); \
    if ((++_sp & 255u) == 0u) { if (xb_ld(&(bar)[XB_TMO])) break; if (_sp > XB_SPIN_CAP) { atomicAdd(&(bar)[XB_TMO], 1u); break; } } } } while (0)
struct XcdBarrier { unsigned* bar; unsigned x; volatile LAS unsigned* st; };
__device__ __forceinline__ XcdBarrier xcd_barrier_post(unsigned* bar, volatile LAS unsigned* st) {
    XcdBarrier b; b.bar = bar; b.x = xb_xcc_id(); b.st = st;
    if (threadIdx.x == 0) (void)xb_add(&bar[XB_XCNT(b.x)], 1u);
    return b;
}
__device__ __forceinline__ void xcd_barrier_complete(unsigned* bar, unsigned x, unsigned& nloc, unsigned& nx) {
    const unsigned G = gridDim.x * gridDim.y * gridDim.z;
    unsigned sum, cnt, mine, sp = 0u;
    for (;;) {
        sum = 0u; cnt = 0u; mine = 0u;
#pragma unroll
        for (unsigned j = 0; j < 16; ++j) { const unsigned c = xb_ld(&bar[XB_XCNT(j)]); sum += c; cnt += (c > 0u) ? 1u : 0u; mine = (j == x) ? c : mine; }
        if (sum == G) break;
        __builtin_amdgcn_s_sleep(1);
        if ((++sp & 255u) == 0u) { if (xb_ld(&bar[XB_TMO])) break; if (sp > XB_SPIN_CAP) { atomicAdd(&bar[XB_TMO], 1u); break; } }
    }
    nloc = mine > 0u ? mine : 1u; nx = cnt > 0u ? cnt : 1u;
}
__device__ __forceinline__ void xcd_barrier(const XcdBarrier& b) {
    asm volatile("s_waitcnt vmcnt(0)" ::: "memory");
    __syncthreads();
    if (threadIdx.x == 0) {
        unsigned* bar = b.bar;
        __builtin_amdgcn_s_waitcnt(0);
        unsigned nloc = b.st[0], nx = b.st[1];
        if (nloc == 0u) { xcd_barrier_complete(bar, b.x, nloc, nx); b.st[0] = nloc; b.st[1] = nx; }
        const unsigned old = xb_add(&bar[XB_XSUB(b.x)], 1u);
        const unsigned gen = old / nloc;
        if (old + 1u == (gen + 1u) * nloc) {
            __builtin_amdgcn_fence(__ATOMIC_RELEASE, "agent");
            asm volatile("s_waitcnt vmcnt(0)" ::: "memory");
            const unsigned og = xb_add(&bar[XB_TOP], 1u);
            const unsigned tg = og / nx;
            if (og + 1u == (tg + 1u) * nx) xb_add(&bar[XB_TOPGEN], 1u);
            else XB_SPIN(xb_ld(&bar[XB_TOPGEN]) == tg, bar);
            __builtin_amdgcn_fence(__ATOMIC_ACQUIRE, "agent");
            xb_add(&bar[XB_XGEN(b.x)], 1u);
            asm volatile("s_waitcnt vmcnt(0)" ::: "memory");
        } else {
            XB_SPIN(xb_ld(&bar[XB_XGEN(b.x)]) == gen, bar);
            __builtin_amdgcn_fence(__ATOMIC_ACQUIRE, "agent");
            asm volatile("s_waitcnt vmcnt(0)" ::: "memory");
        }
    }
    __syncthreads();
}

__device__ __forceinline__ void panel_handoff(unsigned* cnt, unsigned need) {
    asm volatile("s_waitcnt vmcnt(0)" ::: "memory"); __syncthreads();
    if (threadIdx.x == 0) {
        __builtin_amdgcn_fence(__ATOMIC_RELEASE, "agent"); asm volatile("s_waitcnt vmcnt(0)" ::: "memory");
        (void)__hip_atomic_fetch_add(cnt, 1u, __ATOMIC_RELAXED, __HIP_MEMORY_SCOPE_AGENT);
        unsigned sp = 0u; while (__hip_atomic_load(cnt, __ATOMIC_RELAXED, __HIP_MEMORY_SCOPE_AGENT) < need) { __builtin_amdgcn_s_sleep(1); if (++sp > (1u << 22)) break; }
        __builtin_amdgcn_fence(__ATOMIC_ACQUIRE, "agent"); asm volatile("s_waitcnt vmcnt(0)" ::: "memory");
    }
    __syncthreads();
}

__global__ void __launch_bounds__(512, 2) fwd_megakernel(Params p0) {
    extern __shared__ __attribute__((aligned(16))) unsigned char lds_raw[];
    LAS unsigned char* lds = (LAS unsigned char*)lds_raw;
    if (threadIdx.x < 16) ((LAS unsigned*)(lds + LDS_CTL))[threadIdx.x] = 0u;
    __syncthreads();
    XcdBarrier xbar; xbar.bar = (unsigned*)(p0.ws + WS_BAR); xbar.x = 0; xbar.st = (volatile LAS unsigned*)(lds + LDS_CTL + 16);
    if (p0.ph_hi - p0.ph_lo > 1) xbar = xcd_barrier_post((unsigned*)(p0.ws + WS_BAR), (volatile LAS unsigned*)(lds + LDS_CTL + 16));
    for (int ph = p0.ph_lo; ph < p0.ph_hi; ++ph) {
#if defined(__HIP_DEVICE_COMPILE__)
        const __attribute__((address_space(4))) Params* pp = (const __attribute__((address_space(4))) Params*)__builtin_amdgcn_kernarg_segment_ptr();
        asm volatile("" : "+s"(pp));
        const Params p = *pp;
        int G = gridDim.x, bid = blockIdx.x; asm volatile("" : "+s"(G), "+s"(bid));
#else
        const Params p = p0; int G = 0, bid = 0;
#endif
        unsigned char* ws = p.ws;
        float* mod = (float*)(ws + WS_MOD);
        const bool fuse = (G == 256) && (p0.ph_hi - p0.ph_lo > 1);
        if (fuse && (ph == 9 || ph == 12)) continue;
        for (int rep = 0; rep < (((DUPMASK >> ph) & 1) ? 2 : 1); ++rep)
        if (HAS(0) && ph == 0) {
            phase_prep(p, lds, rep == 0);
        } else if (HAS(1) && (ph == 1 || ph == 4 || ph == 9)) {
            const float* sl = ph == 1 ? p.x : p.out; const float* scx = p.ctx;
            const int nrows = ph == 9 ? NLAT : MR, midx = ph == 1 ? 0 : (ph == 4 ? 3 : 6);
            if (fuse && ph == 4)
                phase_rows<0>(sl, scx, MR, p.g_norm + DM, mod, 3, (bf16_t*)(ws + WS_H), nullptr, (const float*)(ws + WS_PART), NLAT + bid * 8, G * 8);
            else
            phase_rows<0>(sl, scx, nrows, p.g_norm + (ph == 1 ? 0 : (ph == 4 ? 1 : 2)) * DM, mod, midx, (bf16_t*)(ws + WS_H), nullptr, ph == 4 ? (const float*)(ws + WS_PART) : nullptr);
        } else if (HAS(2) && (ph == 2 || ph == 10)) {
            pg8::Gemm g{(const bf16_t*)(ws + WS_H), (const bf16_t*)(ws + (ph == 2 ? WS_WUP1 : WS_WUP2)), ph == 2 ? MR : NLAT, NUP, DM, DM};
            pg8::StaticOrder S; S.init(g.M, g.N, G, bid);
            EpiSwiglu E{(bf16_t*)(ws + WS_HID)};
            pg8::gemm_phase<EpiSwiglu>(lds, g, S, E);
            if (ph == 2) { const int busy = S.nwg % G; if (busy != 0 && bid >= busy) prep_weights(p, lds, 1, bid - busy, G - busy); else if (busy == 0) prep_weights(p, lds, 1, bid, G); }
        } else if (HAS(3) && (ph == 3 || ph == 8 || ph == 11)) {
            pg8::Gemm g;
            if (ph == 3) g = pg8::Gemm{(const bf16_t*)(ws + WS_HID), (const bf16_t*)(ws + WS_WDN1), NLAT, DM, DFF, DFF};
            else if (ph == 8) g = pg8::Gemm{(const bf16_t*)(ws + WS_ATT), (const bf16_t*)(ws + WS_WOUT), NLAT, DM, DM, DM};
            else g = pg8::Gemm{(const bf16_t*)(ws + WS_HID), (const bf16_t*)(ws + WS_WDN2), NLAT, DM, DFF, DFF};
            pg8::StaticOrder S; S.init(g.M, g.N, G, bid);
            EpiResid E{ph == 3 ? p.x : p.out, p.ctx, p.out, nullptr, mod, ph == 3 ? 2 : (ph == 8 ? 5 : 8), ph == 8 ? 1.0f : 0.5f};
            pg8::gemm_phase<EpiResid>(lds, g, S, E);
            if (fuse) {
                pg8::Unit u0; S.next(0, u0);
                unsigned* cnt = (unsigned*)(ws + WS_PCNT) + ((ph == 3 ? 0 : (ph == 8 ? 1 : 2)) * 64 + u0.pm) * 64;
                panel_handoff(cnt, 4u);
                const int r0 = u0.pm * 256 + (u0.pn & 3) * 64;
                if (ph == 11) phase_rows<1>(p.out, nullptr, r0 + 64, p.g_final, nullptr, 0, nullptr, p.out, nullptr, r0, 8);
                else phase_rows<0>(p.out, nullptr, r0 + 64, p.g_norm + (ph == 3 ? 1 : 2) * DM, mod, ph == 3 ? 3 : 6, (bf16_t*)(ws + WS_H), nullptr, nullptr, r0, 8);
            }
            if (ph == 3) {
                pg8::Gemm g2{(const bf16_t*)(ws + WS_HID), (const bf16_t*)(ws + WS_WDN1), NCTX, DM, DFF / 4, DFF};
                pg8::StaticOrder S2; S2.init(NCTX, DM, G, bid, 64, 4);
                EpiPartial E2{(float*)(ws + WS_PART)};
                pg8::gemm_phase<EpiPartial>(lds, g2, S2, E2);
            }
        } else if (HAS(5) && ph == 5) {
            pg8::Gemm g{(const bf16_t*)(ws + WS_H), (const bf16_t*)(ws + WS_WIN), MR, PWP, DM, DM};
            pg8::StaticOrder S; S.init(g.M, g.N, G, bid);
            EpiWin E{(bf16_t*)(ws + WS_Q), (bf16_t*)(ws + WS_K), (bf16_t*)(ws + WS_V), (bf16_t*)(ws + WS_MQK), (bf16_t*)(ws + WS_MV), (bf16_t*)(ws + WS_MO), (float*)(ws + WS_GT),
                     p.q_gain, p.k_gain, p.gate_b, (const float*)(ws + WS_ROPE), (LAS float*)(lds + LDS_RED)};
            pg8::gemm_phase<EpiWin>(lds, g, S, E);
            { const int busy = S.nwg % G; if (busy != 0 && bid >= busy) prep_weights(p, lds, 2, bid - busy, G - busy); else if (busy == 0) prep_weights(p, lds, 2, bid, G); }
        } else if (HAS(6) && ph == 6) {
#if !defined(NO_MLSTM)
            for (int s = bid; s < 128 && rep == 0; s += G) mlstm_stream(p, lds, s);
#endif
#if !defined(NO_ATTN)
            {
                int* ctr = (int*)(ws + WS_CTR) + rep * 8;
                for (int qi = 0; qi < 8; ++qi) {
                    const int bq = (bid + qi) & 7;
                    for (;;) {
                        __syncthreads();
                        if (otid() == 0) { int v = __hip_atomic_load(ctr + bq, __ATOMIC_RELAXED, __HIP_MEMORY_SCOPE_AGENT); if (v < 64) v = atomicAdd(ctr + bq, 1); *(LAS int*)(lds + LDS_CTL) = v; }
                        __syncthreads();
                        const int u = *(LAS int*)(lds + LDS_CTL);
                        if (u >= 64) break;
                        attn_unit(p, lds_raw, bq * 64 + u);
                    }
                }
            }
#endif
        } else if (HAS(7) && ph == 7) {
            phase_combine(p);
        } else if (HAS(12) && ph == 12) {
            phase_rows<1>(p.out, nullptr, NLAT, p.g_final, nullptr, 0, nullptr, p.out, nullptr);
        }
        if (ph + 1 < p0.ph_hi && !(fuse && ph == 11)) {
            if (p0.ph_hi > 1000) cg::this_grid().sync(); else xcd_barrier(xbar);
        }
    }
}

extern "C" void kernel_launch(void* const* d_in, const int* in_sizes, int n_in, void* d_out, int out_size, void* d_ws, size_t ws_size, hipStream_t stream) {
    static int grid = 0;
    if (grid == 0) {
        if (n_in != 20 || out_size != NLAT * DM || ws_size < WS_END) { fprintf(stderr, "kernel_launch: unexpected shapes (n_in %d out %d ws %zu need %zu)\n", n_in, out_size, ws_size, (size_t)WS_END); grid = -1; return; }
        int dev = 0, cus = 0, per_cu = 0;
        hipGetDevice(&dev); hipDeviceGetAttribute(&cus, hipDeviceAttributeMultiprocessorCount, dev);
        if (hipFuncSetAttribute((const void*)fwd_megakernel, hipFuncAttributeMaxDynamicSharedMemorySize, LDS_BYTES) != hipSuccess) { fprintf(stderr, "kernel_launch: hipFuncSetAttribute failed\n"); grid = -1; return; }
        hipOccupancyMaxActiveBlocksPerMultiprocessor(&per_cu, (const void*)fwd_megakernel, 512, LDS_BYTES);
        if (per_cu < 1) { fprintf(stderr, "kernel_launch: occupancy query says %d blocks per CU\n", per_cu); per_cu = 1; }
        (void)hipGetLastError();
        grid = cus * 1;
    }
    if (grid < 0) return;
    (void)hipMemsetAsync((char*)d_ws + WS_MOD, 0, (size_t)(WS_ROPE - WS_MOD), stream);
    Params p{};
    p.x = (const float*)d_in[0]; p.c = (const float*)d_in[1]; p.ctx = (const float*)d_in[2]; p.c_ctx = (const float*)d_in[3]; p.w_mod = (const float*)d_in[4]; p.b_mod = (const float*)d_in[5];
    p.g_norm = (const float*)d_in[6]; p.w_up1 = (const float*)d_in[7]; p.w_dn1 = (const float*)d_in[8]; p.w_up2 = (const float*)d_in[9]; p.w_dn2 = (const float*)d_in[10]; p.w_in = (const float*)d_in[11];
    p.q_gain = (const float*)d_in[12]; p.k_gain = (const float*)d_in[13]; p.conv_w = (const float*)d_in[14]; p.conv_b = (const float*)d_in[15]; p.gate_b = (const float*)d_in[16]; p.m_gain = (const float*)d_in[17];
    p.w_out = (const float*)d_in[18]; p.g_final = (const float*)d_in[19]; p.out = (float*)d_out; p.ws = (unsigned char*)d_ws;
#if MK_MULTI
    for (int ph = 0; ph < NPH; ++ph) { p.ph_lo = ph; p.ph_hi = ph + 1; hipLaunchKernelGGL(fwd_megakernel, dim3(grid), dim3(512), LDS_BYTES, stream, p); }
#else
    p.ph_lo = 0; p.ph_hi = NPH;
    void* args[] = {&p};
    hipError_t e = hipLaunchCooperativeKernel((const void*)fwd_megakernel, dim3(grid), dim3(512), args, LDS_BYTES, stream);
    if (e != hipSuccess) fprintf(stderr, "cooperative launch failed: %s (grid %d)\n", hipGetErrorString(e), grid);
#endif
}
```

```cpp
#include <hip/hip_runtime.h>
#include <hip/hip_cooperative_groups.h>
#include <cstdio>
#include <cstdint>
namespace cg = cooperative_groups;

#define LAS __attribute__((address_space(3)))
typedef unsigned short bf16_t;
typedef short bf16x8 __attribute__((ext_vector_type(8)));
typedef short s16x4 __attribute__((ext_vector_type(4)));
typedef float f32x4 __attribute__((ext_vector_type(4)));
typedef float f32x16 __attribute__((ext_vector_type(16)));
typedef unsigned u32x4 __attribute__((ext_vector_type(4)));
typedef unsigned u32x2 __attribute__((ext_vector_type(2)));

#ifndef PHMASK
#define PHMASK 0x1fff
#endif
#define HAS(k) ((PHMASK >> (k)) & 1)
#ifndef DUPMASK
#define DUPMASK 0
#endif
#ifndef MK_MULTI
#define MK_MULTI 0
#endif

constexpr int DM = 2048, NB = 8, TL = 2048, TCX = 256, NLAT = NB * TL, NCTX = NB * TCX, MR = NLAT + NCTX;
constexpr int DFF = 5632, NUP = 2 * DFF, PW = 5664, PWP = 5888, NMOD = 9, MODW = NMOD * DM;
constexpr int SKV = TCX + TL;
constexpr float RMS_EPS = 1e-6f;
constexpr int NPH = 13;

constexpr size_t al256(size_t x) { return (x + 255) / 256 * 256; }
constexpr size_t WS_MOD = 0;
constexpr size_t WS_CTR = WS_MOD + (size_t)9 * MODW * 4;
constexpr size_t WS_BAR = WS_CTR + 256;
constexpr size_t WS_PCNT = al256(WS_BAR + 3456 * 4);
constexpr size_t WS_ROPE = WS_PCNT + (size_t)(4 * 64 + 1) * 256;
constexpr size_t WS_WUP1 = al256(WS_ROPE + 4096 * 4);
constexpr size_t WS_WDN1 = WS_WUP1 + (size_t)NUP * DM * 2;
constexpr size_t WS_WIN = WS_WDN1 + (size_t)DM * DFF * 2;
constexpr size_t WS_WOUT = WS_WIN + (size_t)PWP * DM * 2;
constexpr size_t WS_WUP2 = WS_WOUT + (size_t)DM * DM * 2;
constexpr size_t WS_WDN2 = WS_WUP2 + (size_t)NUP * DM * 2;
constexpr size_t WS_H = WS_WDN2 + (size_t)DM * DFF * 2;
constexpr size_t WS_HID = WS_H + (size_t)MR * DM * 2;
constexpr size_t WS_Q = WS_HID;
constexpr size_t WS_K = WS_Q + (size_t)NLAT * 1024 * 2;
constexpr size_t WS_V = WS_K + (size_t)NB * SKV * 256 * 2;
constexpr size_t WS_MQK = WS_V + (size_t)NB * SKV * 256 * 2;
constexpr size_t WS_MV = WS_MQK + (size_t)MR * 2048 * 2;
constexpr size_t WS_MO = WS_MV + (size_t)MR * 1024 * 2;
constexpr size_t WS_GT = WS_MO + (size_t)NLAT * 1024 * 2;
constexpr size_t WS_PROJ_END = WS_GT + (size_t)MR * 32 * 4;
constexpr size_t WS_ATT = WS_HID + (size_t)MR * DFF * 2;
constexpr size_t WS_PART = WS_ATT;
constexpr size_t WS_XC = WS_ATT + (size_t)NLAT * 2048 * 2;
constexpr size_t WS_END = WS_XC + (size_t)NCTX * DM * 4;
static_assert(WS_PROJ_END <= WS_ATT, "projection outputs must fit in the hidden buffer");

constexpr int LDS_STAGE = 131072;
constexpr int LDS_RED = LDS_STAGE;
constexpr int LDS_CTL = LDS_STAGE + 8192;
constexpr int LDS_BYTES = LDS_CTL + 64;
constexpr int QS_LD = 136, JS_LD = 72;
constexpr int ML_QS = 0, ML_KS = ML_QS + 64 * QS_LD * 2, ML_KT = ML_KS + 64 * QS_LD * 2, ML_VT = ML_KT + 128 * 64 * 2, ML_PS = ML_VT + 144 * 64 * 2,
              ML_C0 = ML_PS + 64 * JS_LD * 2, ML_SC = ML_C0 + 144 * QS_LD * 2, ML_CW = ML_SC + 5 * 64 * 4, ML_CB = ML_CW + 5 * 256 * 4, ML_END = ML_CB + 256 * 4;
static_assert(ML_END <= LDS_BYTES, "mLSTM LDS");

struct Params {
    const float *x, *c, *ctx, *c_ctx, *w_mod, *b_mod, *g_norm, *w_up1, *w_dn1, *w_up2, *w_dn2, *w_in, *q_gain, *k_gain, *conv_w, *conv_b, *gate_b, *m_gain, *w_out, *g_final;
    float* out; unsigned char* ws; int ph_lo, ph_hi;
};

__device__ __forceinline__ int otid() { int t = threadIdx.x; asm volatile("" : "+v"(t)); return t; }
__device__ __forceinline__ unsigned cvt_pk_bf16(float lo, float hi) { unsigned r; asm volatile("v_cvt_pk_bf16_f32 %0, %1, %2" : "=v"(r) : "v"(lo), "v"(hi)); return r; }
__device__ __forceinline__ float bf2f(unsigned short v) { return __uint_as_float(((unsigned)v) << 16); }
__device__ __forceinline__ float silu_f(float x) { return x * __builtin_amdgcn_rcpf(1.0f + __expf(-x)); }
__device__ __forceinline__ float sigmoid_f(float x) { return __builtin_amdgcn_rcpf(1.0f + __expf(-x)); }
__device__ __forceinline__ float logsigmoid_f(float x) { return fminf(x, 0.f) - __logf(1.0f + __expf(-fabsf(x))); }

namespace pg8 {
constexpr int BM = 256, BK = 64, HALF = 128, HTB = HALF * BK * 2, NXCD = 8, WGM = 8;
__device__ __forceinline__ int lds_byte(int r, int c) { const int st = (r >> 4) * 2 + (c >> 5), rr = r & 15, cc = c & 31, ob = rr * 64 + cc * 2; return st * 1024 + (ob ^ (((ob >> 9) & 1) << 5)); }
__device__ __forceinline__ void stage_rc(int b, int& R, int& C) { const int st = b / 1024, sb = b % 1024, swz = sb ^ (((sb >> 9) & 1) << 5); R = (st >> 1) * 16 + swz / 64; C = (st & 1) * 32 + (swz % 64) / 2; }
__device__ __forceinline__ int perm32(int rho) { const int n = rho >> 4, i = rho & 15; return 8 * (i >> 2) + 4 * n + (i & 3); }
struct Unit { int pm, pn, ks; };
struct Gemm { const bf16_t* A; const bf16_t* Bt; int M, N, K, ld; };
struct StaticOrder {
    int nM, nN, nwg, G, c, pm0, nNr;
    __device__ void init(int M, int N, int G_, int c_, int pm0_ = 0, int ksplit = 1) { nM = M / BM; nNr = N / BM; nN = nNr * ksplit; nwg = nM * nN; G = G_; c = c_; pm0 = pm0_; }
    __device__ bool next(int i, Unit& u) const {
        const long L = (long)i * G + c; if (L >= nwg) return false;
        int wgid = (int)L; { const int q = nwg / NXCD, r = nwg % NXCD, xcd = wgid % NXCD, off = wgid / NXCD; wgid = (xcd < r ? xcd * (q + 1) : r * (q + 1) + (xcd - r) * q) + off; }
        const int nig = WGM * nN, gid = wgid / nig, fm = gid * WGM, gsz = (nM - fm) < WGM ? (nM - fm) : WGM;
        u.pm = pm0 + fm + ((wgid % nig) % gsz); const int pe = (wgid % nig) / gsz; u.pn = pe % nNr; u.ks = pe / nNr; return true;
    }
};

template <class Epi>
__device__ __forceinline__ void gemm_phase(LAS unsigned char* lds, const Gemm g, const StaticOrder& S, const Epi& E) {
    const int tid = otid(), wid = __builtin_amdgcn_readfirstlane(tid >> 6), lane = tid & 63, wr = wid >> 2, wc = wid & 3, fr = lane & 15, fq = lane >> 4;
    const int K = g.K, nt = K / BK;
    unsigned voffA[2], voffB[2];
#pragma unroll
    for (int i = 0; i < 2; ++i) { int R, C; stage_rc(tid * 16 + i * 8192, R, C); const int Rb = Epi::PERM ? ((R & ~31) + perm32(R & 31)) : R;
        voffA[i] = (unsigned)(R * g.ld + C) * 2u; voffB[i] = (unsigned)(Rb * g.ld + C) * 2u; }
    const size_t kstep = (size_t)(BK * 2);
    const size_t hstep = (size_t)HALF * g.ld * 2;
    const size_t ksB = (size_t)K * 2;
    const size_t tstep = 2 * hstep;
    const unsigned ldsw = (unsigned)wid * 1024u;
    const int aoff = lds_byte(wr * 64 + fr, fq * 8), boff = lds_byte(wc * 32 + fr, fq * 8);
#define PG8_SA(b, h) (((b) * 2 + (h)) * HTB)
#define PG8_SB(b, h) ((4 + (b) * 2 + (h)) * HTB)
#define PG8_STAGE(bufoff, gbase, voff) do { _Pragma("unroll") for (int _i = 0; _i < 2; ++_i) \
        __builtin_amdgcn_global_load_lds((const unsigned*)((const char*)(gbase) + (voff)[_i]), (LAS unsigned*)(lds + (bufoff) + ldsw + _i * 8192), 16, 0, 0); } while (0)
#define PG8_LDA(dst, b, h) do { _Pragma("unroll") for (int m = 0; m < 4; ++m) _Pragma("unroll") for (int k = 0; k < 2; ++k) dst[m][k] = *(const LAS bf16x8*)(lds + PG8_SA(b, h) + aoff + m * 2048 + k * 1024); } while (0)
#define PG8_LDB(dst, b, h) do { _Pragma("unroll") for (int n = 0; n < 2; ++n) _Pragma("unroll") for (int k = 0; k < 2; ++k) dst[n][k] = *(const LAS bf16x8*)(lds + PG8_SB(b, h) + boff + n * 2048 + k * 1024); } while (0)
#define PG8_MMA(ai, bj, At, Bt) do { __builtin_amdgcn_s_setprio(1); _Pragma("unroll") for (int m = 0; m < 4; ++m) _Pragma("unroll") for (int n = 0; n < 2; ++n) _Pragma("unroll") for (int k = 0; k < 2; ++k) \
        acc[ai][bj][m][n] = __builtin_amdgcn_mfma_f32_16x16x32_bf16(Bt[n][k], At[m][k], acc[ai][bj][m][n], 0, 0, 0); __builtin_amdgcn_s_setprio(0); } while (0)
#define PG8_WAIT_V(n) asm volatile("s_waitcnt vmcnt(" #n ")" ::: "memory")
#define PG8_WAIT_L(n) asm volatile("s_waitcnt lgkmcnt(" #n ")" ::: "memory")
#define PG8_BAR __builtin_amdgcn_s_barrier()
#define PG8_SCHED __builtin_amdgcn_sched_barrier(0)
    Unit cur, nxt; int ui = 0;
    if (!S.next(0, cur)) return;
    f32x4 acc[2][2][4][2];
#pragma unroll
    for (int a = 0; a < 2; ++a)
#pragma unroll
        for (int b = 0; b < 2; ++b)
#pragma unroll
            for (int m = 0; m < 4; ++m)
#pragma unroll
                for (int n = 0; n < 2; ++n) acc[a][b][m][n] = (f32x4){0.f, 0.f, 0.f, 0.f};
    bf16x8 At[4][2], B0[2][2], B1[2][2];
    const char* cA = (const char*)g.A + (size_t)cur.pm * tstep + cur.ks * ksB; const char* cB = (const char*)g.Bt + (size_t)cur.pn * tstep + cur.ks * ksB;
    PG8_STAGE(PG8_SB(0, 0), cB, voffB); PG8_STAGE(PG8_SA(0, 0), cA, voffA); PG8_STAGE(PG8_SB(0, 1), cB + hstep, voffB); PG8_STAGE(PG8_SA(0, 1), cA + hstep, voffA);
    if (wr == 1) PG8_BAR;
    PG8_WAIT_V(4); PG8_BAR;
    PG8_STAGE(PG8_SB(1, 0), cB + kstep, voffB); PG8_STAGE(PG8_SA(1, 0), cA + kstep, voffA); PG8_STAGE(PG8_SB(1, 1), cB + hstep + kstep, voffB);
    PG8_WAIT_V(6); PG8_BAR;
    for (;;) {
        const bool has_next = S.next(ui + 1, nxt);
        const char* nA = has_next ? (const char*)g.A + (size_t)nxt.pm * tstep + nxt.ks * ksB : cA; const char* nB = has_next ? (const char*)g.Bt + (size_t)nxt.pn * tstep + nxt.ks * ksB : cB;
        for (int t = 0; t < nt; t += 2) {
            const bool last = (t == nt - 2);
            const char* a1 = cA + (size_t)(t + 1) * kstep;
            const char* a2 = last ? nA : cA + (size_t)(t + 2) * kstep; const char* b2 = last ? nB : cB + (size_t)(t + 2) * kstep;
            const char* a3 = a2 + kstep; const char* b3 = b2 + kstep;
            PG8_LDB(B0, 0, 0); PG8_SCHED; PG8_LDA(At, 0, 0); PG8_STAGE(PG8_SA(1, 1), a1 + hstep, voffA);
            PG8_WAIT_L(8); PG8_BAR; PG8_WAIT_L(0); PG8_MMA(0, 0, At, B0); PG8_BAR; PG8_SCHED;
            PG8_LDB(B1, 0, 1); PG8_STAGE(PG8_SB(0, 0), b2, voffB);
            PG8_BAR; PG8_WAIT_L(0); PG8_MMA(0, 1, At, B1); PG8_BAR;
            PG8_LDA(At, 0, 1); PG8_STAGE(PG8_SA(0, 0), a2, voffA);
            PG8_BAR; PG8_WAIT_L(0); PG8_MMA(1, 0, At, B0); PG8_BAR; PG8_SCHED;
            PG8_STAGE(PG8_SB(0, 1), b2 + hstep, voffB);
            PG8_WAIT_V(6); PG8_BAR; PG8_MMA(1, 1, At, B1); PG8_BAR;
            PG8_LDB(B0, 1, 0); PG8_SCHED; PG8_LDA(At, 1, 0); PG8_STAGE(PG8_SA(0, 1), a2 + hstep, voffA);
            PG8_WAIT_L(8); PG8_BAR; PG8_WAIT_L(0); PG8_MMA(0, 0, At, B0); PG8_BAR; PG8_SCHED;
            PG8_LDB(B1, 1, 1); PG8_STAGE(PG8_SB(1, 0), b3, voffB);
            PG8_BAR; PG8_WAIT_L(0); PG8_MMA(0, 1, At, B1); PG8_BAR;
            PG8_LDA(At, 1, 1); PG8_STAGE(PG8_SA(1, 0), a3, voffA);
            PG8_BAR; PG8_WAIT_L(0); PG8_MMA(1, 0, At, B0); PG8_BAR; PG8_SCHED;
            PG8_STAGE(PG8_SB(1, 1), b3 + hstep, voffB);
            PG8_WAIT_V(6); PG8_BAR; PG8_MMA(1, 1, At, B1); PG8_BAR;
        }
        E(acc, cur, wr, wc, fr, fq);
        if (!has_next) break;
#pragma unroll
        for (int a = 0; a < 2; ++a)
#pragma unroll
            for (int b = 0; b < 2; ++b)
#pragma unroll
                for (int m = 0; m < 4; ++m)
#pragma unroll
                    for (int n = 0; n < 2; ++n) acc[a][b][m][n] = (f32x4){0.f, 0.f, 0.f, 0.f};
        cur = nxt; cA = nA; cB = nB; ++ui;
    }
    PG8_WAIT_V(0);
    if (wr == 0) PG8_BAR;
    PG8_BAR;
#undef PG8_SA
#undef PG8_SB
#undef PG8_STAGE
#undef PG8_LDA
#undef PG8_LDB
#undef PG8_MMA
#undef PG8_WAIT_V
#undef PG8_WAIT_L
#undef PG8_BAR
#undef PG8_SCHED
}
}

struct EpiSwiglu {
    static constexpr bool PERM = true;
    bf16_t* H;
    __device__ __forceinline__ void operator()(const f32x4 (&acc)[2][2][4][2], const pg8::Unit& u, int wr, int wc, int fr, int fq) const {
        const int row0 = u.pm * 256 + wr * 64 + fr, col0 = u.pn * 128 + wc * 32 + 8 * fq;
#pragma unroll
        for (int ai = 0; ai < 2; ++ai)
#pragma unroll
            for (int m = 0; m < 4; ++m) {
                bf16_t* rowp = H + (size_t)(row0 + ai * 128 + m * 16) * DFF + col0;
                const f32x4 a0 = acc[ai][0][m][0], a1 = acc[ai][0][m][1], b0 = acc[ai][1][m][0], b1 = acc[ai][1][m][1];
                float v[8];
#pragma unroll
                for (int j = 0; j < 4; ++j) { v[j] = silu_f(a0[j]) * b0[j]; v[4 + j] = silu_f(a1[j]) * b1[j]; }
                u32x4 w; w.x = cvt_pk_bf16(v[0], v[1]); w.y = cvt_pk_bf16(v[2], v[3]); w.z = cvt_pk_bf16(v[4], v[5]); w.w = cvt_pk_bf16(v[6], v[7]);
                *(u32x4*)rowp = w;
            }
    }
};
struct EpiResid {
    static constexpr bool PERM = false;
    const float* resid_l; const float* resid_c; float* out_l; float* out_c; const float* mod; int gidx; float coef;
    __device__ __forceinline__ void operator()(const f32x4 (&acc)[2][2][4][2], const pg8::Unit& u, int wr, int wc, int fr, int fq) const {
        const bool isctx = u.pm >= 64; const int b = isctx ? 8 : (u.pm >> 3);
        const int row0 = (isctx ? (u.pm - 64) : u.pm) * 256 + wr * 64 + fr, col0 = u.pn * 256 + wc * 32 + 4 * fq;
        const float* gp = mod + (size_t)(b * NMOD + gidx) * DM + col0;
        const float* rb = isctx ? resid_c : resid_l; float* ob = isctx ? out_c : out_l;
        f32x4 gv[2][2];
#pragma unroll
        for (int bj = 0; bj < 2; ++bj)
#pragma unroll
            for (int n = 0; n < 2; ++n) gv[bj][n] = *(const f32x4*)(gp + bj * 128 + n * 16) * coef;
#pragma unroll
        for (int ai = 0; ai < 2; ++ai)
#pragma unroll
            for (int m = 0; m < 4; ++m) {
                const size_t o = (size_t)(row0 + ai * 128 + m * 16) * DM + col0;
#pragma unroll
                for (int bj = 0; bj < 2; ++bj)
#pragma unroll
                    for (int n = 0; n < 2; ++n) { const f32x4 r = *(const f32x4*)(rb + o + bj * 128 + n * 16); *(f32x4*)(ob + o + bj * 128 + n * 16) = r + gv[bj][n] * acc[ai][bj][m][n]; }
            }
    }
};
struct EpiPartial {
    static constexpr bool PERM = false;
    float* P;
    __device__ __forceinline__ void operator()(const f32x4 (&acc)[2][2][4][2], const pg8::Unit& u, int wr, int wc, int fr, int fq) const {
        const int row0 = (u.pm - 64) * 256 + wr * 64 + fr, col0 = u.pn * 256 + wc * 32 + 4 * fq;
        float* ob = P + (size_t)u.ks * NCTX * DM;
#pragma unroll
        for (int ai = 0; ai < 2; ++ai)
#pragma unroll
            for (int m = 0; m < 4; ++m) {
                const size_t o = (size_t)(row0 + ai * 128 + m * 16) * DM + col0;
#pragma unroll
                for (int bj = 0; bj < 2; ++bj)
#pragma unroll
                    for (int n = 0; n < 2; ++n) *(f32x4*)(ob + o + bj * 128 + n * 16) = acc[ai][bj][m][n];
            }
    }
};
__device__ __forceinline__ int win_src(int slot) {
    if (slot >= PW) return -1;
    if (slot >= 1280) return slot;
    const int head = slot >> 7, s = slot & 127, wc = s >> 5, n = (s >> 4) & 1, fq = (s >> 2) & 3, j = s & 3;
    return head * 128 + (wc >> 1) * 64 + n * 32 + (wc & 1) * 16 + fq * 4 + j;
}
struct EpiWin {
    static constexpr bool PERM = false;
    bf16_t *Q, *K, *V, *MQK, *MV, *MO; float* GT; const float *qg, *kg, *gb, *rope; LAS float* red;
    __device__ __forceinline__ void st4(bf16_t* p, f32x4 v) const { u32x2 w; w.x = cvt_pk_bf16(v[0], v[1]); w.y = cvt_pk_bf16(v[2], v[3]); *(u32x2*)p = w; }
    __device__ __forceinline__ void operator()(const f32x4 (&acc)[2][2][4][2], const pg8::Unit& u, int wr, int wc, int fr, int fq) const {
        asm volatile("" : "+v"(fr), "+v"(fq));
        const int pn = u.pn; const bool isctx = u.pm >= 64;
        const int rt0 = wr * 64 + fr;
        const int grow0 = u.pm * 256 + rt0;
        if (pn <= 4) {
            const float* gain = pn < 4 ? qg : kg;
            const int d1 = (wc >> 1) * 64 + (wc & 1) * 16 + 4 * fq;
            const f32x4 g1 = *(const f32x4*)(gain + d1), g2 = *(const f32x4*)(gain + d1 + 32);
#pragma unroll
            for (int ai = 0; ai < 2; ++ai)
#pragma unroll
                for (int m = 0; m < 4; ++m)
#pragma unroll
                    for (int bj = 0; bj < 2; ++bj) {
                        const f32x4 a = acc[ai][bj][m][0], c = acc[ai][bj][m][1];
                        float ss = a[0] * a[0] + a[1] * a[1] + a[2] * a[2] + a[3] * a[3] + c[0] * c[0] + c[1] * c[1] + c[2] * c[2] + c[3] * c[3];
                        ss += __shfl_xor(ss, 16); ss += __shfl_xor(ss, 32);
                        if (fq == 0) red[((rt0 + ai * 128 + m * 16) * 2 + bj) * 4 + wc] = ss;
                    }
            asm volatile("s_waitcnt lgkmcnt(0)" ::: "memory"); __builtin_amdgcn_s_barrier(); asm volatile("" ::: "memory");
#pragma unroll
            for (int ai = 0; ai < 2; ++ai)
#pragma unroll
                for (int m = 0; m < 4; ++m) {
                    const int rl = rt0 + ai * 128 + m * 16, gr = grow0 + ai * 128 + m * 16;
                    int bidx, tok; if (isctx) { bidx = (gr - NLAT) >> 8; tok = (gr - NLAT) & 255; } else { bidx = gr >> 11; tok = gr & 2047; }
                    f32x4 cs = (f32x4){1.f, 1.f, 1.f, 1.f}, sn = (f32x4){0.f, 0.f, 0.f, 0.f};
                    if (!isctx) { const int pos = (wc >> 1) ? (tok & 63) : (tok >> 6); const int ro = pos * 32 + (wc & 1) * 16 + 4 * fq; cs = *(const f32x4*)(rope + ro); sn = *(const f32x4*)(rope + 2048 + ro); }
#pragma unroll
                    for (int bj = 0; bj < 2; ++bj) {
                        const f32x4 pr = *(const LAS f32x4*)(red + (rl * 2 + bj) * 4);
                        const float rs = __builtin_amdgcn_rsqf((pr[0] + pr[1] + pr[2] + pr[3]) * (1.0f / 128.0f) + RMS_EPS);
                        const f32x4 x1 = acc[ai][bj][m][0] * rs * g1, x2 = acc[ai][bj][m][1] * rs * g2;
                        const f32x4 y1 = x1 * cs - x2 * sn, y2 = x2 * cs + x1 * sn;
                        if (pn < 4) { if (!isctx) { bf16_t* qp = Q + (size_t)gr * 1024 + (pn * 2 + bj) * 128 + d1; st4(qp, y1); st4(qp + 32, y2); } }
                        else { bf16_t* kp = K + ((size_t)bidx * SKV + (isctx ? tok : TCX + tok)) * 256 + bj * 128 + d1; st4(kp, y1); st4(kp + 32, y2); }
                    }
                    __builtin_amdgcn_sched_barrier(0);
                }
        } else {
            const int cc0 = wc * 32 + 4 * fq;
#pragma unroll
            for (int ai = 0; ai < 2; ++ai)
#pragma unroll
                for (int m = 0; m < 4; ++m) {
                    const int gr = grow0 + ai * 128 + m * 16;
                    int bidx, tok; if (isctx) { bidx = (gr - NLAT) >> 8; tok = (gr - NLAT) & 255; } else { bidx = gr >> 11; tok = gr & 2047; }
#pragma unroll
                    for (int bj = 0; bj < 2; ++bj)
#pragma unroll
                        for (int n = 0; n < 2; ++n) {
                            const int cc = cc0 + bj * 128 + n * 16; const f32x4 v = acc[ai][bj][m][n];
                            if (pn == 5) st4(V + ((size_t)bidx * SKV + (isctx ? tok : TCX + tok)) * 256 + cc, v);
                            else if (pn < 14) st4(MQK + (size_t)gr * 2048 + (pn - 6) * 256 + cc, v);
                            else if (pn < 18) st4(MV + (size_t)gr * 1024 + (pn - 14) * 256 + cc, v);
                            else if (pn < 22) { if (!isctx) { f32x4 s; s[0] = sigmoid_f(v[0]); s[1] = sigmoid_f(v[1]); s[2] = sigmoid_f(v[2]); s[3] = sigmoid_f(v[3]); st4(MO + (size_t)gr * 1024 + (pn - 18) * 256 + cc, s); } }
                            else if (cc < 32) {
                                f32x4 t = v + *(const f32x4*)(gb + cc);
                                if (fq >= 2) { t[0] = logsigmoid_f(t[0]); t[1] = logsigmoid_f(t[1]); t[2] = logsigmoid_f(t[2]); t[3] = logsigmoid_f(t[3]); }
                                *(f32x4*)(GT + (size_t)gr * 32 + cc) = t;
                            }
                        }
                    __builtin_amdgcn_sched_barrier(0);
                }
        }
    }
};

__device__ __forceinline__ int up_src(int slot) { const int pn = slot >> 8, r = slot & 255; return (r >> 7) * DFF + pn * 128 + (r & 127); }
template <int MAP  >
__device__ __forceinline__ void prep_tile(const float* __restrict__ W, int Nsrc, bf16_t* __restrict__ Bt, int Kdim, int nt, int kt, LAS float* tl) {
    const int tid = otid();
    { const int n4 = tid & 63, kk = tid >> 6; const int slot = nt * 256 + 4 * n4;
      const int src = MAP == 0 ? slot : (MAP == 1 ? up_src(slot) : win_src(slot));
      f32x4 v[8];
#pragma unroll
      for (int pss = 0; pss < 8; ++pss) { v[pss] = (f32x4){0.f, 0.f, 0.f, 0.f}; if (src >= 0) v[pss] = *(const f32x4*)(W + (size_t)(kt * 64 + kk + pss * 8) * Nsrc + src); }
#pragma unroll
      for (int pss = 0; pss < 8; ++pss) *(LAS f32x4*)(tl + (kk + pss * 8) * 260 + 4 * n4) = v[pss]; }
    __syncthreads();
    { const int n = tid >> 1, kh = (tid & 1) * 32;
#pragma unroll
      for (int q = 0; q < 4; ++q) { float v[8];
#pragma unroll
          for (int e = 0; e < 8; ++e) v[e] = tl[(kh + q * 8 + e) * 260 + n];
          u32x4 w; w.x = cvt_pk_bf16(v[0], v[1]); w.y = cvt_pk_bf16(v[2], v[3]); w.z = cvt_pk_bf16(v[4], v[5]); w.w = cvt_pk_bf16(v[6], v[7]);
          *(u32x4*)(Bt + (size_t)(nt * 256 + n) * Kdim + kt * 64 + kh + q * 8) = w; } }
    __syncthreads();
}
__device__ __forceinline__ void prep_weights(const Params& p, LAS unsigned char* lds, int grp, int idx, int n) {
    LAS float* tl = (LAS float*)lds;
    constexpr int T_UP = (NUP / 256) * (DM / 64), T_DN = (DM / 256) * (DFF / 64), T_IN = (PWP / 256) * (DM / 64), T_OUT = (DM / 256) * (DM / 64);
    const int tot = grp == 1 ? T_IN + T_OUT : T_UP + T_DN;
    for (int t = idx; t < tot; t += n) {
        int q = t;
        if (grp == 1) {
            if (q < T_IN) { prep_tile<2>(p.w_in, PW, (bf16_t*)(p.ws + WS_WIN), DM, q % (PWP / 256), q / (PWP / 256), tl); continue; } q -= T_IN;
            prep_tile<0>(p.w_out, DM, (bf16_t*)(p.ws + WS_WOUT), DM, q % (DM / 256), q / (DM / 256), tl);
        } else {
            const float* wu = grp == 0 ? p.w_up1 : p.w_up2; const float* wd = grp == 0 ? p.w_dn1 : p.w_dn2;
            if (q < T_UP) { prep_tile<1>(wu, NUP, (bf16_t*)(p.ws + (grp == 0 ? WS_WUP1 : WS_WUP2)), DM, q % (NUP / 256), q / (NUP / 256), tl); continue; } q -= T_UP;
            prep_tile<0>(wd, DM, (bf16_t*)(p.ws + (grp == 0 ? WS_WDN1 : WS_WDN2)), DFF, q % (DM / 256), q / (DM / 256), tl);
        }
    }
}
__device__ __forceinline__ void phase_prep(const Params& p, LAS unsigned char* lds, bool do_mod) {
    const int tid = otid(), G = gridDim.x, bid = blockIdx.x;
    float* mod = (float*)(p.ws + WS_MOD);
    LAS float* sv = (LAS float*)lds;
    LAS float* red = (LAS float*)(lds + 9 * 512 * 4);
    for (int item = bid; do_mod && item < 576; item += G) {
        const int cb = item >> 2, ks = item & 3;
        for (int i = tid; i < 9 * 512; i += 512) { const int b = i >> 9, k = i & 511; const float cv = b < 8 ? p.c[b * DM + ks * 512 + k] : p.c_ctx[ks * 512 + k]; sv[i] = silu_f(cv); }
        __syncthreads();
        const int c4 = tid & 31, kr = tid >> 5;
        f32x4 a[9];
#pragma unroll
        for (int b = 0; b < 9; ++b) a[b] = (f32x4){0.f, 0.f, 0.f, 0.f};
        for (int kk = kr; kk < 512; kk += 16) {
            const f32x4 w = *(const f32x4*)(p.w_mod + (size_t)(ks * 512 + kk) * MODW + cb * 128 + c4 * 4);
#pragma unroll
            for (int b = 0; b < 9; ++b) a[b] += w * sv[b * 512 + kk];
        }
#pragma unroll
        for (int b = 0; b < 9; ++b) *(LAS f32x4*)(red + (kr * 9 + b) * 128 + c4 * 4) = a[b];
        __syncthreads();
        for (int o = tid; o < 9 * 128; o += 512) { const int b = o >> 7, cidx = o & 127; float s = 0.f;
#pragma unroll
            for (int r = 0; r < 16; ++r) s += red[(r * 9 + b) * 128 + cidx];
            const int col = cb * 128 + cidx; if (ks == 0) s += p.b_mod[col];
            atomicAdd(mod + (size_t)b * MODW + col, s); }
        __syncthreads();
    }
    if (bid == G - 1) { float* rope = (float*)(p.ws + WS_ROPE);
        for (int i = tid; i < 2048; i += 512) { const int pos = i >> 5, idx = i & 31; const float inv = exp2f(-(float)idx * (13.287712379549449f / 32.0f)); const float ang = (float)pos * inv;
            rope[i] = cosf(ang); rope[2048 + i] = sinf(ang); } }
    prep_weights(p, lds, 0, bid, G);
}

template <int MODE>
__device__ __forceinline__ void phase_rows(const float* src_l, const float* src_c, int nrows, const float* g, const float* mod, int midx, bf16_t* outb, float* outf, const float* part,
                                           int rbase = -1, int rstride = 0) {
    const int wave = otid() >> 6, lane = otid() & 63;
    const int stride = rbase < 0 ? gridDim.x * 8 : rstride;
    for (int r0 = (rbase < 0 ? blockIdx.x * 8 : rbase) + wave; r0 < nrows; r0 += 2 * stride) {
        f32x4 v[2][8]; float ss[2] = {0.f, 0.f};
#pragma unroll
        for (int q = 0; q < 2; ++q) {
            const int r = r0 + q * stride;
            if (r < nrows) {
                const bool isctx = r >= NLAT; const float* xp = isctx ? src_c + (size_t)(r - NLAT) * DM : src_l + (size_t)r * DM;
#pragma unroll
                for (int k = 0; k < 8; ++k) v[q][k] = *(const f32x4*)(xp + (k * 64 + lane) * 4);
                if (isctx && part) {
                    const float* gt = mod + (size_t)(8 * NMOD + 2) * DM; const float* pp = part + (size_t)(r - NLAT) * DM;
#pragma unroll
                    for (int k = 0; k < 8; ++k) { const int c = (k * 64 + lane) * 4;
                        const f32x4 sum = (*(const f32x4*)(pp + c) + *(const f32x4*)(pp + (size_t)NCTX * DM + c)) + (*(const f32x4*)(pp + (size_t)2 * NCTX * DM + c) + *(const f32x4*)(pp + (size_t)3 * NCTX * DM + c));
                        v[q][k] += *(const f32x4*)(gt + c) * 0.5f * sum; }
                }
#pragma unroll
                for (int k = 0; k < 8; ++k) ss[q] += v[q][k][0] * v[q][k][0] + v[q][k][1] * v[q][k][1] + v[q][k][2] * v[q][k][2] + v[q][k][3] * v[q][k][3];
            }
        }
#pragma unroll
        for (int o = 32; o >= 1; o >>= 1) { ss[0] += __shfl_xor(ss[0], o); ss[1] += __shfl_xor(ss[1], o); }
#pragma unroll
        for (int q = 0; q < 2; ++q) {
            const int r = r0 + q * stride;
            if (r < nrows) {
                const float rs = rsqrtf(ss[q] * (1.0f / DM) + RMS_EPS);
                if (MODE == 0) {
                    const int b = r >= NLAT ? 8 : (r >> 11);
                    const float* sh = mod + (size_t)(b * NMOD + midx) * DM; const float* sc = sh + DM;
#pragma unroll
                    for (int k = 0; k < 8; ++k) { const int c = (k * 64 + lane) * 4; const f32x4 gg = *(const f32x4*)(g + c), s1 = *(const f32x4*)(sc + c), s0 = *(const f32x4*)(sh + c);
                        const f32x4 y = v[q][k] * rs * gg * (s1 + 1.0f) + s0; u32x2 w; w.x = cvt_pk_bf16(y[0], y[1]); w.y = cvt_pk_bf16(y[2], y[3]); *(u32x2*)(outb + (size_t)r * DM + c) = w; }
                } else {
#pragma unroll
                    for (int k = 0; k < 8; ++k) { const int c = (k * 64 + lane) * 4; const f32x4 gg = *(const f32x4*)(g + c); *(f32x4*)(outf + (size_t)r * DM + c) = v[q][k] * rs * gg; }
                }
            }
        }
    }
}

namespace att {
constexpr int D = 128, NW = 8, QBLK = 32, KVBLK = 64;
constexpr float SCALE = 0.088388347648318440f, THR = 8.f;
constexpr int LDQ = 1024, LDK = 256, LDO = 2048;
constexpr size_t SHM_V = KVBLK * D * 2, SHM_K = KVBLK * D * 2, SHM_ATTN = 2 * SHM_V + 2 * SHM_K + NW * 64 * 4;
#define KSWZ(row, colB) ((row) * 256 + ((colB) ^ (((row) & 7) << 4)))
#define SBAR() __builtin_amdgcn_sched_barrier(0)
__device__ __forceinline__ int crow(int r, int hi) { return (r & 3) + 8 * (r >> 2) + 4 * hi; }
__device__ __forceinline__ void partialSM(f32x16& p0, f32x16& p1, float& m_reg, float& mn, float& alpha) {
  constexpr float C = SCALE * 1.4426950408889634f;
  float pmax = p0[0]; for (int r = 1; r < 16; ++r) pmax = fmaxf(pmax, p0[r]); for (int r = 0; r < 16; ++r) pmax = fmaxf(pmax, p1[r]);
  { auto rr = __builtin_amdgcn_permlane32_swap(__float_as_uint(pmax), __float_as_uint(pmax), false, false);
    pmax = fmaxf(__uint_as_float(rr[0]), __uint_as_float(rr[1])); }
  if (__builtin_expect(__all(pmax - m_reg <= THR / SCALE), 1)) { mn = m_reg; alpha = 1.f; }
  else { mn = fmaxf(m_reg, pmax); alpha = __builtin_amdgcn_exp2f((m_reg - mn) * C); m_reg = mn; }
  float mnC = -mn * C;
  for (int r = 0; r < 16; ++r) p0[r] = fmaf(p0[r], C, mnC); for (int r = 0; r < 16; ++r) p1[r] = fmaf(p1[r], C, mnC);
  for (int r = 0; r < 16; ++r) p0[r] = __builtin_amdgcn_exp2f(p0[r]);
}
__device__ __forceinline__ void finishSM(f32x16& p0, f32x16& p1, float alpha, float& l_reg, bf16x8& pa0, bf16x8& pa1, bf16x8& pa2, bf16x8& pa3) {
  for (int r = 0; r < 16; ++r) p1[r] = __builtin_amdgcn_exp2f(p1[r]);
  float ps = 0; for (int r = 0; r < 16; ++r) ps += p0[r]; for (int r = 0; r < 16; ++r) ps += p1[r];
  { auto rr = __builtin_amdgcn_permlane32_swap(__float_as_uint(ps), __float_as_uint(ps), false, false);
    ps = __uint_as_float(rr[0]) + __uint_as_float(rr[1]); }
  l_reg = l_reg * alpha + ps;
#define PK4(P, BASE, OUT) do { unsigned a0 = cvt_pk_bf16(P[BASE + 0], P[BASE + 1]), a1 = cvt_pk_bf16(P[BASE + 2], P[BASE + 3]);   \
    unsigned b0 = cvt_pk_bf16(P[BASE + 4], P[BASE + 5]), b1 = cvt_pk_bf16(P[BASE + 6], P[BASE + 7]);                              \
    auto r0 = __builtin_amdgcn_permlane32_swap(a0, b0, false, false); auto r1 = __builtin_amdgcn_permlane32_swap(a1, b1, false, false); \
    u32x4 w = {r0[0], r1[0], r0[1], r1[1]}; OUT = *reinterpret_cast<bf16x8*>(&w); } while (0)
  PK4(p0, 0, pa0); PK4(p0, 8, pa1); PK4(p1, 0, pa2); PK4(p1, 8, pa3);
#undef PK4
}
__device__ __forceinline__ void qkt(f32x16& p0, f32x16& p1, const bf16_t* Ks, const bf16x8* qr, int r32, int hi) {
  p0 = f32x16{}; p1 = f32x16{};
  for (int d0 = 0; d0 < 8; ++d0) { int cb = (d0 * 16 + hi * 8) * 2;
    bf16x8 b0 = *reinterpret_cast<const bf16x8*>((const char*)Ks + KSWZ(r32, cb));
    bf16x8 b1 = *reinterpret_cast<const bf16x8*>((const char*)Ks + KSWZ(32 + r32, cb));
    p0 = __builtin_amdgcn_mfma_f32_32x32x16_bf16(b0, qr[d0], p0, 0, 0, 0);
    p1 = __builtin_amdgcn_mfma_f32_32x32x16_bf16(b1, qr[d0], p1, 0, 0, 0); }
}
__device__ __forceinline__ int v_st(int k, int c) { const int kk = (k & ~0xC) | ((k & 4) << 1) | ((k & 8) >> 1); return ((kk >> 3) * 4 + (c >> 5)) * 512 + ((kk & 7) * 32 + (c & 31)) * 2; }
__device__ __forceinline__ int v_rd_base(int lane) { return ((lane & 3) << 3) | (((lane >> 2) & 3) << 6) | (((lane >> 4) & 1) << 5) | (((lane >> 5) & 1) << 8); }
constexpr int v_rd_off(int d0, int ks, int half) { return d0 * 512 + ks * 4096 + half * 2048; }
template <int OFF> __device__ __forceinline__ s16x4 tr_read(int vb) {
  s16x4 r; asm volatile("ds_read_b64_tr_b16 %0, %1 offset:%2" : "=&v"(r) : "v"(vb), "i"(OFF) : "memory"); return r;
}
template <int D0> __device__ __forceinline__ void pv_one(f32x16& od, int vb, bf16x8 pa0, bf16x8 pa1, bf16x8 pa2, bf16x8 pa3) {
  const s16x4 l0 = tr_read<v_rd_off(D0, 0, 0)>(vb), h0 = tr_read<v_rd_off(D0, 0, 1)>(vb), l1 = tr_read<v_rd_off(D0, 1, 0)>(vb), h1 = tr_read<v_rd_off(D0, 1, 1)>(vb);
  const s16x4 l2 = tr_read<v_rd_off(D0, 2, 0)>(vb), h2 = tr_read<v_rd_off(D0, 2, 1)>(vb), l3 = tr_read<v_rd_off(D0, 3, 0)>(vb), h3 = tr_read<v_rd_off(D0, 3, 1)>(vb);
  asm volatile("s_waitcnt lgkmcnt(0)" ::: "memory"); SBAR();
#define PK(L, H) (bf16x8){L[0], L[1], L[2], L[3], H[0], H[1], H[2], H[3]}
  od = __builtin_amdgcn_mfma_f32_32x32x16_bf16(pa0, PK(l0, h0), od, 0, 0, 0);
  od = __builtin_amdgcn_mfma_f32_32x32x16_bf16(pa1, PK(l1, h1), od, 0, 0, 0);
  od = __builtin_amdgcn_mfma_f32_32x32x16_bf16(pa2, PK(l2, h2), od, 0, 0, 0);
  od = __builtin_amdgcn_mfma_f32_32x32x16_bf16(pa3, PK(l3, h3), od, 0, 0, 0);
#undef PK
}
__device__ __forceinline__ void pv_d0(f32x16* o, int vb, bf16x8 pa0, bf16x8 pa1, bf16x8 pa2, bf16x8 pa3) {
  pv_one<0>(o[0], vb, pa0, pa1, pa2, pa3); pv_one<1>(o[1], vb, pa0, pa1, pa2, pa3); pv_one<2>(o[2], vb, pa0, pa1, pa2, pa3); pv_one<3>(o[3], vb, pa0, pa1, pa2, pa3);
}
__device__ __forceinline__ void attn_dense_body(const bf16_t* __restrict__ Qb, const bf16_t* __restrict__ Kh, const bf16_t* __restrict__ Vh, bf16_t* __restrict__ Ob, int seq, char* lds) {
  const int tid = otid(), wid = tid >> 6, lane = tid & 63, r32 = lane & 31, hi = lane >> 5;
  bf16_t* V_lds = (bf16_t*)lds; bf16_t* K_lds = (bf16_t*)(lds + 2 * SHM_V);
  float* ws = (float*)(lds + 2 * SHM_V + 2 * SHM_K) + wid * 64; float* li_l = ws; float* al_l = ws + 32;
  float m_reg = -1e30f, l_reg = 0; f32x16 o[4] = {}; bf16x8 qr[8];
  const bf16_t* Qw = Qb + (long)(wid * QBLK + r32) * LDQ + hi * 8;
#pragma unroll
  for (int d0 = 0; d0 < 8; ++d0) qr[d0] = *reinterpret_cast<const bf16x8*>(Qw + d0 * 16);
  const int sr = tid >> 4, sc = (tid & 15) * 8, vst0 = v_st(sr, sc), vst1 = v_st(32 + sr, sc);
  const int vb0 = (int)(uintptr_t)V_lds + v_rd_base(lane);
  struct { bf16x8 vs0, vs1, ks0, ks1; } sr_[2];
#define SLOAD(i, k0) do { sr_[i].vs0 = *reinterpret_cast<const bf16x8*>(&Vh[(long)((k0) + sr) * LDK + sc]); sr_[i].vs1 = *reinterpret_cast<const bf16x8*>(&Vh[(long)((k0) + 32 + sr) * LDK + sc]); \
    sr_[i].ks0 = *reinterpret_cast<const bf16x8*>(&Kh[(long)((k0) + sr) * LDK + sc]); sr_[i].ks1 = *reinterpret_cast<const bf16x8*>(&Kh[(long)((k0) + 32 + sr) * LDK + sc]); } while (0)
#define SWRITE(b, i) do { *(bf16x8*)((char*)V_lds + (b) * SHM_V + vst0) = sr_[i].vs0;          \
    *(bf16x8*)((char*)V_lds + (b) * SHM_V + vst1) = sr_[i].vs1; int kc = sc * 2;               \
    *(bf16x8*)((char*)K_lds + (b) * SHM_K + KSWZ(sr, kc)) = sr_[i].ks0;                       \
    *(bf16x8*)((char*)K_lds + (b) * SHM_K + KSWZ(32 + sr, kc)) = sr_[i].ks1; } while (0)
#define SWAIT() asm volatile("s_waitcnt vmcnt(4)" ::: "memory")
#define RESC(a) do { if (__any((a) < 1.f)) { if (hi == 0) al_l[r32] = (a); asm volatile("s_waitcnt lgkmcnt(0)" ::: "memory"); \
    for (int d = 0; d < 4; ++d) for (int r = 0; r < 16; ++r) o[d][r] *= al_l[crow(r, hi)]; } } while (0)
  f32x16 pA0, pA1, pB0, pB1; float mnA, mnB, alA, alB; bf16x8 pa0, pa1, pa2, pa3; const int NT = seq / KVBLK;
  constexpr int SE = 0, SO = 1;
  SLOAD(SE, 0); asm volatile("s_waitcnt vmcnt(0)" ::: "memory"); SWRITE(0, SE); __syncthreads();
  qkt(pA0, pA1, K_lds, qr, r32, hi); partialSM(pA0, pA1, m_reg, mnA, alA);
  SLOAD(SO, KVBLK); if (2 < NT) SLOAD(SE, 2 * KVBLK);
  SWAIT(); SWRITE(1, SO); __syncthreads();
  for (int j = 1; j + 1 < NT; j += 2) {
    SBAR(); qkt(pB0, pB1, (bf16_t*)((char*)K_lds + SHM_K), qr, r32, hi);
    finishSM(pA0, pA1, alA, l_reg, pa0, pa1, pa2, pa3); SBAR();
    SLOAD(SO, (j + 2) * KVBLK); SBAR();
    pv_d0(o, vb0, pa0, pa1, pa2, pa3); partialSM(pB0, pB1, m_reg, mnB, alB);
    __syncthreads(); SWAIT(); SWRITE(0, SE);
    RESC(alB); __syncthreads();
    SBAR(); qkt(pA0, pA1, K_lds, qr, r32, hi);
    finishSM(pB0, pB1, alB, l_reg, pa0, pa1, pa2, pa3); SBAR();
    if (j + 3 < NT) SLOAD(SE, (j + 3) * KVBLK); SBAR();
    pv_d0(o, vb0 + (int)SHM_V, pa0, pa1, pa2, pa3); partialSM(pA0, pA1, m_reg, mnA, alA);
    __syncthreads(); SWAIT(); SWRITE(1, SO);
    RESC(alA); __syncthreads();
  }
  SBAR(); qkt(pB0, pB1, (bf16_t*)((char*)K_lds + SHM_K), qr, r32, hi);
  finishSM(pA0, pA1, alA, l_reg, pa0, pa1, pa2, pa3); SBAR();
  pv_d0(o, vb0, pa0, pa1, pa2, pa3); partialSM(pB0, pB1, m_reg, mnB, alB);
  __syncthreads(); RESC(alB);
  finishSM(pB0, pB1, alB, l_reg, pa0, pa1, pa2, pa3); SBAR();
  pv_d0(o, vb0 + (int)SHM_V, pa0, pa1, pa2, pa3);
  if (hi == 0) li_l[r32] = l_reg; asm volatile("s_waitcnt lgkmcnt(0)" ::: "memory");
  float rli[16];
#pragma unroll
  for (int r = 0; r < 16; ++r) rli[r] = __builtin_amdgcn_rcpf(li_l[crow(r, hi)]);
  bf16_t* Ow = Ob + (long)(wid * QBLK) * LDO;
#pragma unroll
  for (int r = 0; r < 16; ++r) { int orow = crow(r, hi);
    for (int d0 = 0; d0 < 4; ++d0) Ow[(long)orow * LDO + d0 * 32 + r32] = (bf16_t)(cvt_pk_bf16(o[d0][r] * rli[r], 0.f) & 0xffffu); }
#undef SLOAD
#undef SWRITE
#undef SWAIT
#undef RESC
}
}

__device__ __forceinline__ void attn_unit(const Params& p, unsigned char* lds_generic, int u) {
    const int qb = u & 7, g = (u >> 3) & 3, kvh = (u >> 5) & 1, b = u >> 6, hq = kvh * 4 + g;
    const bf16_t* Q = (const bf16_t*)(p.ws + WS_Q) + ((size_t)(b * TL + qb * 256)) * 1024 + hq * 128;
    const bf16_t* K = (const bf16_t*)(p.ws + WS_K) + (size_t)b * SKV * 256 + kvh * 128;
    const bf16_t* V = (const bf16_t*)(p.ws + WS_V) + (size_t)b * SKV * 256 + kvh * 128;
    bf16_t* O = (bf16_t*)(p.ws + WS_ATT) + ((size_t)(b * TL + qb * 256)) * 2048 + hq * 128;
    __syncthreads();
    att::attn_dense_body(Q, K, V, O, SKV, (char*)lds_generic);
}

__device__ __forceinline__ int jsw(int r, int c) { return r * 64 + ((((c) >> 3) ^ ((r ^ (r >> 3)) & 7)) << 3) + (c & 7); }
__device__ __forceinline__ f32x4 mfma16(bf16x8 a, bf16x8 b, f32x4 c) { return __builtin_amdgcn_mfma_f32_16x16x32_bf16(a, b, c, 0, 0, 0); }
__device__ __forceinline__ void mlstm_stream(const Params& p, LAS unsigned char* lds, int sid) {
    const int tid = otid(), w = __builtin_amdgcn_readfirstlane(tid >> 6), lane = tid & 63, fr = lane & 15, fq = lane >> 4;
    const int dir = sid & 1, h = (sid >> 1) & 7, b = sid >> 4;
    LAS bf16_t* Qs = (LAS bf16_t*)(lds + ML_QS); LAS bf16_t* Ks = (LAS bf16_t*)(lds + ML_KS); LAS bf16_t* KT = (LAS bf16_t*)(lds + ML_KT);
    LAS bf16_t* VT = (LAS bf16_t*)(lds + ML_VT); LAS bf16_t* Ps = (LAS bf16_t*)(lds + ML_PS); LAS bf16_t* C0 = (LAS bf16_t*)(lds + ML_C0);
    LAS float* sc_u = (LAS float*)(lds + ML_SC); LAS float* sc_pm = sc_u + 64; LAS float* sc_a = sc_u + 128; LAS float* sc_e = sc_u + 192;
    LAS float* cw = (LAS float*)(lds + ML_CW); LAS float* cbv = (LAS float*)(lds + ML_CB);
    const bf16_t* MQK = (const bf16_t*)(p.ws + WS_MQK); const bf16_t* MV = (const bf16_t*)(p.ws + WS_MV); const float* GT = (const float*)(p.ws + WS_GT);
    bf16_t* HO = (bf16_t*)(p.ws + WS_H) + (size_t)dir * NLAT * 1024;
    const int cg8 = (tid & 15) * 8, rg = tid >> 4, tl0 = 2 * rg;
    const int i0 = dir ? 63 - tl0 : tl0, i1 = dir ? i0 - 1 : i0 + 1, ie = dir ? i1 : i0;
    __syncthreads();
    for (int i = tid; i < 16 * 64; i += 512) VT[128 * 64 + i] = 0x3F80;
    for (int i = tid; i < 5 * 256; i += 512) { const int j = i >> 8, c = i & 255; cw[i] = p.conv_w[j * 2048 + (c < 128 ? h * 128 + c : 1024 + h * 128 + (c - 128))]; }
    for (int i = tid; i < 256; i += 512) cbv[i] = p.conv_b[i < 128 ? h * 128 + i : 1024 + h * 128 + (i - 128)];
    f32x4 C[9];
#pragma unroll
    for (int i = 0; i < 9; ++i) C[i] = (f32x4){0.f, 0.f, 0.f, 0.f};
    float m0 = 0.f;
    bf16x8 xq[6], xk[6], xv0, xv1; float g_ig, g_lf;
#define ML_CHUNK(ci_, lat_, chunk_, TS_, rbase_, t0_) const bool lat_ = (ci_) >= 4; const int chunk_ = lat_ ? (dir ? 35 - (ci_) : (ci_) - 4) : (dir ? 3 - (ci_) : (ci_)); \
        const int TS_ = lat_ ? TL : TCX; const size_t rbase_ = lat_ ? (size_t)b * TL : (size_t)NLAT + (size_t)b * TCX; const int t0_ = chunk_ * 64;
#define ML_LOAD(ci_) do { ML_CHUNK(ci_, l_, c_, ts_, rb_, t_) \
        { const int tl = dir ? 63 - lane : lane; const size_t row = rb_ + t_ + tl; g_ig = GT[row * 32 + dir * 16 + h]; g_lf = GT[row * 32 + dir * 16 + 8 + h]; } \
        _Pragma("unroll") for (int rr = 0; rr < 6; ++rr) { const int sl = t_ + tl0 - 2 + rr; xq[rr] = (bf16x8){0, 0, 0, 0, 0, 0, 0, 0}; xk[rr] = xq[rr]; \
            if (sl >= 0 && sl < ts_) { const bf16_t* src = MQK + (rb_ + sl) * 2048 + h * 128 + cg8; xq[rr] = *(const bf16x8*)src; xk[rr] = *(const bf16x8*)(src + 1024); } } \
        xv0 = *(const bf16x8*)(MV + (rb_ + t_ + tl0) * 1024 + h * 128 + cg8); xv1 = *(const bf16x8*)(MV + (rb_ + t_ + tl0 + 1) * 1024 + h * 128 + cg8); } while (0)
    ML_LOAD(0);
    __syncthreads();
    for (int ci = 0; ci < 36; ++ci) {
        ML_CHUNK(ci, lat, chunk, TS, rbase, t0)
        (void)TS;
        float wgt, decay, m0n;
        {
            float bc = g_lf;
#pragma unroll
            for (int d = 1; d < 64; d <<= 1) { const float v = __shfl_up(bc, d); if (lane >= d) bc += v; }
            const float uu = g_ig - bc; float px = uu;
#pragma unroll
            for (int d = 1; d < 64; d <<= 1) { const float v = __shfl_up(px, d); if (lane >= d) px = fmaxf(px, v); }
            const float pm = fmaxf(m0, px);
            const float bL = __shfl(bc, 63), pmL = __shfl(pm, 63);
            wgt = __expf(uu - pmL); decay = __expf(m0 - pmL); m0n = bL + pmL;
            if (w == 0) { sc_u[lane] = uu; sc_pm[lane] = pm; sc_a[lane] = __expf(m0 - pm); sc_e[lane] = __expf(-bc - pm); }
        }
        {
            const float w0 = __shfl(wgt, i0), w1 = __shfl(wgt, i1);
#pragma unroll
            for (int qk = 0; qk < 2; ++qk) {
                float y0[8], y1[8];
#pragma unroll
                for (int e = 0; e < 8; ++e) { y0[e] = cbv[qk * 128 + cg8 + e]; y1[e] = y0[e]; }
#pragma unroll
                for (int j = 0; j < 5; ++j) {
                    const f32x4 wa = *(const LAS f32x4*)(cw + j * 256 + qk * 128 + cg8), wb = *(const LAS f32x4*)(cw + j * 256 + qk * 128 + cg8 + 4);
#pragma unroll
                    for (int e = 0; e < 8; ++e) { const float wv = e < 4 ? wa[e] : wb[e - 4]; const bf16x8 xa = qk ? xk[j] : xq[j], xb = qk ? xk[j + 1] : xq[j + 1];
                        y0[e] += wv * bf2f((unsigned short)xa[e]); y1[e] += wv * bf2f((unsigned short)xb[e]); }
                }
                const float ksc = qk ? 0.08838834764831845f : 1.0f;
#pragma unroll
                for (int e = 0; e < 8; ++e) { y0[e] = silu_f(y0[e]) * ksc; y1[e] = silu_f(y1[e]) * ksc; }
                LAS bf16_t* dst = qk ? Ks : Qs;
                u32x4 p0, p1; p0.x = cvt_pk_bf16(y0[0], y0[1]); p0.y = cvt_pk_bf16(y0[2], y0[3]); p0.z = cvt_pk_bf16(y0[4], y0[5]); p0.w = cvt_pk_bf16(y0[6], y0[7]);
                p1.x = cvt_pk_bf16(y1[0], y1[1]); p1.y = cvt_pk_bf16(y1[2], y1[3]); p1.z = cvt_pk_bf16(y1[4], y1[5]); p1.w = cvt_pk_bf16(y1[6], y1[7]);
                *(LAS u32x4*)(dst + i0 * QS_LD + cg8) = p0; *(LAS u32x4*)(dst + i1 * QS_LD + cg8) = p1;
                if (qk) {
#pragma unroll
                    for (int e = 0; e < 8; ++e) { const float a0 = y0[e] * w0, a1 = y1[e] * w1; *(LAS unsigned*)(KT + jsw(cg8 + e, ie)) = dir ? cvt_pk_bf16(a1, a0) : cvt_pk_bf16(a0, a1); }
                }
            }
#pragma unroll
            for (int e = 0; e < 8; ++e) { const unsigned lo = (unsigned short)(dir ? xv1[e] : xv0[e]), hi = (unsigned short)(dir ? xv0[e] : xv1[e]); *(LAS unsigned*)(VT + jsw(cg8 + e, ie)) = lo | (hi << 16); }
        }
        if (ci + 1 < 36) ML_LOAD(ci + 1);
        __syncthreads();
        if (lat) {
            const int it = w >> 1;
#pragma unroll
            for (int jj = 0; jj < 2; ++jj) {
                const int jt = (w & 1) * 2 + jj;
                f32x4 s = (f32x4){0.f, 0.f, 0.f, 0.f};
                if (jt <= it) {
#pragma unroll
                    for (int ks = 0; ks < 4; ++ks) { const bf16x8 a = *(const LAS bf16x8*)(Ks + (jt * 16 + fr) * QS_LD + ks * 32 + fq * 8), bb = *(const LAS bf16x8*)(Qs + (it * 16 + fr) * QS_LD + ks * 32 + fq * 8); s = mfma16(a, bb, s); }
                    const int i = it * 16 + fr, j0 = jt * 16 + 4 * fq; const float pmi = sc_pm[i]; const f32x4 uj = *(const LAS f32x4*)(sc_u + j0);
#pragma unroll
                    for (int r = 0; r < 4; ++r) s[r] = (j0 + r <= i) ? s[r] * __expf(uj[r] - pmi) : 0.f;
                }
                u32x2 pw; pw.x = cvt_pk_bf16(s[0], s[1]); pw.y = cvt_pk_bf16(s[2], s[3]);
                *(LAS u32x2*)(Ps + (it * 16 + fr) * JS_LD + jt * 16 + 4 * fq) = pw;
            }
#pragma unroll
            for (int nt = 0; nt < 9; ++nt) { u32x2 cwd; cwd.x = cvt_pk_bf16(C[nt][0], C[nt][1]); cwd.y = cvt_pk_bf16(C[nt][2], C[nt][3]); *(LAS u32x2*)(C0 + (nt * 16 + fr) * QS_LD + w * 16 + 4 * fq) = cwd; }
        }
        {
            const bf16x8 a0 = *(const LAS bf16x8*)(KT + jsw(w * 16 + fr, fq * 8)), a1 = *(const LAS bf16x8*)(KT + jsw(w * 16 + fr, 32 + fq * 8));
#pragma unroll
            for (int nt = 0; nt < 9; ++nt) { C[nt] *= decay;
                C[nt] = mfma16(a0, *(const LAS bf16x8*)(VT + jsw(nt * 16 + fr, fq * 8)), C[nt]); C[nt] = mfma16(a1, *(const LAS bf16x8*)(VT + jsw(nt * 16 + fr, 32 + fq * 8)), C[nt]); }
        }
        __syncthreads();
        if (lat) {
            const int it = w >> 1, dvh = w & 1, i = it * 16 + fr;
            f32x4 ac[5];
#pragma unroll
            for (int t = 0; t < 5; ++t) ac[t] = (f32x4){0.f, 0.f, 0.f, 0.f};
#pragma unroll
            for (int ks = 0; ks < 4; ++ks) { const bf16x8 bq = *(const LAS bf16x8*)(Qs + i * QS_LD + ks * 32 + fq * 8);
#pragma unroll
                for (int t = 0; t < 5; ++t) { const int row = (t < 4 ? (dvh * 4 + t) * 16 : 128) + fr; ac[t] = mfma16(*(const LAS bf16x8*)(C0 + row * QS_LD + ks * 32 + fq * 8), bq, ac[t]); } }
            const float ai = sc_a[i];
#pragma unroll
            for (int t = 0; t < 5; ++t) ac[t] *= ai;
#pragma unroll
            for (int ks = 0; ks < 2; ++ks) { const bf16x8 bp = *(const LAS bf16x8*)(Ps + i * JS_LD + ks * 32 + fq * 8);
#pragma unroll
                for (int t = 0; t < 5; ++t) { const int row = (t < 4 ? (dvh * 4 + t) * 16 : 128) + fr; ac[t] = mfma16(*(const LAS bf16x8*)(VT + jsw(row, ks * 32 + fq * 8)), bp, ac[t]); } }
            const float den = fmaxf(fabsf(ac[4][0]), sc_e[i]); const float rd = 1.0f / den;
            const size_t row = rbase + t0 + (dir ? 63 - i : i);
#pragma unroll
            for (int t = 0; t < 4; ++t) { u32x2 hw; hw.x = cvt_pk_bf16(ac[t][0] * rd, ac[t][1] * rd); hw.y = cvt_pk_bf16(ac[t][2] * rd, ac[t][3] * rd);
                *(u32x2*)(HO + row * 1024 + h * 128 + (dvh * 4 + t) * 16 + 4 * fq) = hw; }
        }
        m0 = m0n;
        __syncthreads();
    }
#undef ML_LOAD
#undef ML_CHUNK
}

__device__ __forceinline__ void phase_combine(const Params& p) {
    const bf16_t* HF = (const bf16_t*)(p.ws + WS_H); const bf16_t* HB = HF + (size_t)NLAT * 1024; const bf16_t* MO = (const bf16_t*)(p.ws + WS_MO);
    bf16_t* AT = (bf16_t*)(p.ws + WS_ATT);
    const int tid = otid(), c8 = (tid & 127) * 8, rq = tid >> 7;
    f32x4 g0 = *(const f32x4*)(p.m_gain + c8), g1 = *(const f32x4*)(p.m_gain + c8 + 4);
    for (int r = blockIdx.x * 4 + rq; r < NLAT; r += gridDim.x * 4) {
        const bf16x8 a = *(const bf16x8*)(HF + (size_t)r * 1024 + c8), bb = *(const bf16x8*)(HB + (size_t)r * 1024 + c8), mo = *(const bf16x8*)(MO + (size_t)r * 1024 + c8);
        float x[8], ss = 0.f;
#pragma unroll
        for (int e = 0; e < 8; ++e) { x[e] = bf2f((unsigned short)a[e]) + bf2f((unsigned short)bb[e]); ss += x[e] * x[e]; }
        ss += __shfl_xor(ss, 1); ss += __shfl_xor(ss, 2); ss += __shfl_xor(ss, 4); ss += __shfl_xor(ss, 8);
        const float rs = rsqrtf(ss * (1.0f / 128.0f) + RMS_EPS);
        float y[8];
#pragma unroll
        for (int e = 0; e < 8; ++e) y[e] = x[e] * rs * (e < 4 ? g0[e] : g1[e - 4]) * bf2f((unsigned short)mo[e]);
        u32x4 wv; wv.x = cvt_pk_bf16(y[0], y[1]); wv.y = cvt_pk_bf16(y[2], y[3]); wv.z = cvt_pk_bf16(y[4], y[5]); wv.w = cvt_pk_bf16(y[6], y[7]);
        *(u32x4*)(AT + (size_t)r * 2048 + 1024 + c8) = wv;
    }
}

__device__ __forceinline__ void combine_item(const Params& p, int b, int h, int t0) {
    const bf16_t* HF = (const bf16_t*)(p.ws + WS_H); const bf16_t* HB = HF + (size_t)NLAT * 1024; const bf16_t* MO = (const bf16_t*)(p.ws + WS_MO);
    bf16_t* AT = (bf16_t*)(p.ws + WS_ATT);
    const int tid = otid(), c8 = (tid & 15) * 8, tr = tid >> 4;
    const f32x4 g0 = *(const f32x4*)(p.m_gain + h * 128 + c8), g1 = *(const f32x4*)(p.m_gain + h * 128 + c8 + 4);
    for (int it = 0; it < 16; it += 4) {
        bf16x8 a[4], bb[4], mo[4];
#pragma unroll
        for (int q = 0; q < 4; ++q) { const size_t r = (size_t)b * TL + t0 + (it + q) * 32 + tr; const size_t o = r * 1024 + h * 128 + c8;
            a[q] = *(const bf16x8*)(HF + o); bb[q] = *(const bf16x8*)(HB + o); mo[q] = *(const bf16x8*)(MO + o); }
#pragma unroll
        for (int q = 0; q < 4; ++q) {
            float x[8], ss = 0.f;
#pragma unroll
            for (int e = 0; e < 8; ++e) { x[e] = bf2f((unsigned short)a[q][e]) + bf2f((unsigned short)bb[q][e]); ss += x[e] * x[e]; }
            ss += __shfl_xor(ss, 1); ss += __shfl_xor(ss, 2); ss += __shfl_xor(ss, 4); ss += __shfl_xor(ss, 8);
            const float rs = rsqrtf(ss * (1.0f / 128.0f) + RMS_EPS);
            float y[8];
#pragma unroll
            for (int e = 0; e < 8; ++e) y[e] = x[e] * rs * (e < 4 ? g0[e] : g1[e - 4]) * bf2f((unsigned short)mo[q][e]);
            u32x4 wv; wv.x = cvt_pk_bf16(y[0], y[1]); wv.y = cvt_pk_bf16(y[2], y[3]); wv.z = cvt_pk_bf16(y[4], y[5]); wv.w = cvt_pk_bf16(y[6], y[7]);
            const size_t r = (size_t)b * TL + t0 + (it + q) * 32 + tr;
            *(u32x4*)(AT + r * 2048 + 1024 + h * 128 + c8) = wv;
        }
    }
}

#define XB_TMO      128
#define XB_XCNT(j)  (256  + 64 * (j))
#define XB_XSUB(j)  (1280 + 64 * (j))
#define XB_XGEN(j)  (2304 + 64 * (j))
#define XB_TOP      3328
#define XB_TOPGEN   3392
#define XCD_BAR_WORDS 3456
#define XB_SPIN_CAP (1u << 22)
__device__ __forceinline__ unsigned xb_ld(unsigned* p)              { return __hip_atomic_load(p, __ATOMIC_RELAXED, __HIP_MEMORY_SCOPE_AGENT); }
__device__ __forceinline__ unsigned xb_add(unsigned* p, unsigned v) { return __hip_atomic_fetch_add(p, v, __ATOMIC_RELAXED, __HIP_MEMORY_SCOPE_AGENT); }
__device__ __forceinline__ unsigned xb_xcc_id() { return (unsigned)__builtin_amdgcn_s_getreg((3 << 11) | 20) & 0xFu; }
#define XB_SPIN(cond, bar) do { unsigned _sp = 0; while (cond) { __builtin_amdgcn_s_sleep(1); \
    if ((++_sp & 255u) == 0u) { if (xb_ld(&(bar)[XB_TMO])) break; if (_sp > XB_SPIN_CAP) { atomicAdd(&(bar)[XB_TMO], 1u); break; } } } } while (0)
struct XcdBarrier { unsigned* bar; unsigned x; volatile LAS unsigned* st; };
__device__ __forceinline__ XcdBarrier xcd_barrier_post(unsigned* bar, volatile LAS unsigned* st) {
    XcdBarrier b; b.bar = bar; b.x = xb_xcc_id(); b.st = st;
    if (threadIdx.x == 0) (void)xb_add(&bar[XB_XCNT(b.x)], 1u);
    return b;
}
__device__ __forceinline__ void xcd_barrier_complete(unsigned* bar, unsigned x, unsigned& nloc, unsigned& nx) {
    const unsigned G = gridDim.x * gridDim.y * gridDim.z;
    unsigned sum, cnt, mine, sp = 0u;
    for (;;) {
        sum = 0u; cnt = 0u; mine = 0u;
#pragma unroll
        for (unsigned j = 0; j < 16; ++j) { const unsigned c = xb_ld(&bar[XB_XCNT(j)]); sum += c; cnt += (c > 0u) ? 1u : 0u; mine = (j == x) ? c : mine; }
        if (sum == G) break;
        __builtin_amdgcn_s_sleep(1);
        if ((++sp & 255u) == 0u) { if (xb_ld(&bar[XB_TMO])) break; if (sp > XB_SPIN_CAP) { atomicAdd(&bar[XB_TMO], 1u); break; } }
    }
    nloc = mine > 0u ? mine : 1u; nx = cnt > 0u ? cnt : 1u;
}
__device__ __forceinline__ void xcd_barrier(const XcdBarrier& b) {
    asm volatile("s_waitcnt vmcnt(0)" ::: "memory");
    __syncthreads();
    if (threadIdx.x == 0) {
        unsigned* bar = b.bar;
        __builtin_amdgcn_s_waitcnt(0);
        unsigned nloc = b.st[0], nx = b.st[1];
        if (nloc == 0u) { xcd_barrier_complete(bar, b.x, nloc, nx); b.st[0] = nloc; b.st[1] = nx; }
        const unsigned old = xb_add(&bar[XB_XSUB(b.x)], 1u);
        const unsigned gen = old / nloc;
        if (old + 1u == (gen + 1u) * nloc) {
            __builtin_amdgcn_fence(__ATOMIC_RELEASE, "agent");
            asm volatile("s_waitcnt vmcnt(0)" ::: "memory");
            const unsigned og = xb_add(&bar[XB_TOP], 1u);
            const unsigned tg = og / nx;
            if (og + 1u == (tg + 1u) * nx) xb_add(&bar[XB_TOPGEN], 1u);
            else XB_SPIN(xb_ld(&bar[XB_TOPGEN]) == tg, bar);
            __builtin_amdgcn_fence(__ATOMIC_ACQUIRE, "agent");
            xb_add(&bar[XB_XGEN(b.x)], 1u);
            asm volatile("s_waitcnt vmcnt(0)" ::: "memory");
        } else {
            XB_SPIN(xb_ld(&bar[XB_XGEN(b.x)]) == gen, bar);
            __builtin_amdgcn_fence(__ATOMIC_ACQUIRE, "agent");
            asm volatile("s_waitcnt vmcnt(0)" ::: "memory");
        }
    }
    __syncthreads();
}

__device__ __forceinline__ void panel_handoff(unsigned* cnt, unsigned need) {
    asm volatile("s_waitcnt vmcnt(0)" ::: "memory"); __syncthreads();
    if (threadIdx.x == 0) {
        __builtin_amdgcn_fence(__ATOMIC_RELEASE, "agent"); asm volatile("s_waitcnt vmcnt(0)" ::: "memory");
        (void)__hip_atomic_fetch_add(cnt, 1u, __ATOMIC_RELAXED, __HIP_MEMORY_SCOPE_AGENT);
        unsigned sp = 0u; while (__hip_atomic_load(cnt, __ATOMIC_RELAXED, __HIP_MEMORY_SCOPE_AGENT) < need) { __builtin_amdgcn_s_sleep(1); if (++sp > (1u << 22)) break; }
        __builtin_amdgcn_fence(__ATOMIC_ACQUIRE, "agent"); asm volatile("s_waitcnt vmcnt(0)" ::: "memory");
    }
    __syncthreads();
}

__global__ void __launch_bounds__(512, 2) fwd_megakernel(Params p0) {
    extern __shared__ __attribute__((aligned(16))) unsigned char lds_raw[];
    LAS unsigned char* lds = (LAS unsigned char*)lds_raw;
    if (threadIdx.x < 16) ((LAS unsigned*)(lds + LDS_CTL))[threadIdx.x] = 0u;
    __syncthreads();
    XcdBarrier xbar; xbar.bar = (unsigned*)(p0.ws + WS_BAR); xbar.x = 0; xbar.st = (volatile LAS unsigned*)(lds + LDS_CTL + 16);
    if (p0.ph_hi - p0.ph_lo > 1) xbar = xcd_barrier_post((unsigned*)(p0.ws + WS_BAR), (volatile LAS unsigned*)(lds + LDS_CTL + 16));
    for (int ph = p0.ph_lo; ph < p0.ph_hi; ++ph) {
#if defined(__HIP_DEVICE_COMPILE__)
        const __attribute__((address_space(4))) Params* pp = (const __attribute__((address_space(4))) Params*)__builtin_amdgcn_kernarg_segment_ptr();
        asm volatile("" : "+s"(pp));
        const Params p = *pp;
        int G = gridDim.x, bid = blockIdx.x; asm volatile("" : "+s"(G), "+s"(bid));
#else
        const Params p = p0; int G = 0, bid = 0;
#endif
        unsigned char* ws = p.ws;
        float* mod = (float*)(ws + WS_MOD);
        const bool fuse = (G == 256) && (p0.ph_hi - p0.ph_lo > 1);
        if (fuse && (ph == 7 || ph == 9 || ph == 12)) continue;
        for (int rep = 0; rep < (((DUPMASK >> ph) & 1) ? 2 : 1); ++rep)
        if (HAS(0) && ph == 0) {
            phase_prep(p, lds, rep == 0);
        } else if (HAS(1) && (ph == 1 || ph == 4 || ph == 9)) {
            const float* sl = ph == 1 ? p.x : p.out; const float* scx = p.ctx;
            const int nrows = ph == 9 ? NLAT : MR, midx = ph == 1 ? 0 : (ph == 4 ? 3 : 6);
            if (fuse && ph == 4)
                phase_rows<0>(sl, scx, MR, p.g_norm + DM, mod, 3, (bf16_t*)(ws + WS_H), nullptr, (const float*)(ws + WS_PART), NLAT + bid * 8, G * 8);
            else
            phase_rows<0>(sl, scx, nrows, p.g_norm + (ph == 1 ? 0 : (ph == 4 ? 1 : 2)) * DM, mod, midx, (bf16_t*)(ws + WS_H), nullptr, ph == 4 ? (const float*)(ws + WS_PART) : nullptr);
        } else if (HAS(2) && (ph == 2 || ph == 10)) {
            pg8::Gemm g{(const bf16_t*)(ws + WS_H), (const bf16_t*)(ws + (ph == 2 ? WS_WUP1 : WS_WUP2)), ph == 2 ? MR : NLAT, NUP, DM, DM};
            pg8::StaticOrder S; S.init(g.M, g.N, G, bid);
            EpiSwiglu E{(bf16_t*)(ws + WS_HID)};
            pg8::gemm_phase<EpiSwiglu>(lds, g, S, E);
            if (ph == 2) { const int busy = S.nwg % G; if (busy != 0 && bid >= busy) prep_weights(p, lds, 1, bid - busy, G - busy); else if (busy == 0) prep_weights(p, lds, 1, bid, G); }
        } else if (HAS(3) && (ph == 3 || ph == 8 || ph == 11)) {
            pg8::Gemm g;
            if (ph == 3) g = pg8::Gemm{(const bf16_t*)(ws + WS_HID), (const bf16_t*)(ws + WS_WDN1), NLAT, DM, DFF, DFF};
            else if (ph == 8) g = pg8::Gemm{(const bf16_t*)(ws + WS_ATT), (const bf16_t*)(ws + WS_WOUT), NLAT, DM, DM, DM};
            else g = pg8::Gemm{(const bf16_t*)(ws + WS_HID), (const bf16_t*)(ws + WS_WDN2), NLAT, DM, DFF, DFF};
            pg8::StaticOrder S; S.init(g.M, g.N, G, bid);
            EpiResid E{ph == 3 ? p.x : p.out, p.ctx, p.out, nullptr, mod, ph == 3 ? 2 : (ph == 8 ? 5 : 8), ph == 8 ? 1.0f : 0.5f};
            pg8::gemm_phase<EpiResid>(lds, g, S, E);
            if (fuse) {
                pg8::Unit u0; S.next(0, u0);
                unsigned* cnt = (unsigned*)(ws + WS_PCNT) + ((ph == 3 ? 0 : (ph == 8 ? 1 : 2)) * 64 + u0.pm) * 64;
                panel_handoff(cnt, 4u);
                const int r0 = u0.pm * 256 + (u0.pn & 3) * 64;
                if (ph == 11) phase_rows<1>(p.out, nullptr, r0 + 64, p.g_final, nullptr, 0, nullptr, p.out, nullptr, r0, 8);
                else phase_rows<0>(p.out, nullptr, r0 + 64, p.g_norm + (ph == 3 ? 1 : 2) * DM, mod, ph == 3 ? 3 : 6, (bf16_t*)(ws + WS_H), nullptr, nullptr, r0, 8);
            }
            if (ph == 3) {
                pg8::Gemm g2{(const bf16_t*)(ws + WS_HID), (const bf16_t*)(ws + WS_WDN1), NCTX, DM, DFF / 4, DFF};
                pg8::StaticOrder S2; S2.init(NCTX, DM, G, bid, 64, 4);
                EpiPartial E2{(float*)(ws + WS_PART)};
                pg8::gemm_phase<EpiPartial>(lds, g2, S2, E2);
            }
        } else if (HAS(5) && ph == 5) {
            pg8::Gemm g{(const bf16_t*)(ws + WS_H), (const bf16_t*)(ws + WS_WIN), MR, PWP, DM, DM};
            pg8::StaticOrder S; S.init(g.M, g.N, G, bid);
            EpiWin E{(bf16_t*)(ws + WS_Q), (bf16_t*)(ws + WS_K), (bf16_t*)(ws + WS_V), (bf16_t*)(ws + WS_MQK), (bf16_t*)(ws + WS_MV), (bf16_t*)(ws + WS_MO), (float*)(ws + WS_GT),
                     p.q_gain, p.k_gain, p.gate_b, (const float*)(ws + WS_ROPE), (LAS float*)(lds + LDS_RED)};
            pg8::gemm_phase<EpiWin>(lds, g, S, E);
            { const int busy = S.nwg % G; if (busy != 0 && bid >= busy) prep_weights(p, lds, 2, bid - busy, G - busy); else if (busy == 0) prep_weights(p, lds, 2, bid, G); }
        } else if (HAS(6) && ph == 6) {
#if !defined(NO_MLSTM)
            for (int s = bid; s < 128 && rep == 0; s += G) { mlstm_stream(p, lds, s);
                if (fuse) {
                    asm volatile("s_waitcnt vmcnt(0)" ::: "memory"); __syncthreads();
                    if (otid() == 0) { __builtin_amdgcn_fence(__ATOMIC_RELEASE, "agent"); asm volatile("s_waitcnt vmcnt(0)" ::: "memory");
                        (void)__hip_atomic_fetch_add((unsigned*)(ws + WS_PCNT) + (3 * 64 + (s >> 1)) * 64, 1u, __ATOMIC_RELAXED, __HIP_MEMORY_SCOPE_AGENT); } } }
#endif
#if !defined(NO_ATTN)
            {
                int* ctr = (int*)(ws + WS_CTR) + rep * 8;
                for (int qi = 0; qi < 8; ++qi) {
                    const int bq = (bid + qi) & 7;
                    for (;;) {
                        __syncthreads();
                        if (otid() == 0) { int v = __hip_atomic_load(ctr + bq, __ATOMIC_RELAXED, __HIP_MEMORY_SCOPE_AGENT); if (v < 64) v = atomicAdd(ctr + bq, 1); *(LAS int*)(lds + LDS_CTL) = v; }
                        __syncthreads();
                        const int u = *(LAS int*)(lds + LDS_CTL);
                        if (u >= 64) break;
                        attn_unit(p, lds_raw, bq * 64 + u);
                    }
                }
            }
#endif
            if (fuse) {
                unsigned* pc = (unsigned*)(ws + WS_PCNT);
                for (;;) {
                    __syncthreads();
                    if (otid() == 0) { unsigned v = __hip_atomic_fetch_add(pc + 4 * 64 * 64, 1u, __ATOMIC_RELAXED, __HIP_MEMORY_SCOPE_AGENT);
                        if (v < 256u) { unsigned* c2 = pc + (3 * 64 + (v >> 2)) * 64; unsigned sp = 0u;
                            while (__hip_atomic_load(c2, __ATOMIC_RELAXED, __HIP_MEMORY_SCOPE_AGENT) < 2u) { __builtin_amdgcn_s_sleep(1); if (++sp > (1u << 22)) break; }
                            __builtin_amdgcn_fence(__ATOMIC_ACQUIRE, "agent"); asm volatile("s_waitcnt vmcnt(0)" ::: "memory"); }
                        *(LAS int*)(lds + LDS_CTL) = (int)v; }
                    __syncthreads();
                    const int v = *(LAS int*)(lds + LDS_CTL);
                    if (v >= 256) break;
                    combine_item(p, v >> 5, (v >> 2) & 7, (v & 3) * 512);
                }
            }
        } else if (HAS(7) && ph == 7) {
            phase_combine(p);
        } else if (HAS(12) && ph == 12) {
            phase_rows<1>(p.out, nullptr, NLAT, p.g_final, nullptr, 0, nullptr, p.out, nullptr);
        }
        if (ph + 1 < p0.ph_hi && !(fuse && ph == 11)) {
            if (p0.ph_hi > 1000) cg::this_grid().sync(); else xcd_barrier(xbar);
        }
    }
}

extern "C" void kernel_launch(void* const* d_in, const int* in_sizes, int n_in, void* d_out, int out_size, void* d_ws, size_t ws_size, hipStream_t stream) {
    static int grid = 0;
    if (grid == 0) {
        if (n_in != 20 || out_size != NLAT * DM || ws_size < WS_END) { fprintf(stderr, "kernel_launch: unexpected shapes (n_in %d out %d ws %zu need %zu)\n", n_in, out_size, ws_size, (size_t)WS_END); grid = -1; return; }
        int dev = 0, cus = 0, per_cu = 0;
        hipGetDevice(&dev); hipDeviceGetAttribute(&cus, hipDeviceAttributeMultiprocessorCount, dev);
        if (hipFuncSetAttribute((const void*)fwd_megakernel, hipFuncAttributeMaxDynamicSharedMemorySize, LDS_BYTES) != hipSuccess) { fprintf(stderr, "kernel_launch: hipFuncSetAttribute failed\n"); grid = -1; return; }
        hipOccupancyMaxActiveBlocksPerMultiprocessor(&per_cu, (const void*)fwd_megakernel, 512, LDS_BYTES);
        if (per_cu < 1) { fprintf(stderr, "kernel_launch: occupancy query says %d blocks per CU\n", per_cu); per_cu = 1; }
        (void)hipGetLastError();
        grid = cus * 1;
    }
    if (grid < 0) return;
    (void)hipMemsetAsync((char*)d_ws + WS_MOD, 0, (size_t)(WS_ROPE - WS_MOD), stream);
    Params p{};
    p.x = (const float*)d_in[0]; p.c = (const float*)d_in[1]; p.ctx = (const float*)d_in[2]; p.c_ctx = (const float*)d_in[3]; p.w_mod = (const float*)d_in[4]; p.b_mod = (const float*)d_in[5];
    p.g_norm = (const float*)d_in[6]; p.w_up1 = (const float*)d_in[7]; p.w_dn1 = (const float*)d_in[8]; p.w_up2 = (const float*)d_in[9]; p.w_dn2 = (const float*)d_in[10]; p.w_in = (const float*)d_in[11];
    p.q_gain = (const float*)d_in[12]; p.k_gain = (const float*)d_in[13]; p.conv_w = (const float*)d_in[14]; p.conv_b = (const float*)d_in[15]; p.gate_b = (const float*)d_in[16]; p.m_gain = (const float*)d_in[17];
    p.w_out = (const float*)d_in[18]; p.g_final = (const float*)d_in[19]; p.out = (float*)d_out; p.ws = (unsigned char*)d_ws;
#if MK_MULTI
    for (int ph = 0; ph < NPH; ++ph) { p.ph_lo = ph; p.ph_hi = ph + 1; hipLaunchKernelGGL(fwd_megakernel, dim3(grid), dim3(512), LDS_BYTES, stream, p); }
#else
    p.ph_lo = 0; p.ph_hi = NPH;
    void* args[] = {&p};
    hipError_t e = hipLaunchCooperativeKernel((const void*)fwd_megakernel, dim3(grid), dim3(512), args, LDS_BYTES, stream);
    if (e != hipSuccess) fprintf(stderr, "cooperative launch failed: %s (grid %d)\n", hipGetErrorString(e), grid);
#endif
}
```

```cpp
#include <hip/hip_runtime.h>
#include <hip/hip_cooperative_groups.h>
#include <cstdio>
#include <cstdint>
namespace cg = cooperative_groups;

#define LAS __attribute__((address_space(3)))
typedef unsigned short bf16_t;
typedef short bf16x8 __attribute__((ext_vector_type(8)));
typedef short s16x4 __attribute__((ext_vector_type(4)));
typedef float f32x4 __attribute__((ext_vector_type(4)));
typedef float f32x16 __attribute__((ext_vector_type(16)));
typedef unsigned u32x4 __attribute__((ext_vector_type(4)));
typedef unsigned u32x2 __attribute__((ext_vector_type(2)));

#ifndef PHMASK
#define PHMASK 0x1fff
#endif
#define HAS(k) ((PHMASK >> (k)) & 1)
#ifndef DUPMASK
#define DUPMASK 0
#endif
#ifndef MK_MULTI
#define MK_MULTI 0
#endif

constexpr int DM = 2048, NB = 8, TL = 2048, TCX = 256, NLAT = NB * TL, NCTX = NB * TCX, MR = NLAT + NCTX;
constexpr int DFF = 5632, NUP = 2 * DFF, PW = 5664, PWP = 5888, NMOD = 9, MODW = NMOD * DM;
constexpr int SKV = TCX + TL;
constexpr float RMS_EPS = 1e-6f;
constexpr int NPH = 13;

constexpr size_t al256(size_t x) { return (x + 255) / 256 * 256; }
constexpr size_t WS_MOD = 0;
constexpr size_t WS_CTR = WS_MOD + (size_t)9 * MODW * 4;
constexpr size_t WS_BAR = WS_CTR + 256;
constexpr size_t WS_PCNT = al256(WS_BAR + 3456 * 4);
constexpr size_t WS_ROPE = WS_PCNT + (size_t)(5 * 64 + 1) * 256;
constexpr size_t WS_WUP1 = al256(WS_ROPE + 4096 * 4);
constexpr size_t WS_WDN1 = WS_WUP1 + (size_t)NUP * DM * 2;
constexpr size_t WS_WIN = WS_WDN1 + (size_t)DM * DFF * 2;
constexpr size_t WS_WOUT = WS_WIN + (size_t)PWP * DM * 2;
constexpr size_t WS_WUP2 = WS_WOUT + (size_t)DM * DM * 2;
constexpr size_t WS_WDN2 = WS_WUP2 + (size_t)NUP * DM * 2;
constexpr size_t WS_H = WS_WDN2 + (size_t)DM * DFF * 2;
constexpr size_t WS_HID = WS_H + (size_t)MR * DM * 2;
constexpr size_t WS_Q = WS_HID;
constexpr size_t WS_K = WS_Q + (size_t)NLAT * 1024 * 2;
constexpr size_t WS_V = WS_K + (size_t)NB * SKV * 256 * 2;
constexpr size_t WS_MQK = WS_V + (size_t)NB * SKV * 256 * 2;
constexpr size_t WS_MV = WS_MQK + (size_t)MR * 2048 * 2;
constexpr size_t WS_MO = WS_MV + (size_t)MR * 1024 * 2;
constexpr size_t WS_GT = WS_MO + (size_t)NLAT * 1024 * 2;
constexpr size_t WS_PROJ_END = WS_GT + (size_t)MR * 32 * 4;
constexpr size_t WS_ATT = WS_HID + (size_t)MR * DFF * 2;
constexpr size_t WS_PART = WS_ATT;
constexpr size_t WS_XC = WS_ATT + (size_t)NLAT * 2048 * 2;
constexpr size_t WS_END = WS_XC + (size_t)NCTX * DM * 4;
static_assert(WS_PROJ_END <= WS_ATT, "projection outputs must fit in the hidden buffer");

constexpr int LDS_STAGE = 131072;
constexpr int LDS_RED = LDS_STAGE;
constexpr int LDS_CTL = LDS_STAGE + 8192;
constexpr int LDS_BYTES = LDS_CTL + 64;
constexpr int QS_LD = 136, JS_LD = 72;
constexpr int ML_QS = 0, ML_KS = ML_QS + 64 * QS_LD * 2, ML_KT = ML_KS + 64 * QS_LD * 2, ML_VT = ML_KT + 128 * 64 * 2, ML_PS = ML_VT + 144 * 64 * 2,
              ML_C0 = ML_PS + 64 * JS_LD * 2, ML_SC = ML_C0 + 144 * QS_LD * 2, ML_CW = ML_SC + 5 * 64 * 4, ML_CB = ML_CW + 5 * 256 * 4, ML_END = ML_CB + 256 * 4;
static_assert(ML_END <= LDS_BYTES, "mLSTM LDS");

struct Params {
    const float *x, *c, *ctx, *c_ctx, *w_mod, *b_mod, *g_norm, *w_up1, *w_dn1, *w_up2, *w_dn2, *w_in, *q_gain, *k_gain, *conv_w, *conv_b, *gate_b, *m_gain, *w_out, *g_final;
    float* out; unsigned char* ws; int ph_lo, ph_hi;
};

__device__ __forceinline__ int otid() { int t = threadIdx.x; asm volatile("" : "+v"(t)); return t; }
__device__ __forceinline__ unsigned cvt_pk_bf16(float lo, float hi) { unsigned r; asm volatile("v_cvt_pk_bf16_f32 %0, %1, %2" : "=v"(r) : "v"(lo), "v"(hi)); return r; }
__device__ __forceinline__ float bf2f(unsigned short v) { return __uint_as_float(((unsigned)v) << 16); }
__device__ __forceinline__ float silu_f(float x) { return x * __builtin_amdgcn_rcpf(1.0f + __expf(-x)); }
__device__ __forceinline__ float sigmoid_f(float x) { return __builtin_amdgcn_rcpf(1.0f + __expf(-x)); }
__device__ __forceinline__ float logsigmoid_f(float x) { return fminf(x, 0.f) - __logf(1.0f + __expf(-fabsf(x))); }

namespace pg8 {
constexpr int BM = 256, BK = 64, HALF = 128, HTB = HALF * BK * 2, NXCD = 8, WGM = 8;
__device__ __forceinline__ int lds_byte(int r, int c) { const int st = (r >> 4) * 2 + (c >> 5), rr = r & 15, cc = c & 31, ob = rr * 64 + cc * 2; return st * 1024 + (ob ^ (((ob >> 9) & 1) << 5)); }
__device__ __forceinline__ void stage_rc(int b, int& R, int& C) { const int st = b / 1024, sb = b % 1024, swz = sb ^ (((sb >> 9) & 1) << 5); R = (st >> 1) * 16 + swz / 64; C = (st & 1) * 32 + (swz % 64) / 2; }
__device__ __forceinline__ int perm32(int rho) { const int n = rho >> 4, i = rho & 15; return 8 * (i >> 2) + 4 * n + (i & 3); }
struct Unit { int pm, pn, ks; };
struct Gemm { const bf16_t* A; const bf16_t* Bt; int M, N, K, ld; };
struct StaticOrder {
    int nM, nN, nwg, G, c, pm0, nNr;
    __device__ void init(int M, int N, int G_, int c_, int pm0_ = 0, int ksplit = 1) { nM = M / BM; nNr = N / BM; nN = nNr * ksplit; nwg = nM * nN; G = G_; c = c_; pm0 = pm0_; }
    __device__ bool next(int i, Unit& u) const {
        const long L = (long)i * G + c; if (L >= nwg) return false;
        int wgid = (int)L; { const int q = nwg / NXCD, r = nwg % NXCD, xcd = wgid % NXCD, off = wgid / NXCD; wgid = (xcd < r ? xcd * (q + 1) : r * (q + 1) + (xcd - r) * q) + off; }
        const int nig = WGM * nN, gid = wgid / nig, fm = gid * WGM, gsz = (nM - fm) < WGM ? (nM - fm) : WGM;
        u.pm = pm0 + fm + ((wgid % nig) % gsz); const int pe = (wgid % nig) / gsz; u.pn = pe % nNr; u.ks = pe / nNr; return true;
    }
};

template <class Epi>
__device__ __forceinline__ void gemm_phase(LAS unsigned char* lds, const Gemm g, const StaticOrder& S, const Epi& E) {
    const int tid = otid(), wid = __builtin_amdgcn_readfirstlane(tid >> 6), lane = tid & 63, wr = wid >> 2, wc = wid & 3, fr = lane & 15, fq = lane >> 4;
    const int K = g.K, nt = K / BK;
    unsigned voffA[2], voffB[2];
#pragma unroll
    for (int i = 0; i < 2; ++i) { int R, C; stage_rc(tid * 16 + i * 8192, R, C); const int Rb = Epi::PERM ? ((R & ~31) + perm32(R & 31)) : R;
        voffA[i] = (unsigned)(R * g.ld + C) * 2u; voffB[i] = (unsigned)(Rb * g.ld + C) * 2u; }
    const size_t kstep = (size_t)(BK * 2);
    const size_t hstep = (size_t)HALF * g.ld * 2;
    const size_t ksB = (size_t)K * 2;
    const size_t tstep = 2 * hstep;
    const unsigned ldsw = (unsigned)wid * 1024u;
    const int aoff = lds_byte(wr * 64 + fr, fq * 8), boff = lds_byte(wc * 32 + fr, fq * 8);
#define PG8_SA(b, h) (((b) * 2 + (h)) * HTB)
#define PG8_SB(b, h) ((4 + (b) * 2 + (h)) * HTB)
#define PG8_STAGE(bufoff, gbase, voff) do { _Pragma("unroll") for (int _i = 0; _i < 2; ++_i) \
        __builtin_amdgcn_global_load_lds((const unsigned*)((const char*)(gbase) + (voff)[_i]), (LAS unsigned*)(lds + (bufoff) + ldsw + _i * 8192), 16, 0, 0); } while (0)
#define PG8_LDA(dst, b, h) do { _Pragma("unroll") for (int m = 0; m < 4; ++m) _Pragma("unroll") for (int k = 0; k < 2; ++k) dst[m][k] = *(const LAS bf16x8*)(lds + PG8_SA(b, h) + aoff + m * 2048 + k * 1024); } while (0)
#define PG8_LDB(dst, b, h) do { _Pragma("unroll") for (int n = 0; n < 2; ++n) _Pragma("unroll") for (int k = 0; k < 2; ++k) dst[n][k] = *(const LAS bf16x8*)(lds + PG8_SB(b, h) + boff + n * 2048 + k * 1024); } while (0)
#define PG8_MMA(ai, bj, At, Bt) do { __builtin_amdgcn_s_setprio(1); _Pragma("unroll") for (int m = 0; m < 4; ++m) _Pragma("unroll") for (int n = 0; n < 2; ++n) _Pragma("unroll") for (int k = 0; k < 2; ++k) \
        acc[ai][bj][m][n] = __builtin_amdgcn_mfma_f32_16x16x32_bf16(Bt[n][k], At[m][k], acc[ai][bj][m][n], 0, 0, 0); __builtin_amdgcn_s_setprio(0); } while (0)
#define PG8_WAIT_V(n) asm volatile("s_waitcnt vmcnt(" #n ")" ::: "memory")
#define PG8_WAIT_L(n) asm volatile("s_waitcnt lgkmcnt(" #n ")" ::: "memory")
#define PG8_BAR __builtin_amdgcn_s_barrier()
#define PG8_SCHED __builtin_amdgcn_sched_barrier(0)
    Unit cur, nxt; int ui = 0;
    if (!S.next(0, cur)) return;
    f32x4 acc[2][2][4][2];
#pragma unroll
    for (int a = 0; a < 2; ++a)
#pragma unroll
        for (int b = 0; b < 2; ++b)
#pragma unroll
            for (int m = 0; m < 4; ++m)
#pragma unroll
                for (int n = 0; n < 2; ++n) acc[a][b][m][n] = (f32x4){0.f, 0.f, 0.f, 0.f};
    bf16x8 At[4][2], B0[2][2], B1[2][2];
    const char* cA = (const char*)g.A + (size_t)cur.pm * tstep + cur.ks * ksB; const char* cB = (const char*)g.Bt + (size_t)cur.pn * tstep + cur.ks * ksB;
    PG8_STAGE(PG8_SB(0, 0), cB, voffB); PG8_STAGE(PG8_SA(0, 0), cA, voffA); PG8_STAGE(PG8_SB(0, 1), cB + hstep, voffB); PG8_STAGE(PG8_SA(0, 1), cA + hstep, voffA);
    if (wr == 1) PG8_BAR;
    PG8_WAIT_V(4); PG8_BAR;
    PG8_STAGE(PG8_SB(1, 0), cB + kstep, voffB); PG8_STAGE(PG8_SA(1, 0), cA + kstep, voffA); PG8_STAGE(PG8_SB(1, 1), cB + hstep + kstep, voffB);
    PG8_WAIT_V(6); PG8_BAR;
    for (;;) {
        const bool has_next = S.next(ui + 1, nxt);
        const char* nA = has_next ? (const char*)g.A + (size_t)nxt.pm * tstep + nxt.ks * ksB : cA; const char* nB = has_next ? (const char*)g.Bt + (size_t)nxt.pn * tstep + nxt.ks * ksB : cB;
        for (int t = 0; t < nt; t += 2) {
            const bool last = (t == nt - 2);
            const char* a1 = cA + (size_t)(t + 1) * kstep;
            const char* a2 = last ? nA : cA + (size_t)(t + 2) * kstep; const char* b2 = last ? nB : cB + (size_t)(t + 2) * kstep;
            const char* a3 = a2 + kstep; const char* b3 = b2 + kstep;
            PG8_LDB(B0, 0, 0); PG8_SCHED; PG8_LDA(At, 0, 0); PG8_STAGE(PG8_SA(1, 1), a1 + hstep, voffA);
            PG8_WAIT_L(8); PG8_BAR; PG8_WAIT_L(0); PG8_MMA(0, 0, At, B0); PG8_BAR; PG8_SCHED;
            PG8_LDB(B1, 0, 1); PG8_STAGE(PG8_SB(0, 0), b2, voffB);
            PG8_BAR; PG8_WAIT_L(0); PG8_MMA(0, 1, At, B1); PG8_BAR;
            PG8_LDA(At, 0, 1); PG8_STAGE(PG8_SA(0, 0), a2, voffA);
            PG8_BAR; PG8_WAIT_L(0); PG8_MMA(1, 0, At, B0); PG8_BAR; PG8_SCHED;
            PG8_STAGE(PG8_SB(0, 1), b2 + hstep, voffB);
            PG8_WAIT_V(6); PG8_BAR; PG8_MMA(1, 1, At, B1); PG8_BAR;
            PG8_LDB(B0, 1, 0); PG8_SCHED; PG8_LDA(At, 1, 0); PG8_STAGE(PG8_SA(0, 1), a2 + hstep, voffA);
            PG8_WAIT_L(8); PG8_BAR; PG8_WAIT_L(0); PG8_MMA(0, 0, At, B0); PG8_BAR; PG8_SCHED;
            PG8_LDB(B1, 1, 1); PG8_STAGE(PG8_SB(1, 0), b3, voffB);
            PG8_BAR; PG8_WAIT_L(0); PG8_MMA(0, 1, At, B1); PG8_BAR;
            PG8_LDA(At, 1, 1); PG8_STAGE(PG8_SA(1, 0), a3, voffA);
            PG8_BAR; PG8_WAIT_L(0); PG8_MMA(1, 0, At, B0); PG8_BAR; PG8_SCHED;
            PG8_STAGE(PG8_SB(1, 1), b3 + hstep, voffB);
            PG8_WAIT_V(6); PG8_BAR; PG8_MMA(1, 1, At, B1); PG8_BAR;
        }
        E(acc, cur, wr, wc, fr, fq);
        if (!has_next) break;
#pragma unroll
        for (int a = 0; a < 2; ++a)
#pragma unroll
            for (int b = 0; b < 2; ++b)
#pragma unroll
                for (int m = 0; m < 4; ++m)
#pragma unroll
                    for (int n = 0; n < 2; ++n) acc[a][b][m][n] = (f32x4){0.f, 0.f, 0.f, 0.f};
        cur = nxt; cA = nA; cB = nB; ++ui;
    }
    PG8_WAIT_V(0);
    if (wr == 0) PG8_BAR;
    PG8_BAR;
#undef PG8_SA
#undef PG8_SB
#undef PG8_STAGE
#undef PG8_LDA
#undef PG8_LDB
#undef PG8_MMA
#undef PG8_WAIT_V
#undef PG8_WAIT_L
#undef PG8_BAR
#undef PG8_SCHED
}
}

struct EpiSwiglu {
    static constexpr bool PERM = true;
    bf16_t* H;
    __device__ __forceinline__ void operator()(const f32x4 (&acc)[2][2][4][2], const pg8::Unit& u, int wr, int wc, int fr, int fq) const {
        const int row0 = u.pm * 256 + wr * 64 + fr, col0 = u.pn * 128 + wc * 32 + 8 * fq;
#pragma unroll
        for (int ai = 0; ai < 2; ++ai)
#pragma unroll
            for (int m = 0; m < 4; ++m) {
                bf16_t* rowp = H + (size_t)(row0 + ai * 128 + m * 16) * DFF + col0;
                const f32x4 a0 = acc[ai][0][m][0], a1 = acc[ai][0][m][1], b0 = acc[ai][1][m][0], b1 = acc[ai][1][m][1];
                float v[8];
#pragma unroll
                for (int j = 0; j < 4; ++j) { v[j] = silu_f(a0[j]) * b0[j]; v[4 + j] = silu_f(a1[j]) * b1[j]; }
                u32x4 w; w.x = cvt_pk_bf16(v[0], v[1]); w.y = cvt_pk_bf16(v[2], v[3]); w.z = cvt_pk_bf16(v[4], v[5]); w.w = cvt_pk_bf16(v[6], v[7]);
                *(u32x4*)rowp = w;
            }
    }
};
struct EpiResid {
    static constexpr bool PERM = false;
    const float* resid_l; const float* resid_c; float* out_l; float* out_c; const float* mod; int gidx; float coef;
    __device__ __forceinline__ void operator()(const f32x4 (&acc)[2][2][4][2], const pg8::Unit& u, int wr, int wc, int fr, int fq) const {
        const bool isctx = u.pm >= 64; const int b = isctx ? 8 : (u.pm >> 3);
        const int row0 = (isctx ? (u.pm - 64) : u.pm) * 256 + wr * 64 + fr, col0 = u.pn * 256 + wc * 32 + 4 * fq;
        const float* gp = mod + (size_t)(b * NMOD + gidx) * DM + col0;
        const float* rb = isctx ? resid_c : resid_l; float* ob = isctx ? out_c : out_l;
        f32x4 gv[2][2];
#pragma unroll
        for (int bj = 0; bj < 2; ++bj)
#pragma unroll
            for (int n = 0; n < 2; ++n) gv[bj][n] = *(const f32x4*)(gp + bj * 128 + n * 16) * coef;
#pragma unroll
        for (int ai = 0; ai < 2; ++ai)
#pragma unroll
            for (int m = 0; m < 4; ++m) {
                const size_t o = (size_t)(row0 + ai * 128 + m * 16) * DM + col0;
#pragma unroll
                for (int bj = 0; bj < 2; ++bj)
#pragma unroll
                    for (int n = 0; n < 2; ++n) { const f32x4 r = *(const f32x4*)(rb + o + bj * 128 + n * 16); *(f32x4*)(ob + o + bj * 128 + n * 16) = r + gv[bj][n] * acc[ai][bj][m][n]; }
            }
    }
};
struct EpiPartial {
    static constexpr bool PERM = false;
    float* P;
    __device__ __forceinline__ void operator()(const f32x4 (&acc)[2][2][4][2], const pg8::Unit& u, int wr, int wc, int fr, int fq) const {
        const int row0 = (u.pm - 64) * 256 + wr * 64 + fr, col0 = u.pn * 256 + wc * 32 + 4 * fq;
        float* ob = P + (size_t)u.ks * NCTX * DM;
#pragma unroll
        for (int ai = 0; ai < 2; ++ai)
#pragma unroll
            for (int m = 0; m < 4; ++m) {
                const size_t o = (size_t)(row0 + ai * 128 + m * 16) * DM + col0;
#pragma unroll
                for (int bj = 0; bj < 2; ++bj)
#pragma unroll
                    for (int n = 0; n < 2; ++n) *(f32x4*)(ob + o + bj * 128 + n * 16) = acc[ai][bj][m][n];
            }
    }
};
__device__ __forceinline__ int win_src(int slot) {
    if (slot >= PW) return -1;
    if (slot >= 1280) return slot;
    const int head = slot >> 7, s = slot & 127, wc = s >> 5, n = (s >> 4) & 1, fq = (s >> 2) & 3, j = s & 3;
    return head * 128 + (wc >> 1) * 64 + n * 32 + (wc & 1) * 16 + fq * 4 + j;
}
struct EpiWin {
    static constexpr bool PERM = false;
    bf16_t *Q, *K, *V, *MQK, *MV, *MO; float* GT; const float *qg, *kg, *gb, *rope; LAS float* red;
    __device__ __forceinline__ void st4(bf16_t* p, f32x4 v) const { u32x2 w; w.x = cvt_pk_bf16(v[0], v[1]); w.y = cvt_pk_bf16(v[2], v[3]); *(u32x2*)p = w; }
    __device__ __forceinline__ void operator()(const f32x4 (&acc)[2][2][4][2], const pg8::Unit& u, int wr, int wc, int fr, int fq) const {
        asm volatile("" : "+v"(fr), "+v"(fq));
        const int pn = u.pn; const bool isctx = u.pm >= 64;
        const int rt0 = wr * 64 + fr;
        const int grow0 = u.pm * 256 + rt0;
        if (pn <= 4) {
            const float* gain = pn < 4 ? qg : kg;
            const int d1 = (wc >> 1) * 64 + (wc & 1) * 16 + 4 * fq;
            const f32x4 g1 = *(const f32x4*)(gain + d1), g2 = *(const f32x4*)(gain + d1 + 32);
#pragma unroll
            for (int ai = 0; ai < 2; ++ai)
#pragma unroll
                for (int m = 0; m < 4; ++m)
#pragma unroll
                    for (int bj = 0; bj < 2; ++bj) {
                        const f32x4 a = acc[ai][bj][m][0], c = acc[ai][bj][m][1];
                        float ss = a[0] * a[0] + a[1] * a[1] + a[2] * a[2] + a[3] * a[3] + c[0] * c[0] + c[1] * c[1] + c[2] * c[2] + c[3] * c[3];
                        ss += __shfl_xor(ss, 16); ss += __shfl_xor(ss, 32);
                        if (fq == 0) red[((rt0 + ai * 128 + m * 16) * 2 + bj) * 4 + wc] = ss;
                    }
            asm volatile("s_waitcnt lgkmcnt(0)" ::: "memory"); __builtin_amdgcn_s_barrier(); asm volatile("" ::: "memory");
#pragma unroll
            for (int ai = 0; ai < 2; ++ai)
#pragma unroll
                for (int m = 0; m < 4; ++m) {
                    const int rl = rt0 + ai * 128 + m * 16, gr = grow0 + ai * 128 + m * 16;
                    int bidx, tok; if (isctx) { bidx = (gr - NLAT) >> 8; tok = (gr - NLAT) & 255; } else { bidx = gr >> 11; tok = gr & 2047; }
                    f32x4 cs = (f32x4){1.f, 1.f, 1.f, 1.f}, sn = (f32x4){0.f, 0.f, 0.f, 0.f};
                    if (!isctx) { const int pos = (wc >> 1) ? (tok & 63) : (tok >> 6); const int ro = pos * 32 + (wc & 1) * 16 + 4 * fq; cs = *(const f32x4*)(rope + ro); sn = *(const f32x4*)(rope + 2048 + ro); }
#pragma unroll
                    for (int bj = 0; bj < 2; ++bj) {
                        const f32x4 pr = *(const LAS f32x4*)(red + (rl * 2 + bj) * 4);
                        const float rs = __builtin_amdgcn_rsqf((pr[0] + pr[1] + pr[2] + pr[3]) * (1.0f / 128.0f) + RMS_EPS);
                        const f32x4 x1 = acc[ai][bj][m][0] * rs * g1, x2 = acc[ai][bj][m][1] * rs * g2;
                        const f32x4 y1 = x1 * cs - x2 * sn, y2 = x2 * cs + x1 * sn;
                        if (pn < 4) { if (!isctx) { bf16_t* qp = Q + (size_t)gr * 1024 + (pn * 2 + bj) * 128 + d1; st4(qp, y1); st4(qp + 32, y2); } }
                        else { bf16_t* kp = K + ((size_t)bidx * SKV + (isctx ? tok : TCX + tok)) * 256 + bj * 128 + d1; st4(kp, y1); st4(kp + 32, y2); }
                    }
                    __builtin_amdgcn_sched_barrier(0);
                }
        } else {
            const int cc0 = wc * 32 + 4 * fq;
#pragma unroll
            for (int ai = 0; ai < 2; ++ai)
#pragma unroll
                for (int m = 0; m < 4; ++m) {
                    const int gr = grow0 + ai * 128 + m * 16;
                    int bidx, tok; if (isctx) { bidx = (gr - NLAT) >> 8; tok = (gr - NLAT) & 255; } else { bidx = gr >> 11; tok = gr & 2047; }
#pragma unroll
                    for (int bj = 0; bj < 2; ++bj)
#pragma unroll
                        for (int n = 0; n < 2; ++n) {
                            const int cc = cc0 + bj * 128 + n * 16; const f32x4 v = acc[ai][bj][m][n];
                            if (pn == 5) st4(V + ((size_t)bidx * SKV + (isctx ? tok : TCX + tok)) * 256 + cc, v);
                            else if (pn < 14) st4(MQK + (size_t)gr * 2048 + (pn - 6) * 256 + cc, v);
                            else if (pn < 18) st4(MV + (size_t)gr * 1024 + (pn - 14) * 256 + cc, v);
                            else if (pn < 22) { if (!isctx) { f32x4 s; s[0] = sigmoid_f(v[0]); s[1] = sigmoid_f(v[1]); s[2] = sigmoid_f(v[2]); s[3] = sigmoid_f(v[3]); st4(MO + (size_t)gr * 1024 + (pn - 18) * 256 + cc, s); } }
                            else if (cc < 32) {
                                f32x4 t = v + *(const f32x4*)(gb + cc);
                                if (fq >= 2) { t[0] = logsigmoid_f(t[0]); t[1] = logsigmoid_f(t[1]); t[2] = logsigmoid_f(t[2]); t[3] = logsigmoid_f(t[3]); }
                                *(f32x4*)(GT + (size_t)gr * 32 + cc) = t;
                            }
                        }
                    __builtin_amdgcn_sched_barrier(0);
                }
        }
    }
};

__device__ __forceinline__ int up_src(int slot) { const int pn = slot >> 8, r = slot & 255; return (r >> 7) * DFF + pn * 128 + (r & 127); }
template <int MAP  >
__device__ __forceinline__ void prep_tile(const float* __restrict__ W, int Nsrc, bf16_t* __restrict__ Bt, int Kdim, int nt, int kt, LAS float* tl) {
    const int tid = otid();
    { const int n4 = tid & 63, kk = tid >> 6; const int slot = nt * 256 + 4 * n4;
      const int src = MAP == 0 ? slot : (MAP == 1 ? up_src(slot) : win_src(slot));
      f32x4 v[8];
#pragma unroll
      for (int pss = 0; pss < 8; ++pss) { v[pss] = (f32x4){0.f, 0.f, 0.f, 0.f}; if (src >= 0) v[pss] = *(const f32x4*)(W + (size_t)(kt * 64 + kk + pss * 8) * Nsrc + src); }
#pragma unroll
      for (int pss = 0; pss < 8; ++pss) *(LAS f32x4*)(tl + (kk + pss * 8) * 260 + 4 * n4) = v[pss]; }
    __syncthreads();
    { const int n = tid >> 1, kh = (tid & 1) * 32;
#pragma unroll
      for (int q = 0; q < 4; ++q) { float v[8];
#pragma unroll
          for (int e = 0; e < 8; ++e) v[e] = tl[(kh + q * 8 + e) * 260 + n];
          u32x4 w; w.x = cvt_pk_bf16(v[0], v[1]); w.y = cvt_pk_bf16(v[2], v[3]); w.z = cvt_pk_bf16(v[4], v[5]); w.w = cvt_pk_bf16(v[6], v[7]);
          *(u32x4*)(Bt + (size_t)(nt * 256 + n) * Kdim + kt * 64 + kh + q * 8) = w; } }
    __syncthreads();
}
__device__ __forceinline__ void prep_weights(const Params& p, LAS unsigned char* lds, int grp, int idx, int n) {
    LAS float* tl = (LAS float*)lds;
    constexpr int T_UP = (NUP / 256) * (DM / 64), T_DN = (DM / 256) * (DFF / 64), T_IN = (PWP / 256) * (DM / 64), T_OUT = (DM / 256) * (DM / 64);
    const int tot = grp == 1 ? T_IN + T_OUT : T_UP + T_DN;
    for (int t = idx; t < tot; t += n) {
        int q = t;
        if (grp == 1) {
            if (q < T_IN) { prep_tile<2>(p.w_in, PW, (bf16_t*)(p.ws + WS_WIN), DM, q % (PWP / 256), q / (PWP / 256), tl); continue; } q -= T_IN;
            prep_tile<0>(p.w_out, DM, (bf16_t*)(p.ws + WS_WOUT), DM, q % (DM / 256), q / (DM / 256), tl);
        } else {
            const float* wu = grp == 0 ? p.w_up1 : p.w_up2; const float* wd = grp == 0 ? p.w_dn1 : p.w_dn2;
            if (q < T_UP) { prep_tile<1>(wu, NUP, (bf16_t*)(p.ws + (grp == 0 ? WS_WUP1 : WS_WUP2)), DM, q % (NUP / 256), q / (NUP / 256), tl); continue; } q -= T_UP;
            prep_tile<0>(wd, DM, (bf16_t*)(p.ws + (grp == 0 ? WS_WDN1 : WS_WDN2)), DFF, q % (DM / 256), q / (DM / 256), tl);
        }
    }
}
__device__ __forceinline__ void phase_prep(const Params& p, LAS unsigned char* lds, bool do_mod) {
    const int tid = otid(), G = gridDim.x, bid = blockIdx.x;
    float* mod = (float*)(p.ws + WS_MOD);
    LAS float* sv = (LAS float*)lds;
    LAS float* red = (LAS float*)(lds + 9 * 512 * 4);
    for (int item = bid; do_mod && item < 576; item += G) {
        const int cb = item >> 2, ks = item & 3;
        for (int i = tid; i < 9 * 512; i += 512) { const int b = i >> 9, k = i & 511; const float cv = b < 8 ? p.c[b * DM + ks * 512 + k] : p.c_ctx[ks * 512 + k]; sv[i] = silu_f(cv); }
        __syncthreads();
        const int c4 = tid & 31, kr = tid >> 5;
        f32x4 a[9];
#pragma unroll
        for (int b = 0; b < 9; ++b) a[b] = (f32x4){0.f, 0.f, 0.f, 0.f};
        for (int kk = kr; kk < 512; kk += 16) {
            const f32x4 w = *(const f32x4*)(p.w_mod + (size_t)(ks * 512 + kk) * MODW + cb * 128 + c4 * 4);
#pragma unroll
            for (int b = 0; b < 9; ++b) a[b] += w * sv[b * 512 + kk];
        }
#pragma unroll
        for (int b = 0; b < 9; ++b) *(LAS f32x4*)(red + (kr * 9 + b) * 128 + c4 * 4) = a[b];
        __syncthreads();
        for (int o = tid; o < 9 * 128; o += 512) { const int b = o >> 7, cidx = o & 127; float s = 0.f;
#pragma unroll
            for (int r = 0; r < 16; ++r) s += red[(r * 9 + b) * 128 + cidx];
            const int col = cb * 128 + cidx; if (ks == 0) s += p.b_mod[col];
            atomicAdd(mod + (size_t)b * MODW + col, s); }
        __syncthreads();
    }
    if (bid == G - 1) { float* rope = (float*)(p.ws + WS_ROPE);
        for (int i = tid; i < 2048; i += 512) { const int pos = i >> 5, idx = i & 31; const float inv = exp2f(-(float)idx * (13.287712379549449f / 32.0f)); const float ang = (float)pos * inv;
            rope[i] = cosf(ang); rope[2048 + i] = sinf(ang); } }
    prep_weights(p, lds, 0, bid, G);
}

template <int MODE>
__device__ __forceinline__ void phase_rows(const float* src_l, const float* src_c, int nrows, const float* g, const float* mod, int midx, bf16_t* outb, float* outf, const float* part,
                                           int rbase = -1, int rstride = 0) {
    const int wave = otid() >> 6, lane = otid() & 63;
    const int stride = rbase < 0 ? gridDim.x * 8 : rstride;
    for (int r0 = (rbase < 0 ? blockIdx.x * 8 : rbase) + wave; r0 < nrows; r0 += 2 * stride) {
        f32x4 v[2][8]; float ss[2] = {0.f, 0.f};
#pragma unroll
        for (int q = 0; q < 2; ++q) {
            const int r = r0 + q * stride;
            if (r < nrows) {
                const bool isctx = r >= NLAT; const float* xp = isctx ? src_c + (size_t)(r - NLAT) * DM : src_l + (size_t)r * DM;
#pragma unroll
                for (int k = 0; k < 8; ++k) v[q][k] = *(const f32x4*)(xp + (k * 64 + lane) * 4);
                if (isctx && part) {
                    const float* gt = mod + (size_t)(8 * NMOD + 2) * DM; const float* pp = part + (size_t)(r - NLAT) * DM;
#pragma unroll
                    for (int k = 0; k < 8; ++k) { const int c = (k * 64 + lane) * 4;
                        const f32x4 sum = (*(const f32x4*)(pp + c) + *(const f32x4*)(pp + (size_t)NCTX * DM + c)) + (*(const f32x4*)(pp + (size_t)2 * NCTX * DM + c) + *(const f32x4*)(pp + (size_t)3 * NCTX * DM + c));
                        v[q][k] += *(const f32x4*)(gt + c) * 0.5f * sum; }
                }
#pragma unroll
                for (int k = 0; k < 8; ++k) ss[q] += v[q][k][0] * v[q][k][0] + v[q][k][1] * v[q][k][1] + v[q][k][2] * v[q][k][2] + v[q][k][3] * v[q][k][3];
            }
        }
#pragma unroll
        for (int o = 32; o >= 1; o >>= 1) { ss[0] += __shfl_xor(ss[0], o); ss[1] += __shfl_xor(ss[1], o); }
#pragma unroll
        for (int q = 0; q < 2; ++q) {
            const int r = r0 + q * stride;
            if (r < nrows) {
                const float rs = rsqrtf(ss[q] * (1.0f / DM) + RMS_EPS);
                if (MODE == 0) {
                    const int b = r >= NLAT ? 8 : (r >> 11);
                    const float* sh = mod + (size_t)(b * NMOD + midx) * DM; const float* sc = sh + DM;
#pragma unroll
                    for (int k = 0; k < 8; ++k) { const int c = (k * 64 + lane) * 4; const f32x4 gg = *(const f32x4*)(g + c), s1 = *(const f32x4*)(sc + c), s0 = *(const f32x4*)(sh + c);
                        const f32x4 y = v[q][k] * rs * gg * (s1 + 1.0f) + s0; u32x2 w; w.x = cvt_pk_bf16(y[0], y[1]); w.y = cvt_pk_bf16(y[2], y[3]); *(u32x2*)(outb + (size_t)r * DM + c) = w; }
                } else {
#pragma unroll
                    for (int k = 0; k < 8; ++k) { const int c = (k * 64 + lane) * 4; const f32x4 gg = *(const f32x4*)(g + c); *(f32x4*)(outf + (size_t)r * DM + c) = v[q][k] * rs * gg; }
                }
            }
        }
    }
}

namespace att {
constexpr int D = 128, NW = 8, QBLK = 32, KVBLK = 64;
constexpr float SCALE = 0.088388347648318440f, THR = 8.f;
constexpr int LDQ = 1024, LDK = 256, LDO = 2048;
constexpr size_t SHM_V = KVBLK * D * 2, SHM_K = KVBLK * D * 2, SHM_ATTN = 2 * SHM_V + 2 * SHM_K + NW * 64 * 4;
#define KSWZ(row, colB) ((row) * 256 + ((colB) ^ (((row) & 7) << 4)))
#define SBAR() __builtin_amdgcn_sched_barrier(0)
__device__ __forceinline__ int crow(int r, int hi) { return (r & 3) + 8 * (r >> 2) + 4 * hi; }
__device__ __forceinline__ void partialSM(f32x16& p0, f32x16& p1, float& m_reg, float& mn, float& alpha) {
  constexpr float C = SCALE * 1.4426950408889634f;
  float pmax = p0[0]; for (int r = 1; r < 16; ++r) pmax = fmaxf(pmax, p0[r]); for (int r = 0; r < 16; ++r) pmax = fmaxf(pmax, p1[r]);
  { auto rr = __builtin_amdgcn_permlane32_swap(__float_as_uint(pmax), __float_as_uint(pmax), false, false);
    pmax = fmaxf(__uint_as_float(rr[0]), __uint_as_float(rr[1])); }
  if (__builtin_expect(__all(pmax - m_reg <= THR / SCALE), 1)) { mn = m_reg; alpha = 1.f; }
  else { mn = fmaxf(m_reg, pmax); alpha = __builtin_amdgcn_exp2f((m_reg - mn) * C); m_reg = mn; }
  float mnC = -mn * C;
  for (int r = 0; r < 16; ++r) p0[r] = fmaf(p0[r], C, mnC); for (int r = 0; r < 16; ++r) p1[r] = fmaf(p1[r], C, mnC);
  for (int r = 0; r < 16; ++r) p0[r] = __builtin_amdgcn_exp2f(p0[r]);
}
__device__ __forceinline__ void finishSM(f32x16& p0, f32x16& p1, float alpha, float& l_reg, bf16x8& pa0, bf16x8& pa1, bf16x8& pa2, bf16x8& pa3) {
  for (int r = 0; r < 16; ++r) p1[r] = __builtin_amdgcn_exp2f(p1[r]);
  float ps = 0; for (int r = 0; r < 16; ++r) ps += p0[r]; for (int r = 0; r < 16; ++r) ps += p1[r];
  { auto rr = __builtin_amdgcn_permlane32_swap(__float_as_uint(ps), __float_as_uint(ps), false, false);
    ps = __uint_as_float(rr[0]) + __uint_as_float(rr[1]); }
  l_reg = l_reg * alpha + ps;
#define PK4(P, BASE, OUT) do { unsigned a0 = cvt_pk_bf16(P[BASE + 0], P[BASE + 1]), a1 = cvt_pk_bf16(P[BASE + 2], P[BASE + 3]);   \
    unsigned b0 = cvt_pk_bf16(P[BASE + 4], P[BASE + 5]), b1 = cvt_pk_bf16(P[BASE + 6], P[BASE + 7]);                              \
    auto r0 = __builtin_amdgcn_permlane32_swap(a0, b0, false, false); auto r1 = __builtin_amdgcn_permlane32_swap(a1, b1, false, false); \
    u32x4 w = {r0[0], r1[0], r0[1], r1[1]}; OUT = *reinterpret_cast<bf16x8*>(&w); } while (0)
  PK4(p0, 0, pa0); PK4(p0, 8, pa1); PK4(p1, 0, pa2); PK4(p1, 8, pa3);
#undef PK4
}
__device__ __forceinline__ void qkt(f32x16& p0, f32x16& p1, const bf16_t* Ks, const bf16x8* qr, int r32, int hi) {
  p0 = f32x16{}; p1 = f32x16{};
  for (int d0 = 0; d0 < 8; ++d0) { int cb = (d0 * 16 + hi * 8) * 2;
    bf16x8 b0 = *reinterpret_cast<const bf16x8*>((const char*)Ks + KSWZ(r32, cb));
    bf16x8 b1 = *reinterpret_cast<const bf16x8*>((const char*)Ks + KSWZ(32 + r32, cb));
    p0 = __builtin_amdgcn_mfma_f32_32x32x16_bf16(b0, qr[d0], p0, 0, 0, 0);
    p1 = __builtin_amdgcn_mfma_f32_32x32x16_bf16(b1, qr[d0], p1, 0, 0, 0); }
}
__device__ __forceinline__ int v_st(int k, int c) { const int kk = (k & ~0xC) | ((k & 4) << 1) | ((k & 8) >> 1); return ((kk >> 3) * 4 + (c >> 5)) * 512 + ((kk & 7) * 32 + (c & 31)) * 2; }
__device__ __forceinline__ int v_rd_base(int lane) { return ((lane & 3) << 3) | (((lane >> 2) & 3) << 6) | (((lane >> 4) & 1) << 5) | (((lane >> 5) & 1) << 8); }
constexpr int v_rd_off(int d0, int ks, int half) { return d0 * 512 + ks * 4096 + half * 2048; }
template <int OFF> __device__ __forceinline__ s16x4 tr_read(int vb) {
  s16x4 r; asm volatile("ds_read_b64_tr_b16 %0, %1 offset:%2" : "=&v"(r) : "v"(vb), "i"(OFF) : "memory"); return r;
}
template <int D0> __device__ __forceinline__ void pv_one(f32x16& od, int vb, bf16x8 pa0, bf16x8 pa1, bf16x8 pa2, bf16x8 pa3) {
  const s16x4 l0 = tr_read<v_rd_off(D0, 0, 0)>(vb), h0 = tr_read<v_rd_off(D0, 0, 1)>(vb), l1 = tr_read<v_rd_off(D0, 1, 0)>(vb), h1 = tr_read<v_rd_off(D0, 1, 1)>(vb);
  const s16x4 l2 = tr_read<v_rd_off(D0, 2, 0)>(vb), h2 = tr_read<v_rd_off(D0, 2, 1)>(vb), l3 = tr_read<v_rd_off(D0, 3, 0)>(vb), h3 = tr_read<v_rd_off(D0, 3, 1)>(vb);
  asm volatile("s_waitcnt lgkmcnt(0)" ::: "memory"); SBAR();
#define PK(L, H) (bf16x8){L[0], L[1], L[2], L[3], H[0], H[1], H[2], H[3]}
  od = __builtin_amdgcn_mfma_f32_32x32x16_bf16(pa0, PK(l0, h0), od, 0, 0, 0);
  od = __builtin_amdgcn_mfma_f32_32x32x16_bf16(pa1, PK(l1, h1), od, 0, 0, 0);
  od = __builtin_amdgcn_mfma_f32_32x32x16_bf16(pa2, PK(l2, h2), od, 0, 0, 0);
  od = __builtin_amdgcn_mfma_f32_32x32x16_bf16(pa3, PK(l3, h3), od, 0, 0, 0);
#undef PK
}
__device__ __forceinline__ void pv_d0(f32x16* o, int vb, bf16x8 pa0, bf16x8 pa1, bf16x8 pa2, bf16x8 pa3) {
  pv_one<0>(o[0], vb, pa0, pa1, pa2, pa3); pv_one<1>(o[1], vb, pa0, pa1, pa2, pa3); pv_one<2>(o[2], vb, pa0, pa1, pa2, pa3); pv_one<3>(o[3], vb, pa0, pa1, pa2, pa3);
}
__device__ __forceinline__ void attn_dense_body(const bf16_t* __restrict__ Qb, const bf16_t* __restrict__ Kh, const bf16_t* __restrict__ Vh, bf16_t* __restrict__ Ob, int seq, char* lds) {
  const int tid = otid(), wid = tid >> 6, lane = tid & 63, r32 = lane & 31, hi = lane >> 5;
  bf16_t* V_lds = (bf16_t*)lds; bf16_t* K_lds = (bf16_t*)(lds + 2 * SHM_V);
  float* ws = (float*)(lds + 2 * SHM_V + 2 * SHM_K) + wid * 64; float* li_l = ws; float* al_l = ws + 32;
  float m_reg = -1e30f, l_reg = 0; f32x16 o[4] = {}; bf16x8 qr[8];
  const bf16_t* Qw = Qb + (long)(wid * QBLK + r32) * LDQ + hi * 8;
#pragma unroll
  for (int d0 = 0; d0 < 8; ++d0) qr[d0] = *reinterpret_cast<const bf16x8*>(Qw + d0 * 16);
  const int sr = tid >> 4, sc = (tid & 15) * 8, vst0 = v_st(sr, sc), vst1 = v_st(32 + sr, sc);
  const int vb0 = (int)(uintptr_t)V_lds + v_rd_base(lane);
  struct { bf16x8 vs0, vs1, ks0, ks1; } sr_[2];
#define SLOAD(i, k0) do { sr_[i].vs0 = *reinterpret_cast<const bf16x8*>(&Vh[(long)((k0) + sr) * LDK + sc]); sr_[i].vs1 = *reinterpret_cast<const bf16x8*>(&Vh[(long)((k0) + 32 + sr) * LDK + sc]); \
    sr_[i].ks0 = *reinterpret_cast<const bf16x8*>(&Kh[(long)((k0) + sr) * LDK + sc]); sr_[i].ks1 = *reinterpret_cast<const bf16x8*>(&Kh[(long)((k0) + 32 + sr) * LDK + sc]); } while (0)
#define SWRITE(b, i) do { *(bf16x8*)((char*)V_lds + (b) * SHM_V + vst0) = sr_[i].vs0;          \
    *(bf16x8*)((char*)V_lds + (b) * SHM_V + vst1) = sr_[i].vs1; int kc = sc * 2;               \
    *(bf16x8*)((char*)K_lds + (b) * SHM_K + KSWZ(sr, kc)) = sr_[i].ks0;                       \
    *(bf16x8*)((char*)K_lds + (b) * SHM_K + KSWZ(32 + sr, kc)) = sr_[i].ks1; } while (0)
#define SWAIT() asm volatile("s_waitcnt vmcnt(4)" ::: "memory")
#define RESC(a) do { if (__any((a) < 1.f)) { if (hi == 0) al_l[r32] = (a); asm volatile("s_waitcnt lgkmcnt(0)" ::: "memory"); \
    for (int d = 0; d < 4; ++d) for (int r = 0; r < 16; ++r) o[d][r] *= al_l[crow(r, hi)]; } } while (0)
  f32x16 pA0, pA1, pB0, pB1; float mnA, mnB, alA, alB; bf16x8 pa0, pa1, pa2, pa3; const int NT = seq / KVBLK;
  constexpr int SE = 0, SO = 1;
  SLOAD(SE, 0); asm volatile("s_waitcnt vmcnt(0)" ::: "memory"); SWRITE(0, SE); __syncthreads();
  qkt(pA0, pA1, K_lds, qr, r32, hi); partialSM(pA0, pA1, m_reg, mnA, alA);
  SLOAD(SO, KVBLK); if (2 < NT) SLOAD(SE, 2 * KVBLK);
  SWAIT(); SWRITE(1, SO); __syncthreads();
  for (int j = 1; j + 1 < NT; j += 2) {
    SBAR(); qkt(pB0, pB1, (bf16_t*)((char*)K_lds + SHM_K), qr, r32, hi);
    finishSM(pA0, pA1, alA, l_reg, pa0, pa1, pa2, pa3); SBAR();
    SLOAD(SO, (j + 2) * KVBLK); SBAR();
    pv_d0(o, vb0, pa0, pa1, pa2, pa3); partialSM(pB0, pB1, m_reg, mnB, alB);
    __syncthreads(); SWAIT(); SWRITE(0, SE);
    RESC(alB); __syncthreads();
    SBAR(); qkt(pA0, pA1, K_lds, qr, r32, hi);
    finishSM(pB0, pB1, alB, l_reg, pa0, pa1, pa2, pa3); SBAR();
    if (j + 3 < NT) SLOAD(SE, (j + 3) * KVBLK); SBAR();
    pv_d0(o, vb0 + (int)SHM_V, pa0, pa1, pa2, pa3); partialSM(pA0, pA1, m_reg, mnA, alA);
    __syncthreads(); SWAIT(); SWRITE(1, SO);
    RESC(alA); __syncthreads();
  }
  SBAR(); qkt(pB0, pB1, (bf16_t*)((char*)K_lds + SHM_K), qr, r32, hi);
  finishSM(pA0, pA1, alA, l_reg, pa0, pa1, pa2, pa3); SBAR();
  pv_d0(o, vb0, pa0, pa1, pa2, pa3); partialSM(pB0, pB1, m_reg, mnB, alB);
  __syncthreads(); RESC(alB);
  finishSM(pB0, pB1, alB, l_reg, pa0, pa1, pa2, pa3); SBAR();
  pv_d0(o, vb0 + (int)SHM_V, pa0, pa1, pa2, pa3);
  if (hi == 0) li_l[r32] = l_reg; asm volatile("s_waitcnt lgkmcnt(0)" ::: "memory");
  float rli[16];
#pragma unroll
  for (int r = 0; r < 16; ++r) rli[r] = __builtin_amdgcn_rcpf(li_l[crow(r, hi)]);
  bf16_t* Ow = Ob + (long)(wid * QBLK) * LDO;
#pragma unroll
  for (int r = 0; r < 16; ++r) { int orow = crow(r, hi);
    for (int d0 = 0; d0 < 4; ++d0) Ow[(long)orow * LDO + d0 * 32 + r32] = (bf16_t)(cvt_pk_bf16(o[d0][r] * rli[r], 0.f) & 0xffffu); }
#undef SLOAD
#undef SWRITE
#undef SWAIT
#undef RESC
}
}

__device__ __forceinline__ void attn_unit(const Params& p, unsigned char* lds_generic, int u) {
    const int qb = u & 7, g = (u >> 3) & 3, kvh = (u >> 5) & 1, b = u >> 6, hq = kvh * 4 + g;
    const bf16_t* Q = (const bf16_t*)(p.ws + WS_Q) + ((size_t)(b * TL + qb * 256)) * 1024 + hq * 128;
    const bf16_t* K = (const bf16_t*)(p.ws + WS_K) + (size_t)b * SKV * 256 + kvh * 128;
    const bf16_t* V = (const bf16_t*)(p.ws + WS_V) + (size_t)b * SKV * 256 + kvh * 128;
    bf16_t* O = (bf16_t*)(p.ws + WS_ATT) + ((size_t)(b * TL + qb * 256)) * 2048 + hq * 128;
    __syncthreads();
    att::attn_dense_body(Q, K, V, O, SKV, (char*)lds_generic);
}

__device__ __forceinline__ int jsw(int r, int c) { return r * 64 + ((((c) >> 3) ^ ((r ^ (r >> 3)) & 7)) << 3) + (c & 7); }
__device__ __forceinline__ f32x4 mfma16(bf16x8 a, bf16x8 b, f32x4 c) { return __builtin_amdgcn_mfma_f32_16x16x32_bf16(a, b, c, 0, 0, 0); }
__device__ __forceinline__ void mlstm_stream(const Params& p, LAS unsigned char* lds, int sid) {
    const int tid = otid(), w = __builtin_amdgcn_readfirstlane(tid >> 6), lane = tid & 63, fr = lane & 15, fq = lane >> 4;
    const int dir = sid & 1, h = (sid >> 1) & 7, b = sid >> 4;
    LAS bf16_t* Qs = (LAS bf16_t*)(lds + ML_QS); LAS bf16_t* Ks = (LAS bf16_t*)(lds + ML_KS); LAS bf16_t* KT = (LAS bf16_t*)(lds + ML_KT);
    LAS bf16_t* VT = (LAS bf16_t*)(lds + ML_VT); LAS bf16_t* Ps = (LAS bf16_t*)(lds + ML_PS); LAS bf16_t* C0 = (LAS bf16_t*)(lds + ML_C0);
    LAS float* sc_u = (LAS float*)(lds + ML_SC); LAS float* sc_pm = sc_u + 64; LAS float* sc_a = sc_u + 128; LAS float* sc_e = sc_u + 192;
    LAS float* cw = (LAS float*)(lds + ML_CW); LAS float* cbv = (LAS float*)(lds + ML_CB);
    const bf16_t* MQK = (const bf16_t*)(p.ws + WS_MQK); const bf16_t* MV = (const bf16_t*)(p.ws + WS_MV); const float* GT = (const float*)(p.ws + WS_GT);
    bf16_t* HO = (bf16_t*)(p.ws + WS_H) + (size_t)dir * NLAT * 1024;
    const int cg8 = (tid & 15) * 8, rg = tid >> 4, tl0 = 2 * rg;
    const int i0 = dir ? 63 - tl0 : tl0, i1 = dir ? i0 - 1 : i0 + 1, ie = dir ? i1 : i0;
    __syncthreads();
    for (int i = tid; i < 16 * 64; i += 512) VT[128 * 64 + i] = 0x3F80;
    for (int i = tid; i < 5 * 256; i += 512) { const int j = i >> 8, c = i & 255; cw[i] = p.conv_w[j * 2048 + (c < 128 ? h * 128 + c : 1024 + h * 128 + (c - 128))]; }
    for (int i = tid; i < 256; i += 512) cbv[i] = p.conv_b[i < 128 ? h * 128 + i : 1024 + h * 128 + (i - 128)];
    f32x4 C[9];
#pragma unroll
    for (int i = 0; i < 9; ++i) C[i] = (f32x4){0.f, 0.f, 0.f, 0.f};
    float m0 = 0.f;
    bf16x8 xq[6], xk[6], xv0, xv1; float g_ig, g_lf;
#define ML_CHUNK(ci_, lat_, chunk_, TS_, rbase_, t0_) const bool lat_ = (ci_) >= 4; const int chunk_ = lat_ ? (dir ? 35 - (ci_) : (ci_) - 4) : (dir ? 3 - (ci_) : (ci_)); \
        const int TS_ = lat_ ? TL : TCX; const size_t rbase_ = lat_ ? (size_t)b * TL : (size_t)NLAT + (size_t)b * TCX; const int t0_ = chunk_ * 64;
#define ML_LOAD(ci_) do { ML_CHUNK(ci_, l_, c_, ts_, rb_, t_) \
        { const int tl = dir ? 63 - lane : lane; const size_t row = rb_ + t_ + tl; g_ig = GT[row * 32 + dir * 16 + h]; g_lf = GT[row * 32 + dir * 16 + 8 + h]; } \
        _Pragma("unroll") for (int rr = 0; rr < 6; ++rr) { const int sl = t_ + tl0 - 2 + rr; xq[rr] = (bf16x8){0, 0, 0, 0, 0, 0, 0, 0}; xk[rr] = xq[rr]; \
            if (sl >= 0 && sl < ts_) { const bf16_t* src = MQK + (rb_ + sl) * 2048 + h * 128 + cg8; xq[rr] = *(const bf16x8*)src; xk[rr] = *(const bf16x8*)(src + 1024); } } \
        xv0 = *(const bf16x8*)(MV + (rb_ + t_ + tl0) * 1024 + h * 128 + cg8); xv1 = *(const bf16x8*)(MV + (rb_ + t_ + tl0 + 1) * 1024 + h * 128 + cg8); } while (0)
    ML_LOAD(0);
    __syncthreads();
    for (int ci = 0; ci < 36; ++ci) {
        ML_CHUNK(ci, lat, chunk, TS, rbase, t0)
        (void)TS;
        float wgt, decay, m0n;
        {
            float bc = g_lf;
#pragma unroll
            for (int d = 1; d < 64; d <<= 1) { const float v = __shfl_up(bc, d); if (lane >= d) bc += v; }
            const float uu = g_ig - bc; float px = uu;
#pragma unroll
            for (int d = 1; d < 64; d <<= 1) { const float v = __shfl_up(px, d); if (lane >= d) px = fmaxf(px, v); }
            const float pm = fmaxf(m0, px);
            const float bL = __shfl(bc, 63), pmL = __shfl(pm, 63);
            wgt = __expf(uu - pmL); decay = __expf(m0 - pmL); m0n = bL + pmL;
            if (w == 0) { sc_u[lane] = uu; sc_pm[lane] = pm; sc_a[lane] = __expf(m0 - pm); sc_e[lane] = __expf(-bc - pm); }
        }
        {
            const float w0 = __shfl(wgt, i0), w1 = __shfl(wgt, i1);
#pragma unroll
            for (int qk = 0; qk < 2; ++qk) {
                float y0[8], y1[8];
#pragma unroll
                for (int e = 0; e < 8; ++e) { y0[e] = cbv[qk * 128 + cg8 + e]; y1[e] = y0[e]; }
#pragma unroll
                for (int j = 0; j < 5; ++j) {
                    const f32x4 wa = *(const LAS f32x4*)(cw + j * 256 + qk * 128 + cg8), wb = *(const LAS f32x4*)(cw + j * 256 + qk * 128 + cg8 + 4);
#pragma unroll
                    for (int e = 0; e < 8; ++e) { const float wv = e < 4 ? wa[e] : wb[e - 4]; const bf16x8 xa = qk ? xk[j] : xq[j], xb = qk ? xk[j + 1] : xq[j + 1];
                        y0[e] += wv * bf2f((unsigned short)xa[e]); y1[e] += wv * bf2f((unsigned short)xb[e]); }
                }
                const float ksc = qk ? 0.08838834764831845f : 1.0f;
#pragma unroll
                for (int e = 0; e < 8; ++e) { y0[e] = silu_f(y0[e]) * ksc; y1[e] = silu_f(y1[e]) * ksc; }
                LAS bf16_t* dst = qk ? Ks : Qs;
                u32x4 p0, p1; p0.x = cvt_pk_bf16(y0[0], y0[1]); p0.y = cvt_pk_bf16(y0[2], y0[3]); p0.z = cvt_pk_bf16(y0[4], y0[5]); p0.w = cvt_pk_bf16(y0[6], y0[7]);
                p1.x = cvt_pk_bf16(y1[0], y1[1]); p1.y = cvt_pk_bf16(y1[2], y1[3]); p1.z = cvt_pk_bf16(y1[4], y1[5]); p1.w = cvt_pk_bf16(y1[6], y1[7]);
                *(LAS u32x4*)(dst + i0 * QS_LD + cg8) = p0; *(LAS u32x4*)(dst + i1 * QS_LD + cg8) = p1;
                if (qk) {
#pragma unroll
                    for (int e = 0; e < 8; ++e) { const float a0 = y0[e] * w0, a1 = y1[e] * w1; *(LAS unsigned*)(KT + jsw(cg8 + e, ie)) = dir ? cvt_pk_bf16(a1, a0) : cvt_pk_bf16(a0, a1); }
                }
            }
#pragma unroll
            for (int e = 0; e < 8; ++e) { const unsigned lo = (unsigned short)(dir ? xv1[e] : xv0[e]), hi = (unsigned short)(dir ? xv0[e] : xv1[e]); *(LAS unsigned*)(VT + jsw(cg8 + e, ie)) = lo | (hi << 16); }
        }
        if (ci + 1 < 36) ML_LOAD(ci + 1);
        __syncthreads();
        if (lat) {
            const int it = w >> 1;
#pragma unroll
            for (int jj = 0; jj < 2; ++jj) {
                const int jt = (w & 1) * 2 + jj;
                f32x4 s = (f32x4){0.f, 0.f, 0.f, 0.f};
                if (jt <= it) {
#pragma unroll
                    for (int ks = 0; ks < 4; ++ks) { const bf16x8 a = *(const LAS bf16x8*)(Ks + (jt * 16 + fr) * QS_LD + ks * 32 + fq * 8), bb = *(const LAS bf16x8*)(Qs + (it * 16 + fr) * QS_LD + ks * 32 + fq * 8); s = mfma16(a, bb, s); }
                    const int i = it * 16 + fr, j0 = jt * 16 + 4 * fq; const float pmi = sc_pm[i]; const f32x4 uj = *(const LAS f32x4*)(sc_u + j0);
#pragma unroll
                    for (int r = 0; r < 4; ++r) s[r] = (j0 + r <= i) ? s[r] * __expf(uj[r] - pmi) : 0.f;
                }
                u32x2 pw; pw.x = cvt_pk_bf16(s[0], s[1]); pw.y = cvt_pk_bf16(s[2], s[3]);
                *(LAS u32x2*)(Ps + (it * 16 + fr) * JS_LD + jt * 16 + 4 * fq) = pw;
            }
#pragma unroll
            for (int nt = 0; nt < 9; ++nt) { u32x2 cwd; cwd.x = cvt_pk_bf16(C[nt][0], C[nt][1]); cwd.y = cvt_pk_bf16(C[nt][2], C[nt][3]); *(LAS u32x2*)(C0 + (nt * 16 + fr) * QS_LD + w * 16 + 4 * fq) = cwd; }
        }
        {
            const bf16x8 a0 = *(const LAS bf16x8*)(KT + jsw(w * 16 + fr, fq * 8)), a1 = *(const LAS bf16x8*)(KT + jsw(w * 16 + fr, 32 + fq * 8));
#pragma unroll
            for (int nt = 0; nt < 9; ++nt) { C[nt] *= decay;
                C[nt] = mfma16(a0, *(const LAS bf16x8*)(VT + jsw(nt * 16 + fr, fq * 8)), C[nt]); C[nt] = mfma16(a1, *(const LAS bf16x8*)(VT + jsw(nt * 16 + fr, 32 + fq * 8)), C[nt]); }
        }
        __syncthreads();
        if (lat) {
            const int it = w >> 1, dvh = w & 1, i = it * 16 + fr;
            f32x4 ac[5];
#pragma unroll
            for (int t = 0; t < 5; ++t) ac[t] = (f32x4){0.f, 0.f, 0.f, 0.f};
#pragma unroll
            for (int ks = 0; ks < 4; ++ks) { const bf16x8 bq = *(const LAS bf16x8*)(Qs + i * QS_LD + ks * 32 + fq * 8);
#pragma unroll
                for (int t = 0; t < 5; ++t) { const int row = (t < 4 ? (dvh * 4 + t) * 16 : 128) + fr; ac[t] = mfma16(*(const LAS bf16x8*)(C0 + row * QS_LD + ks * 32 + fq * 8), bq, ac[t]); } }
            const float ai = sc_a[i];
#pragma unroll
            for (int t = 0; t < 5; ++t) ac[t] *= ai;
#pragma unroll
            for (int ks = 0; ks < 2; ++ks) { const bf16x8 bp = *(const LAS bf16x8*)(Ps + i * JS_LD + ks * 32 + fq * 8);
#pragma unroll
                for (int t = 0; t < 5; ++t) { const int row = (t < 4 ? (dvh * 4 + t) * 16 : 128) + fr; ac[t] = mfma16(*(const LAS bf16x8*)(VT + jsw(row, ks * 32 + fq * 8)), bp, ac[t]); } }
            const float den = fmaxf(fabsf(ac[4][0]), sc_e[i]); const float rd = 1.0f / den;
            const size_t row = rbase + t0 + (dir ? 63 - i : i);
#pragma unroll
            for (int t = 0; t < 4; ++t) { u32x2 hw; hw.x = cvt_pk_bf16(ac[t][0] * rd, ac[t][1] * rd); hw.y = cvt_pk_bf16(ac[t][2] * rd, ac[t][3] * rd);
                *(u32x2*)(HO + row * 1024 + h * 128 + (dvh * 4 + t) * 16 + 4 * fq) = hw; }
        }
        m0 = m0n;
        __syncthreads();
    }
#undef ML_LOAD
#undef ML_CHUNK
}

__device__ __forceinline__ void phase_combine(const Params& p) {
    const bf16_t* HF = (const bf16_t*)(p.ws + WS_H); const bf16_t* HB = HF + (size_t)NLAT * 1024; const bf16_t* MO = (const bf16_t*)(p.ws + WS_MO);
    bf16_t* AT = (bf16_t*)(p.ws + WS_ATT);
    const int tid = otid(), c8 = (tid & 127) * 8, rq = tid >> 7;
    f32x4 g0 = *(const f32x4*)(p.m_gain + c8), g1 = *(const f32x4*)(p.m_gain + c8 + 4);
    for (int r = blockIdx.x * 4 + rq; r < NLAT; r += gridDim.x * 4) {
        const bf16x8 a = *(const bf16x8*)(HF + (size_t)r * 1024 + c8), bb = *(const bf16x8*)(HB + (size_t)r * 1024 + c8), mo = *(const bf16x8*)(MO + (size_t)r * 1024 + c8);
        float x[8], ss = 0.f;
#pragma unroll
        for (int e = 0; e < 8; ++e) { x[e] = bf2f((unsigned short)a[e]) + bf2f((unsigned short)bb[e]); ss += x[e] * x[e]; }
        ss += __shfl_xor(ss, 1); ss += __shfl_xor(ss, 2); ss += __shfl_xor(ss, 4); ss += __shfl_xor(ss, 8);
        const float rs = rsqrtf(ss * (1.0f / 128.0f) + RMS_EPS);
        float y[8];
#pragma unroll
        for (int e = 0; e < 8; ++e) y[e] = x[e] * rs * (e < 4 ? g0[e] : g1[e - 4]) * bf2f((unsigned short)mo[e]);
        u32x4 wv; wv.x = cvt_pk_bf16(y[0], y[1]); wv.y = cvt_pk_bf16(y[2], y[3]); wv.z = cvt_pk_bf16(y[4], y[5]); wv.w = cvt_pk_bf16(y[6], y[7]);
        *(u32x4*)(AT + (size_t)r * 2048 + 1024 + c8) = wv;
    }
}

__device__ __forceinline__ void combine_item(const Params& p, int b, int h, int t0) {
    const bf16_t* HF = (const bf16_t*)(p.ws + WS_H); const bf16_t* HB = HF + (size_t)NLAT * 1024; const bf16_t* MO = (const bf16_t*)(p.ws + WS_MO);
    bf16_t* AT = (bf16_t*)(p.ws + WS_ATT);
    const int tid = otid(), c8 = (tid & 15) * 8, tr = tid >> 4;
    const f32x4 g0 = *(const f32x4*)(p.m_gain + h * 128 + c8), g1 = *(const f32x4*)(p.m_gain + h * 128 + c8 + 4);
    for (int it = 0; it < 16; it += 4) {
        bf16x8 a[4], bb[4], mo[4];
#pragma unroll
        for (int q = 0; q < 4; ++q) { const size_t r = (size_t)b * TL + t0 + (it + q) * 32 + tr; const size_t o = r * 1024 + h * 128 + c8;
            a[q] = *(const bf16x8*)(HF + o); bb[q] = *(const bf16x8*)(HB + o); mo[q] = *(const bf16x8*)(MO + o); }
#pragma unroll
        for (int q = 0; q < 4; ++q) {
            float x[8], ss = 0.f;
#pragma unroll
            for (int e = 0; e < 8; ++e) { x[e] = bf2f((unsigned short)a[q][e]) + bf2f((unsigned short)bb[q][e]); ss += x[e] * x[e]; }
            ss += __shfl_xor(ss, 1); ss += __shfl_xor(ss, 2); ss += __shfl_xor(ss, 4); ss += __shfl_xor(ss, 8);
            const float rs = rsqrtf(ss * (1.0f / 128.0f) + RMS_EPS);
            float y[8];
#pragma unroll
            for (int e = 0; e < 8; ++e) y[e] = x[e] * rs * (e < 4 ? g0[e] : g1[e - 4]) * bf2f((unsigned short)mo[q][e]);
            u32x4 wv; wv.x = cvt_pk_bf16(y[0], y[1]); wv.y = cvt_pk_bf16(y[2], y[3]); wv.z = cvt_pk_bf16(y[4], y[5]); wv.w = cvt_pk_bf16(y[6], y[7]);
            const size_t r = (size_t)b * TL + t0 + (it + q) * 32 + tr;
            *(u32x4*)(AT + r * 2048 + 1024 + h * 128 + c8) = wv;
        }
    }
}

#define XB_TMO      128
#define XB_XCNT(j)  (256  + 64 * (j))
#define XB_XSUB(j)  (1280 + 64 * (j))
#define XB_XGEN(j)  (2304 + 64 * (j))
#define XB_TOP      3328
#define XB_TOPGEN   3392
#define XCD_BAR_WORDS 3456
#define XB_SPIN_CAP (1u << 22)
__device__ __forceinline__ unsigned xb_ld(unsigned* p)              { return __hip_atomic_load(p, __ATOMIC_RELAXED, __HIP_MEMORY_SCOPE_AGENT); }
__device__ __forceinline__ unsigned xb_add(unsigned* p, unsigned v) { return __hip_atomic_fetch_add(p, v, __ATOMIC_RELAXED, __HIP_MEMORY_SCOPE_AGENT); }
__device__ __forceinline__ unsigned xb_xcc_id() { return (unsigned)__builtin_amdgcn_s_getreg((3 << 11) | 20) & 0xFu; }
#define XB_SPIN(cond, bar) do { unsigned _sp = 0; while (cond) { __builtin_amdgcn_s_sleep(1); \
    if ((++_sp & 255u) == 0u) { if (xb_ld(&(bar)[XB_TMO])) break; if (_sp > XB_SPIN_CAP) { atomicAdd(&(bar)[XB_TMO], 1u); break; } } } } while (0)
struct XcdBarrier { unsigned* bar; unsigned x; volatile LAS unsigned* st; };
__device__ __forceinline__ XcdBarrier xcd_barrier_post(unsigned* bar, volatile LAS unsigned* st) {
    XcdBarrier b; b.bar = bar; b.x = xb_xcc_id(); b.st = st;
    if (threadIdx.x == 0) (void)xb_add(&bar[XB_XCNT(b.x)], 1u);
    return b;
}
__device__ __forceinline__ void xcd_barrier_complete(unsigned* bar, unsigned x, unsigned& nloc, unsigned& nx) {
    const unsigned G = gridDim.x * gridDim.y * gridDim.z;
    unsigned sum, cnt, mine, sp = 0u;
    for (;;) {
        sum = 0u; cnt = 0u; mine = 0u;
#pragma unroll
        for (unsigned j = 0; j < 16; ++j) { const unsigned c = xb_ld(&bar[XB_XCNT(j)]); sum += c; cnt += (c > 0u) ? 1u : 0u; mine = (j == x) ? c : mine; }
        if (sum == G) break;
        __builtin_amdgcn_s_sleep(1);
        if ((++sp & 255u) == 0u) { if (xb_ld(&bar[XB_TMO])) break; if (sp > XB_SPIN_CAP) { atomicAdd(&bar[XB_TMO], 1u); break; } }
    }
    nloc = mine > 0u ? mine : 1u; nx = cnt > 0u ? cnt : 1u;
}
__device__ __forceinline__ void xcd_barrier(const XcdBarrier& b) {
    asm volatile("s_waitcnt vmcnt(0)" ::: "memory");
    __syncthreads();
    if (threadIdx.x == 0) {
        unsigned* bar = b.bar;
        __builtin_amdgcn_s_waitcnt(0);
        unsigned nloc = b.st[0], nx = b.st[1];
        if (nloc == 0u) { xcd_barrier_complete(bar, b.x, nloc, nx); b.st[0] = nloc; b.st[1] = nx; }
        const unsigned old = xb_add(&bar[XB_XSUB(b.x)], 1u);
        const unsigned gen = old / nloc;
        if (old + 1u == (gen + 1u) * nloc) {
            __builtin_amdgcn_fence(__ATOMIC_RELEASE, "agent");
            asm volatile("s_waitcnt vmcnt(0)" ::: "memory");
            const unsigned og = xb_add(&bar[XB_TOP], 1u);
            const unsigned tg = og / nx;
            if (og + 1u == (tg + 1u) * nx) xb_add(&bar[XB_TOPGEN], 1u);
            else XB_SPIN(xb_ld(&bar[XB_TOPGEN]) == tg, bar);
            __builtin_amdgcn_fence(__ATOMIC_ACQUIRE, "agent");
            xb_add(&bar[XB_XGEN(b.x)], 1u);
            asm volatile("s_waitcnt vmcnt(0)" ::: "memory");
        } else {
            XB_SPIN(xb_ld(&bar[XB_XGEN(b.x)]) == gen, bar);
            __builtin_amdgcn_fence(__ATOMIC_ACQUIRE, "agent");
            asm volatile("s_waitcnt vmcnt(0)" ::: "memory");
        }
    }
    __syncthreads();
}

__device__ __forceinline__ void panel_handoff(unsigned* cnt, unsigned need) {
    asm volatile("s_waitcnt vmcnt(0)" ::: "memory"); __syncthreads();
    if (threadIdx.x == 0) {
        __builtin_amdgcn_fence(__ATOMIC_RELEASE, "agent"); asm volatile("s_waitcnt vmcnt(0)" ::: "memory");
        (void)__hip_atomic_fetch_add(cnt, 1u, __ATOMIC_RELAXED, __HIP_MEMORY_SCOPE_AGENT);
        unsigned sp = 0u; while (__hip_atomic_load(cnt, __ATOMIC_RELAXED, __HIP_MEMORY_SCOPE_AGENT) < need) { __builtin_amdgcn_s_sleep(1); if (++sp > (1u << 22)) break; }
        __builtin_amdgcn_fence(__ATOMIC_ACQUIRE, "agent"); asm volatile("s_waitcnt vmcnt(0)" ::: "memory");
    }
    __syncthreads();
}

__global__ void __launch_bounds__(512, 2) fwd_megakernel(Params p0) {
    extern __shared__ __attribute__((aligned(16))) unsigned char lds_raw[];
    LAS unsigned char* lds = (LAS unsigned char*)lds_raw;
    if (threadIdx.x < 16) ((LAS unsigned*)(lds + LDS_CTL))[threadIdx.x] = 0u;
    __syncthreads();
    XcdBarrier xbar; xbar.bar = (unsigned*)(p0.ws + WS_BAR); xbar.x = 0; xbar.st = (volatile LAS unsigned*)(lds + LDS_CTL + 16);
    if (p0.ph_hi - p0.ph_lo > 1) xbar = xcd_barrier_post((unsigned*)(p0.ws + WS_BAR), (volatile LAS unsigned*)(lds + LDS_CTL + 16));
    for (int ph = p0.ph_lo; ph < p0.ph_hi; ++ph) {
#if defined(__HIP_DEVICE_COMPILE__)
        const __attribute__((address_space(4))) Params* pp = (const __attribute__((address_space(4))) Params*)__builtin_amdgcn_kernarg_segment_ptr();
        asm volatile("" : "+s"(pp));
        const Params p = *pp;
        int G = gridDim.x, bid = blockIdx.x; asm volatile("" : "+s"(G), "+s"(bid));
#else
        const Params p = p0; int G = 0, bid = 0;
#endif
        unsigned char* ws = p.ws;
        float* mod = (float*)(ws + WS_MOD);
        const bool fuse = (G == 256) && (p0.ph_hi - p0.ph_lo > 1);
        if (fuse && (ph == 4 || ph == 7 || ph == 9 || ph == 12)) continue;
        for (int rep = 0; rep < (((DUPMASK >> ph) & 1) ? 2 : 1); ++rep)
        if (HAS(0) && ph == 0) {
            phase_prep(p, lds, rep == 0);
        } else if (HAS(1) && (ph == 1 || ph == 4 || ph == 9)) {
            const float* sl = ph == 1 ? p.x : p.out; const float* scx = p.ctx;
            const int nrows = ph == 9 ? NLAT : MR, midx = ph == 1 ? 0 : (ph == 4 ? 3 : 6);
            if (fuse && ph == 4)
                phase_rows<0>(sl, scx, MR, p.g_norm + DM, mod, 3, (bf16_t*)(ws + WS_H), nullptr, (const float*)(ws + WS_PART), NLAT + bid * 8, G * 8);
            else
            phase_rows<0>(sl, scx, nrows, p.g_norm + (ph == 1 ? 0 : (ph == 4 ? 1 : 2)) * DM, mod, midx, (bf16_t*)(ws + WS_H), nullptr, ph == 4 ? (const float*)(ws + WS_PART) : nullptr);
        } else if (HAS(2) && (ph == 2 || ph == 10)) {
            pg8::Gemm g{(const bf16_t*)(ws + WS_H), (const bf16_t*)(ws + (ph == 2 ? WS_WUP1 : WS_WUP2)), ph == 2 ? MR : NLAT, NUP, DM, DM};
            pg8::StaticOrder S; S.init(g.M, g.N, G, bid);
            EpiSwiglu E{(bf16_t*)(ws + WS_HID)};
            pg8::gemm_phase<EpiSwiglu>(lds, g, S, E);
            if (ph == 2) { const int busy = S.nwg % G; if (busy != 0 && bid >= busy) prep_weights(p, lds, 1, bid - busy, G - busy); else if (busy == 0) prep_weights(p, lds, 1, bid, G); }
        } else if (HAS(3) && (ph == 3 || ph == 8 || ph == 11)) {
            pg8::Gemm g;
            if (ph == 3) g = pg8::Gemm{(const bf16_t*)(ws + WS_HID), (const bf16_t*)(ws + WS_WDN1), NLAT, DM, DFF, DFF};
            else if (ph == 8) g = pg8::Gemm{(const bf16_t*)(ws + WS_ATT), (const bf16_t*)(ws + WS_WOUT), NLAT, DM, DM, DM};
            else g = pg8::Gemm{(const bf16_t*)(ws + WS_HID), (const bf16_t*)(ws + WS_WDN2), NLAT, DM, DFF, DFF};
            pg8::StaticOrder S; S.init(g.M, g.N, G, bid);
            EpiResid E{ph == 3 ? p.x : p.out, p.ctx, p.out, nullptr, mod, ph == 3 ? 2 : (ph == 8 ? 5 : 8), ph == 8 ? 1.0f : 0.5f};
            pg8::gemm_phase<EpiResid>(lds, g, S, E);
            if (fuse) {
                pg8::Unit u0; S.next(0, u0);
                unsigned* cnt = (unsigned*)(ws + WS_PCNT) + ((ph == 3 ? 0 : (ph == 8 ? 1 : 2)) * 64 + u0.pm) * 64;
                panel_handoff(cnt, 4u);
                const int r0 = u0.pm * 256 + (u0.pn & 3) * 64;
                if (ph == 11) phase_rows<1>(p.out, nullptr, r0 + 64, p.g_final, nullptr, 0, nullptr, p.out, nullptr, r0, 8);
                else phase_rows<0>(p.out, nullptr, r0 + 64, p.g_norm + (ph == 3 ? 1 : 2) * DM, mod, ph == 3 ? 3 : 6, (bf16_t*)(ws + WS_H), nullptr, nullptr, r0, 8);
            }
            if (ph == 3) {
                pg8::Gemm g2{(const bf16_t*)(ws + WS_HID), (const bf16_t*)(ws + WS_WDN1), NCTX, DM, DFF / 4, DFF};
                pg8::StaticOrder S2; S2.init(NCTX, DM, G, bid, 64, 4);
                EpiPartial E2{(float*)(ws + WS_PART)};
                pg8::gemm_phase<EpiPartial>(lds, g2, S2, E2);
                if (fuse) {
                    pg8::Unit u2; S2.next(0, u2);
                    panel_handoff((unsigned*)(ws + WS_PCNT) + (4 * 64 + (u2.pm - 64)) * 64, 32u);
                    const int rc = NLAT + (u2.pm - 64) * 256 + (u2.ks * 8 + u2.pn) * 8;
                    phase_rows<0>(p.out, p.ctx, rc + 8, p.g_norm + DM, mod, 3, (bf16_t*)(ws + WS_H), nullptr, (const float*)(ws + WS_PART), rc, 8);
                }
            }
        } else if (HAS(5) && ph == 5) {
            pg8::Gemm g{(const bf16_t*)(ws + WS_H), (const bf16_t*)(ws + WS_WIN), MR, PWP, DM, DM};
            pg8::StaticOrder S; S.init(g.M, g.N, G, bid);
            EpiWin E{(bf16_t*)(ws + WS_Q), (bf16_t*)(ws + WS_K), (bf16_t*)(ws + WS_V), (bf16_t*)(ws + WS_MQK), (bf16_t*)(ws + WS_MV), (bf16_t*)(ws + WS_MO), (float*)(ws + WS_GT),
                     p.q_gain, p.k_gain, p.gate_b, (const float*)(ws + WS_ROPE), (LAS float*)(lds + LDS_RED)};
            pg8::gemm_phase<EpiWin>(lds, g, S, E);
            { const int busy = S.nwg % G; if (busy != 0 && bid >= busy) prep_weights(p, lds, 2, bid - busy, G - busy); else if (busy == 0) prep_weights(p, lds, 2, bid, G); }
        } else if (HAS(6) && ph == 6) {
#if !defined(NO_MLSTM)
            for (int s = bid; s < 128 && rep == 0; s += G) { mlstm_stream(p, lds, s);
                if (fuse) {
                    asm volatile("s_waitcnt vmcnt(0)" ::: "memory"); __syncthreads();
                    if (otid() == 0) { __builtin_amdgcn_fence(__ATOMIC_RELEASE, "agent"); asm volatile("s_waitcnt vmcnt(0)" ::: "memory");
                        (void)__hip_atomic_fetch_add((unsigned*)(ws + WS_PCNT) + (3 * 64 + (s >> 1)) * 64, 1u, __ATOMIC_RELAXED, __HIP_MEMORY_SCOPE_AGENT); } } }
#endif
#if !defined(NO_ATTN)
            {
                int* ctr = (int*)(ws + WS_CTR) + rep * 8;
                for (int qi = 0; qi < 8; ++qi) {
                    const int bq = (bid + qi) & 7;
                    for (;;) {
                        __syncthreads();
                        if (otid() == 0) { int v = __hip_atomic_load(ctr + bq, __ATOMIC_RELAXED, __HIP_MEMORY_SCOPE_AGENT); if (v < 64) v = atomicAdd(ctr + bq, 1); *(LAS int*)(lds + LDS_CTL) = v; }
                        __syncthreads();
                        const int u = *(LAS int*)(lds + LDS_CTL);
                        if (u >= 64) break;
                        attn_unit(p, lds_raw, bq * 64 + u);
                    }
                }
            }
#endif
            if (fuse) {
                unsigned* pc = (unsigned*)(ws + WS_PCNT);
                for (;;) {
                    __syncthreads();
                    if (otid() == 0) { unsigned v = __hip_atomic_fetch_add(pc + 5 * 64 * 64, 1u, __ATOMIC_RELAXED, __HIP_MEMORY_SCOPE_AGENT);
                        if (v < 256u) { unsigned* c2 = pc + (3 * 64 + (v >> 2)) * 64; unsigned sp = 0u;
                            while (__hip_atomic_load(c2, __ATOMIC_RELAXED, __HIP_MEMORY_SCOPE_AGENT) < 2u) { __builtin_amdgcn_s_sleep(1); if (++sp > (1u << 22)) break; }
                            __builtin_amdgcn_fence(__ATOMIC_ACQUIRE, "agent"); asm volatile("s_waitcnt vmcnt(0)" ::: "memory"); }
                        *(LAS int*)(lds + LDS_CTL) = (int)v; }
                    __syncthreads();
                    const int v = *(LAS int*)(lds + LDS_CTL);
                    if (v >= 256) break;
                    combine_item(p, v >> 5, (v >> 2) & 7, (v & 3) * 512);
                }
            }
        } else if (HAS(7) && ph == 7) {
            phase_combine(p);
        } else if (HAS(12) && ph == 12) {
            phase_rows<1>(p.out, nullptr, NLAT, p.g_final, nullptr, 0, nullptr, p.out, nullptr);
        }
        if (ph + 1 < p0.ph_hi && !(fuse && ph == 11)) {
            if (p0.ph_hi > 1000) cg::this_grid().sync(); else xcd_barrier(xbar);
        }
    }
}

extern "C" void kernel_launch(void* const* d_in, const int* in_sizes, int n_in, void* d_out, int out_size, void* d_ws, size_t ws_size, hipStream_t stream) {
    static int grid = 0;
    if (grid == 0) {
        if (n_in != 20 || out_size != NLAT * DM || ws_size < WS_END) { fprintf(stderr, "kernel_launch: unexpected shapes (n_in %d out %d ws %zu need %zu)\n", n_in, out_size, ws_size, (size_t)WS_END); grid = -1; return; }
        int dev = 0, cus = 0, per_cu = 0;
        hipGetDevice(&dev); hipDeviceGetAttribute(&cus, hipDeviceAttributeMultiprocessorCount, dev);
        if (hipFuncSetAttribute((const void*)fwd_megakernel, hipFuncAttributeMaxDynamicSharedMemorySize, LDS_BYTES) != hipSuccess) { fprintf(stderr, "kernel_launch: hipFuncSetAttribute failed\n"); grid = -1; return; }
        hipOccupancyMaxActiveBlocksPerMultiprocessor(&per_cu, (const void*)fwd_megakernel, 512, LDS_BYTES);
        if (per_cu < 1) { fprintf(stderr, "kernel_launch: occupancy query says %d blocks per CU\n", per_cu); per_cu = 1; }
        (void)hipGetLastError();
        grid = cus * 1;
    }
    if (grid < 0) return;
    (void)hipMemsetAsync((char*)d_ws + WS_MOD, 0, (size_t)(WS_ROPE - WS_MOD), stream);
    Params p{};
    p.x = (const float*)d_in[0]; p.c = (const float*)d_in[1]; p.ctx = (const float*)d_in[2]; p.c_ctx = (const float*)d_in[3]; p.w_mod = (const float*)d_in[4]; p.b_mod = (const float*)d_in[5];
    p.g_norm = (const float*)d_in[6]; p.w_up1 = (const float*)d_in[7]; p.w_dn1 = (const float*)d_in[8]; p.w_up2 = (const float*)d_in[9]; p.w_dn2 = (const float*)d_in[10]; p.w_in = (const float*)d_in[11];
    p.q_gain = (const float*)d_in[12]; p.k_gain = (const float*)d_in[13]; p.conv_w = (const float*)d_in[14]; p.conv_b = (const float*)d_in[15]; p.gate_b = (const float*)d_in[16]; p.m_gain = (const float*)d_in[17];
    p.w_out = (const float*)d_in[18]; p.g_final = (const float*)d_in[19]; p.out = (float*)d_out; p.ws = (unsigned char*)d_ws;
#if MK_MULTI
    for (int ph = 0; ph < NPH; ++ph) { p.ph_lo = ph; p.ph_hi = ph + 1; hipLaunchKernelGGL(fwd_megakernel, dim3(grid), dim3(512), LDS_BYTES, stream, p); }
#else
    p.ph_lo = 0; p.ph_hi = NPH;
    void* args[] = {&p};
    hipError_t e = hipLaunchCooperativeKernel((const void*)fwd_megakernel, dim3(grid), dim3(512), args, LDS_BYTES, stream);
    if (e != hipSuccess) fprintf(stderr, "cooperative launch failed: %s (grid %d)\n", hipGetErrorString(e), grid);
#endif
}
```

```cpp
#include <hip/hip_runtime.h>
#include <hip/hip_cooperative_groups.h>
#include <cstdio>
#include <cstdint>
namespace cg = cooperative_groups;

#define LAS __attribute__((address_space(3)))
typedef unsigned short bf16_t;
typedef short bf16x8 __attribute__((ext_vector_type(8)));
typedef short s16x4 __attribute__((ext_vector_type(4)));
typedef float f32x4 __attribute__((ext_vector_type(4)));
typedef float f32x16 __attribute__((ext_vector_type(16)));
typedef unsigned u32x4 __attribute__((ext_vector_type(4)));
typedef unsigned u32x2 __attribute__((ext_vector_type(2)));

#ifndef PHMASK
#define PHMASK 0x1fff
#endif
#define HAS(k) ((PHMASK >> (k)) & 1)
#ifndef DUPMASK
#define DUPMASK 0
#endif
#ifndef MK_MULTI
#define MK_MULTI 0
#endif

constexpr int DM = 2048, NB = 8, TL = 2048, TCX = 256, NLAT = NB * TL, NCTX = NB * TCX, MR = NLAT + NCTX;
constexpr int DFF = 5632, NUP = 2 * DFF, PW = 5664, PWP = 5888, NMOD = 9, MODW = NMOD * DM;
constexpr int SKV = TCX + TL;
constexpr float RMS_EPS = 1e-6f;
constexpr int NPH = 13;

constexpr size_t al256(size_t x) { return (x + 255) / 256 * 256; }
constexpr size_t WS_MOD = 0;
constexpr size_t WS_CTR = WS_MOD + (size_t)9 * MODW * 4;
constexpr size_t WS_BAR = WS_CTR + 256;
constexpr size_t WS_PCNT = al256(WS_BAR + 3456 * 4);
constexpr size_t WS_ROPE = WS_PCNT + (size_t)(5 * 64 + 1) * 256;
constexpr size_t WS_WUP1 = al256(WS_ROPE + 4096 * 4);
constexpr size_t WS_WDN1 = WS_WUP1 + (size_t)NUP * DM * 2;
constexpr size_t WS_WIN = WS_WDN1 + (size_t)DM * DFF * 2;
constexpr size_t WS_WOUT = WS_WIN + (size_t)PWP * DM * 2;
constexpr size_t WS_WUP2 = WS_WOUT + (size_t)DM * DM * 2;
constexpr size_t WS_WDN2 = WS_WUP2 + (size_t)NUP * DM * 2;
constexpr size_t WS_H = WS_WDN2 + (size_t)DM * DFF * 2;
constexpr size_t WS_HID = WS_H + (size_t)MR * DM * 2;
constexpr size_t WS_Q = WS_HID;
constexpr size_t WS_K = WS_Q + (size_t)NLAT * 1024 * 2;
constexpr size_t WS_V = WS_K + (size_t)NB * SKV * 256 * 2;
constexpr size_t WS_MQK = WS_V + (size_t)NB * SKV * 256 * 2;
constexpr size_t WS_MV = WS_MQK + (size_t)MR * 2048 * 2;
constexpr size_t WS_MO = WS_MV + (size_t)MR * 1024 * 2;
constexpr size_t WS_GT = WS_MO + (size_t)NLAT * 1024 * 2;
constexpr size_t WS_PROJ_END = WS_GT + (size_t)MR * 32 * 4;
constexpr size_t WS_ATT = WS_HID + (size_t)MR * DFF * 2;
constexpr size_t WS_PART = WS_ATT;
constexpr size_t WS_XC = WS_ATT + (size_t)NLAT * 2048 * 2;
constexpr size_t WS_END = WS_XC + (size_t)NCTX * DM * 4;
static_assert(WS_PROJ_END <= WS_ATT, "projection outputs must fit in the hidden buffer");

constexpr int LDS_STAGE = 131072;
constexpr int LDS_RED = LDS_STAGE;
constexpr int LDS_CTL = LDS_STAGE + 8192;
constexpr int LDS_BYTES = LDS_CTL + 64;
constexpr int QS_LD = 136, JS_LD = 72;
constexpr int ML_QS = 0, ML_KS = ML_QS + 64 * QS_LD * 2, ML_KT = ML_KS + 64 * QS_LD * 2, ML_VT = ML_KT + 128 * 64 * 2, ML_PS = ML_VT + 144 * 64 * 2,
              ML_C0 = ML_PS + 64 * JS_LD * 2, ML_SC = ML_C0 + 144 * QS_LD * 2, ML_CW = ML_SC + 5 * 64 * 4, ML_CB = ML_CW + 5 * 256 * 4, ML_END = ML_CB + 256 * 4;
static_assert(ML_END <= LDS_BYTES, "mLSTM LDS");

struct Params {
    const float *x, *c, *ctx, *c_ctx, *w_mod, *b_mod, *g_norm, *w_up1, *w_dn1, *w_up2, *w_dn2, *w_in, *q_gain, *k_gain, *conv_w, *conv_b, *gate_b, *m_gain, *w_out, *g_final;
    float* out; unsigned char* ws; int ph_lo, ph_hi;
};

__device__ __forceinline__ int otid() { int t = threadIdx.x; asm volatile("" : "+v"(t)); return t; }
__device__ __forceinline__ unsigned cvt_pk_bf16(float lo, float hi) { unsigned r; asm volatile("v_cvt_pk_bf16_f32 %0, %1, %2" : "=v"(r) : "v"(lo), "v"(hi)); return r; }
__device__ __forceinline__ float bf2f(unsigned short v) { return __uint_as_float(((unsigned)v) << 16); }
__device__ __forceinline__ float silu_f(float x) { return x * __builtin_amdgcn_rcpf(1.0f + __expf(-x)); }
__device__ __forceinline__ float sigmoid_f(float x) { return __builtin_amdgcn_rcpf(1.0f + __expf(-x)); }
__device__ __forceinline__ float logsigmoid_f(float x) { return fminf(x, 0.f) - __logf(1.0f + __expf(-fabsf(x))); }

namespace pg8 {
constexpr int BM = 256, BK = 64, HALF = 128, HTB = HALF * BK * 2, NXCD = 8, WGM = 8;
__device__ __forceinline__ int lds_byte(int r, int c) { const int st = (r >> 4) * 2 + (c >> 5), rr = r & 15, cc = c & 31, ob = rr * 64 + cc * 2; return st * 1024 + (ob ^ (((ob >> 9) & 1) << 5)); }
__device__ __forceinline__ void stage_rc(int b, int& R, int& C) { const int st = b / 1024, sb = b % 1024, swz = sb ^ (((sb >> 9) & 1) << 5); R = (st >> 1) * 16 + swz / 64; C = (st & 1) * 32 + (swz % 64) / 2; }
__device__ __forceinline__ int perm32(int rho) { const int n = rho >> 4, i = rho & 15; return 8 * (i >> 2) + 4 * n + (i & 3); }
struct Unit { int pm, pn, ks; };
struct Gemm { const bf16_t* A; const bf16_t* Bt; int M, N, K, ld; };
struct StaticOrder {
    int nM, nN, nwg, G, c, pm0, nNr;
    __device__ void init(int M, int N, int G_, int c_, int pm0_ = 0, int ksplit = 1) { nM = M / BM; nNr = N / BM; nN = nNr * ksplit; nwg = nM * nN; G = G_; c = c_; pm0 = pm0_; }
    __device__ bool next(int i, Unit& u) const {
        const long L = (long)i * G + c; if (L >= nwg) return false;
        int wgid = (int)L; { const int q = nwg / NXCD, r = nwg % NXCD, xcd = wgid % NXCD, off = wgid / NXCD; wgid = (xcd < r ? xcd * (q + 1) : r * (q + 1) + (xcd - r) * q) + off; }
        const int nig = WGM * nN, gid = wgid / nig, fm = gid * WGM, gsz = (nM - fm) < WGM ? (nM - fm) : WGM;
        u.pm = pm0 + fm + ((wgid % nig) % gsz); const int pe = (wgid % nig) / gsz; u.pn = pe % nNr; u.ks = pe / nNr; return true;
    }
};

template <class Epi>
__device__ __forceinline__ void gemm_phase(LAS unsigned char* lds, const Gemm g, const StaticOrder& S, const Epi& E) {
    const int tid = otid(), wid = __builtin_amdgcn_readfirstlane(tid >> 6), lane = tid & 63, wr = wid >> 2, wc = wid & 3, fr = lane & 15, fq = lane >> 4;
    const int K = g.K, nt = K / BK;
    unsigned voffA[2], voffB[2];
#pragma unroll
    for (int i = 0; i < 2; ++i) { int R, C; stage_rc(tid * 16 + i * 8192, R, C); const int Rb = Epi::PERM ? ((R & ~31) + perm32(R & 31)) : R;
        voffA[i] = (unsigned)(R * g.ld + C) * 2u; voffB[i] = (unsigned)(Rb * g.ld + C) * 2u; }
    const size_t kstep = (size_t)(BK * 2);
    const size_t hstep = (size_t)HALF * g.ld * 2;
    const size_t ksB = (size_t)K * 2;
    const size_t tstep = 2 * hstep;
    const unsigned ldsw = (unsigned)wid * 1024u;
    const int aoff = lds_byte(wr * 64 + fr, fq * 8), boff = lds_byte(wc * 32 + fr, fq * 8);
#define PG8_SA(b, h) (((b) * 2 + (h)) * HTB)
#define PG8_SB(b, h) ((4 + (b) * 2 + (h)) * HTB)
#define PG8_STAGE(bufoff, gbase, voff) do { _Pragma("unroll") for (int _i = 0; _i < 2; ++_i) \
        __builtin_amdgcn_global_load_lds((const unsigned*)((const char*)(gbase) + (voff)[_i]), (LAS unsigned*)(lds + (bufoff) + ldsw + _i * 8192), 16, 0, 0); } while (0)
#define PG8_LDA(dst, b, h) do { _Pragma("unroll") for (int m = 0; m < 4; ++m) _Pragma("unroll") for (int k = 0; k < 2; ++k) dst[m][k] = *(const LAS bf16x8*)(lds + PG8_SA(b, h) + aoff + m * 2048 + k * 1024); } while (0)
#define PG8_LDB(dst, b, h) do { _Pragma("unroll") for (int n = 0; n < 2; ++n) _Pragma("unroll") for (int k = 0; k < 2; ++k) dst[n][k] = *(const LAS bf16x8*)(lds + PG8_SB(b, h) + boff + n * 2048 + k * 1024); } while (0)
#define PG8_MMA(ai, bj, At, Bt) do { __builtin_amdgcn_s_setprio(1); _Pragma("unroll") for (int m = 0; m < 4; ++m) _Pragma("unroll") for (int n = 0; n < 2; ++n) _Pragma("unroll") for (int k = 0; k < 2; ++k) \
        acc[ai][bj][m][n] = __builtin_amdgcn_mfma_f32_16x16x32_bf16(Bt[n][k], At[m][k], acc[ai][bj][m][n], 0, 0, 0); __builtin_amdgcn_s_setprio(0); } while (0)
#define PG8_WAIT_V(n) asm volatile("s_waitcnt vmcnt(" #n ")" ::: "memory")
#define PG8_WAIT_L(n) asm volatile("s_waitcnt lgkmcnt(" #n ")" ::: "memory")
#define PG8_BAR __builtin_amdgcn_s_barrier()
#define PG8_SCHED __builtin_amdgcn_sched_barrier(0)
    Unit cur, nxt; int ui = 0;
    if (!S.next(0, cur)) return;
    f32x4 acc[2][2][4][2];
#pragma unroll
    for (int a = 0; a < 2; ++a)
#pragma unroll
        for (int b = 0; b < 2; ++b)
#pragma unroll
            for (int m = 0; m < 4; ++m)
#pragma unroll
                for (int n = 0; n < 2; ++n) acc[a][b][m][n] = (f32x4){0.f, 0.f, 0.f, 0.f};
    bf16x8 At[4][2], B0[2][2], B1[2][2];
    const char* cA = (const char*)g.A + (size_t)cur.pm * tstep + cur.ks * ksB; const char* cB = (const char*)g.Bt + (size_t)cur.pn * tstep + cur.ks * ksB;
    PG8_STAGE(PG8_SB(0, 0), cB, voffB); PG8_STAGE(PG8_SA(0, 0), cA, voffA); PG8_STAGE(PG8_SB(0, 1), cB + hstep, voffB); PG8_STAGE(PG8_SA(0, 1), cA + hstep, voffA);
    if (wr == 1) PG8_BAR;
    PG8_WAIT_V(4); PG8_BAR;
    PG8_STAGE(PG8_SB(1, 0), cB + kstep, voffB); PG8_STAGE(PG8_SA(1, 0), cA + kstep, voffA); PG8_STAGE(PG8_SB(1, 1), cB + hstep + kstep, voffB);
    PG8_WAIT_V(6); PG8_BAR;
    for (;;) {
        const bool has_next = S.next(ui + 1, nxt);
        const char* nA = has_next ? (const char*)g.A + (size_t)nxt.pm * tstep + nxt.ks * ksB : cA; const char* nB = has_next ? (const char*)g.Bt + (size_t)nxt.pn * tstep + nxt.ks * ksB : cB;
        for (int t = 0; t < nt; t += 2) {
            const bool last = (t == nt - 2);
            const char* a1 = cA + (size_t)(t + 1) * kstep;
            const char* a2 = last ? nA : cA + (size_t)(t + 2) * kstep; const char* b2 = last ? nB : cB + (size_t)(t + 2) * kstep;
            const char* a3 = a2 + kstep; const char* b3 = b2 + kstep;
            PG8_LDB(B0, 0, 0); PG8_SCHED; PG8_LDA(At, 0, 0); PG8_STAGE(PG8_SA(1, 1), a1 + hstep, voffA);
            PG8_WAIT_L(8); PG8_BAR; PG8_WAIT_L(0); PG8_MMA(0, 0, At, B0); PG8_BAR; PG8_SCHED;
            PG8_LDB(B1, 0, 1); PG8_STAGE(PG8_SB(0, 0), b2, voffB);
            PG8_BAR; PG8_WAIT_L(0); PG8_MMA(0, 1, At, B1); PG8_BAR;
            PG8_LDA(At, 0, 1); PG8_STAGE(PG8_SA(0, 0), a2, voffA);
            PG8_BAR; PG8_WAIT_L(0); PG8_MMA(1, 0, At, B0); PG8_BAR; PG8_SCHED;
            PG8_STAGE(PG8_SB(0, 1), b2 + hstep, voffB);
            PG8_WAIT_V(6); PG8_BAR; PG8_MMA(1, 1, At, B1); PG8_BAR;
            PG8_LDB(B0, 1, 0); PG8_SCHED; PG8_LDA(At, 1, 0); PG8_STAGE(PG8_SA(0, 1), a2 + hstep, voffA);
            PG8_WAIT_L(8); PG8_BAR; PG8_WAIT_L(0); PG8_MMA(0, 0, At, B0); PG8_BAR; PG8_SCHED;
            PG8_LDB(B1, 1, 1); PG8_STAGE(PG8_SB(1, 0), b3, voffB);
            PG8_BAR; PG8_WAIT_L(0); PG8_MMA(0, 1, At, B1); PG8_BAR;
            PG8_LDA(At, 1, 1); PG8_STAGE(PG8_SA(1, 0), a3, voffA);
            PG8_BAR; PG8_WAIT_L(0); PG8_MMA(1, 0, At, B0); PG8_BAR; PG8_SCHED;
            PG8_STAGE(PG8_SB(1, 1), b3 + hstep, voffB);
            PG8_WAIT_V(6); PG8_BAR; PG8_MMA(1, 1, At, B1); PG8_BAR;
        }
        E(acc, cur, wr, wc, fr, fq);
        if (!has_next) break;
#pragma unroll
        for (int a = 0; a < 2; ++a)
#pragma unroll
            for (int b = 0; b < 2; ++b)
#pragma unroll
                for (int m = 0; m < 4; ++m)
#pragma unroll
                    for (int n = 0; n < 2; ++n) acc[a][b][m][n] = (f32x4){0.f, 0.f, 0.f, 0.f};
        cur = nxt; cA = nA; cB = nB; ++ui;
    }
    PG8_WAIT_V(0);
    if (wr == 0) PG8_BAR;
    PG8_BAR;
#undef PG8_SA
#undef PG8_SB
#undef PG8_STAGE
#undef PG8_LDA
#undef PG8_LDB
#undef PG8_MMA
#undef PG8_WAIT_V
#undef PG8_WAIT_L
#undef PG8_BAR
#undef PG8_SCHED
}
}

struct EpiSwiglu {
    static constexpr bool PERM = true;
    bf16_t* H;
    __device__ __forceinline__ void operator()(const f32x4 (&acc)[2][2][4][2], const pg8::Unit& u, int wr, int wc, int fr, int fq) const {
        const int row0 = u.pm * 256 + wr * 64 + fr, col0 = u.pn * 128 + wc * 32 + 8 * fq;
#pragma unroll
        for (int ai = 0; ai < 2; ++ai)
#pragma unroll
            for (int m = 0; m < 4; ++m) {
                bf16_t* rowp = H + (size_t)(row0 + ai * 128 + m * 16) * DFF + col0;
                const f32x4 a0 = acc[ai][0][m][0], a1 = acc[ai][0][m][1], b0 = acc[ai][1][m][0], b1 = acc[ai][1][m][1];
                float v[8];
#pragma unroll
                for (int j = 0; j < 4; ++j) { v[j] = silu_f(a0[j]) * b0[j]; v[4 + j] = silu_f(a1[j]) * b1[j]; }
                u32x4 w; w.x = cvt_pk_bf16(v[0], v[1]); w.y = cvt_pk_bf16(v[2], v[3]); w.z = cvt_pk_bf16(v[4], v[5]); w.w = cvt_pk_bf16(v[6], v[7]);
                *(u32x4*)rowp = w;
            }
    }
};
struct EpiResid {
    static constexpr bool PERM = false;
    const float* resid_l; const float* resid_c; float* out_l; float* out_c; const float* mod; int gidx; float coef;
    __device__ __forceinline__ void operator()(const f32x4 (&acc)[2][2][4][2], const pg8::Unit& u, int wr, int wc, int fr, int fq) const {
        const bool isctx = u.pm >= 64; const int b = isctx ? 8 : (u.pm >> 3);
        const int row0 = (isctx ? (u.pm - 64) : u.pm) * 256 + wr * 64 + fr, col0 = u.pn * 256 + wc * 32 + 4 * fq;
        const float* gp = mod + (size_t)(b * NMOD + gidx) * DM + col0;
        const float* rb = isctx ? resid_c : resid_l; float* ob = isctx ? out_c : out_l;
        f32x4 gv[2][2];
#pragma unroll
        for (int bj = 0; bj < 2; ++bj)
#pragma unroll
            for (int n = 0; n < 2; ++n) gv[bj][n] = *(const f32x4*)(gp + bj * 128 + n * 16) * coef;
#pragma unroll
        for (int ai = 0; ai < 2; ++ai)
#pragma unroll
            for (int m = 0; m < 4; ++m) {
                const size_t o = (size_t)(row0 + ai * 128 + m * 16) * DM + col0;
#pragma unroll
                for (int bj = 0; bj < 2; ++bj)
#pragma unroll
                    for (int n = 0; n < 2; ++n) { const f32x4 r = *(const f32x4*)(rb + o + bj * 128 + n * 16); *(f32x4*)(ob + o + bj * 128 + n * 16) = r + gv[bj][n] * acc[ai][bj][m][n]; }
            }
    }
};
struct EpiPartial {
    static constexpr bool PERM = false;
    float* P;
    __device__ __forceinline__ void operator()(const f32x4 (&acc)[2][2][4][2], const pg8::Unit& u, int wr, int wc, int fr, int fq) const {
        const int row0 = (u.pm - 64) * 256 + wr * 64 + fr, col0 = u.pn * 256 + wc * 32 + 4 * fq;
        float* ob = P + (size_t)u.ks * NCTX * DM;
#pragma unroll
        for (int ai = 0; ai < 2; ++ai)
#pragma unroll
            for (int m = 0; m < 4; ++m) {
                const size_t o = (size_t)(row0 + ai * 128 + m * 16) * DM + col0;
#pragma unroll
                for (int bj = 0; bj < 2; ++bj)
#pragma unroll
                    for (int n = 0; n < 2; ++n) *(f32x4*)(ob + o + bj * 128 + n * 16) = acc[ai][bj][m][n];
            }
    }
};
__device__ __forceinline__ int win_src(int slot) {
    if (slot >= PW) return -1;
    if (slot >= 1280) return slot;
    const int head = slot >> 7, s = slot & 127, wc = s >> 5, n = (s >> 4) & 1, fq = (s >> 2) & 3, j = s & 3;
    return head * 128 + (wc >> 1) * 64 + n * 32 + (wc & 1) * 16 + fq * 4 + j;
}
struct EpiWin {
    static constexpr bool PERM = false;
    bf16_t *Q, *K, *V, *MQK, *MV, *MO; float* GT; const float *qg, *kg, *gb, *rope; LAS float* red;
    __device__ __forceinline__ void st4(bf16_t* p, f32x4 v) const { u32x2 w; w.x = cvt_pk_bf16(v[0], v[1]); w.y = cvt_pk_bf16(v[2], v[3]); *(u32x2*)p = w; }
    __device__ __forceinline__ void operator()(const f32x4 (&acc)[2][2][4][2], const pg8::Unit& u, int wr, int wc, int fr, int fq) const {
        asm volatile("" : "+v"(fr), "+v"(fq));
        const int pn = u.pn; const bool isctx = u.pm >= 64;
        const int rt0 = wr * 64 + fr;
        const int grow0 = u.pm * 256 + rt0;
        if (pn <= 4) {
            const float* gain = pn < 4 ? qg : kg;
            const int d1 = (wc >> 1) * 64 + (wc & 1) * 16 + 4 * fq;
            const f32x4 g1 = *(const f32x4*)(gain + d1), g2 = *(const f32x4*)(gain + d1 + 32);
#pragma unroll
            for (int ai = 0; ai < 2; ++ai)
#pragma unroll
                for (int m = 0; m < 4; ++m)
#pragma unroll
                    for (int bj = 0; bj < 2; ++bj) {
                        const f32x4 a = acc[ai][bj][m][0], c = acc[ai][bj][m][1];
                        float ss = a[0] * a[0] + a[1] * a[1] + a[2] * a[2] + a[3] * a[3] + c[0] * c[0] + c[1] * c[1] + c[2] * c[2] + c[3] * c[3];
                        ss += __shfl_xor(ss, 16); ss += __shfl_xor(ss, 32);
                        if (fq == 0) red[((rt0 + ai * 128 + m * 16) * 2 + bj) * 4 + wc] = ss;
                    }
            asm volatile("s_waitcnt lgkmcnt(0)" ::: "memory"); __builtin_amdgcn_s_barrier(); asm volatile("" ::: "memory");
#pragma unroll
            for (int ai = 0; ai < 2; ++ai)
#pragma unroll
                for (int m = 0; m < 4; ++m) {
                    const int rl = rt0 + ai * 128 + m * 16, gr = grow0 + ai * 128 + m * 16;
                    int bidx, tok; if (isctx) { bidx = (gr - NLAT) >> 8; tok = (gr - NLAT) & 255; } else { bidx = gr >> 11; tok = gr & 2047; }
                    f32x4 cs = (f32x4){1.f, 1.f, 1.f, 1.f}, sn = (f32x4){0.f, 0.f, 0.f, 0.f};
                    if (!isctx) { const int pos = (wc >> 1) ? (tok & 63) : (tok >> 6); const int ro = pos * 32 + (wc & 1) * 16 + 4 * fq; cs = *(const f32x4*)(rope + ro); sn = *(const f32x4*)(rope + 2048 + ro); }
#pragma unroll
                    for (int bj = 0; bj < 2; ++bj) {
                        const f32x4 pr = *(const LAS f32x4*)(red + (rl * 2 + bj) * 4);
                        const float rs = __builtin_amdgcn_rsqf((pr[0] + pr[1] + pr[2] + pr[3]) * (1.0f / 128.0f) + RMS_EPS);
                        const f32x4 x1 = acc[ai][bj][m][0] * rs * g1, x2 = acc[ai][bj][m][1] * rs * g2;
                        const f32x4 y1 = x1 * cs - x2 * sn, y2 = x2 * cs + x1 * sn;
                        if (pn < 4) { if (!isctx) { bf16_t* qp = Q + (size_t)gr * 1024 + (pn * 2 + bj) * 128 + d1; st4(qp, y1); st4(qp + 32, y2); } }
                        else { bf16_t* kp = K + ((size_t)bidx * SKV + (isctx ? tok : TCX + tok)) * 256 + bj * 128 + d1; st4(kp, y1); st4(kp + 32, y2); }
                    }
                    __builtin_amdgcn_sched_barrier(0);
                }
        } else {
            const int cc0 = wc * 32 + 4 * fq;
#pragma unroll
            for (int ai = 0; ai < 2; ++ai)
#pragma unroll
                for (int m = 0; m < 4; ++m) {
                    const int gr = grow0 + ai * 128 + m * 16;
                    int bidx, tok; if (isctx) { bidx = (gr - NLAT) >> 8; tok = (gr - NLAT) & 255; } else { bidx = gr >> 11; tok = gr & 2047; }
#pragma unroll
                    for (int bj = 0; bj < 2; ++bj)
#pragma unroll
                        for (int n = 0; n < 2; ++n) {
                            const int cc = cc0 + bj * 128 + n * 16; const f32x4 v = acc[ai][bj][m][n];
                            if (pn == 5) st4(V + ((size_t)bidx * SKV + (isctx ? tok : TCX + tok)) * 256 + cc, v);
                            else if (pn < 14) st4(MQK + (size_t)gr * 2048 + (pn - 6) * 256 + cc, v);
                            else if (pn < 18) st4(MV + (size_t)gr * 1024 + (pn - 14) * 256 + cc, v);
                            else if (pn < 22) { if (!isctx) { f32x4 s; s[0] = sigmoid_f(v[0]); s[1] = sigmoid_f(v[1]); s[2] = sigmoid_f(v[2]); s[3] = sigmoid_f(v[3]); st4(MO + (size_t)gr * 1024 + (pn - 18) * 256 + cc, s); } }
                            else if (cc < 32) {
                                f32x4 t = v + *(const f32x4*)(gb + cc);
                                if (fq >= 2) { t[0] = logsigmoid_f(t[0]); t[1] = logsigmoid_f(t[1]); t[2] = logsigmoid_f(t[2]); t[3] = logsigmoid_f(t[3]); }
                                *(f32x4*)(GT + (size_t)gr * 32 + cc) = t;
                            }
                        }
                    __builtin_amdgcn_sched_barrier(0);
                }
        }
    }
};

__device__ __forceinline__ int up_src(int slot) { const int pn = slot >> 8, r = slot & 255; return (r >> 7) * DFF + pn * 128 + (r & 127); }
template <int MAP  >
__device__ __forceinline__ void prep_tile(const float* __restrict__ W, int Nsrc, bf16_t* __restrict__ Bt, int Kdim, int nt, int kt, LAS float* tl) {
    const int tid = otid();
    { const int n4 = tid & 63, kk = tid >> 6; const int slot = nt * 256 + 4 * n4;
      const int src = MAP == 0 ? slot : (MAP == 1 ? up_src(slot) : win_src(slot));
      f32x4 v[8];
#pragma unroll
      for (int pss = 0; pss < 8; ++pss) { v[pss] = (f32x4){0.f, 0.f, 0.f, 0.f}; if (src >= 0) v[pss] = *(const f32x4*)(W + (size_t)(kt * 64 + kk + pss * 8) * Nsrc + src); }
#pragma unroll
      for (int pss = 0; pss < 8; ++pss) *(LAS f32x4*)(tl + (kk + pss * 8) * 260 + 4 * n4) = v[pss]; }
    __syncthreads();
    { const int n = tid >> 1, kh = (tid & 1) * 32;
#pragma unroll
      for (int q = 0; q < 4; ++q) { float v[8];
#pragma unroll
          for (int e = 0; e < 8; ++e) v[e] = tl[(kh + q * 8 + e) * 260 + n];
          u32x4 w; w.x = cvt_pk_bf16(v[0], v[1]); w.y = cvt_pk_bf16(v[2], v[3]); w.z = cvt_pk_bf16(v[4], v[5]); w.w = cvt_pk_bf16(v[6], v[7]);
          *(u32x4*)(Bt + (size_t)(nt * 256 + n) * Kdim + kt * 64 + kh + q * 8) = w; } }
    __syncthreads();
}
__device__ __forceinline__ void prep_weights(const Params& p, LAS unsigned char* lds, int grp, int t0, int ts, int t1 = 1 << 30) {
    LAS float* tl = (LAS float*)lds;
    constexpr int T_UP = (NUP / 256) * (DM / 64), T_DN = (DM / 256) * (DFF / 64), T_IN = (PWP / 256) * (DM / 64), T_OUT = (DM / 256) * (DM / 64);
    int tot = grp == 0 ? T_UP : (grp == 1 ? T_DN + T_IN + T_OUT : T_UP + T_DN); if (t1 < tot) tot = t1;
    for (int t = t0; t < tot; t += ts) {
        int q = t;
        if (grp == 1) {
            if (q < T_DN) { prep_tile<0>(p.w_dn1, DM, (bf16_t*)(p.ws + WS_WDN1), DFF, q % (DM / 256), q / (DM / 256), tl); continue; } q -= T_DN;
            if (q < T_IN) { prep_tile<2>(p.w_in, PW, (bf16_t*)(p.ws + WS_WIN), DM, q % (PWP / 256), q / (PWP / 256), tl); continue; } q -= T_IN;
            prep_tile<0>(p.w_out, DM, (bf16_t*)(p.ws + WS_WOUT), DM, q % (DM / 256), q / (DM / 256), tl);
        } else {
            const float* wu = grp == 0 ? p.w_up1 : p.w_up2;
            if (q < T_UP) { prep_tile<1>(wu, NUP, (bf16_t*)(p.ws + (grp == 0 ? WS_WUP1 : WS_WUP2)), DM, q % (NUP / 256), q / (NUP / 256), tl); continue; } q -= T_UP;
            prep_tile<0>(p.w_dn2, DM, (bf16_t*)(p.ws + WS_WDN2), DFF, q % (DM / 256), q / (DM / 256), tl);
        }
    }
}
__device__ __forceinline__ void phase_prep(const Params& p, LAS unsigned char* lds, bool do_mod) {
    const int tid = otid(), G = gridDim.x, bid = blockIdx.x;
    float* mod = (float*)(p.ws + WS_MOD);
    LAS float* sv = (LAS float*)lds;
    LAS float* red = (LAS float*)(lds + 9 * 512 * 4);
    for (int item = bid; do_mod && item < 576; item += G) {
        const int cb = item >> 2, ks = item & 3;
        for (int i = tid; i < 9 * 512; i += 512) { const int b = i >> 9, k = i & 511; const float cv = b < 8 ? p.c[b * DM + ks * 512 + k] : p.c_ctx[ks * 512 + k]; sv[i] = silu_f(cv); }
        __syncthreads();
        const int c4 = tid & 31, kr = tid >> 5;
        f32x4 a[9];
#pragma unroll
        for (int b = 0; b < 9; ++b) a[b] = (f32x4){0.f, 0.f, 0.f, 0.f};
        for (int kk = kr; kk < 512; kk += 16) {
            const f32x4 w = *(const f32x4*)(p.w_mod + (size_t)(ks * 512 + kk) * MODW + cb * 128 + c4 * 4);
#pragma unroll
            for (int b = 0; b < 9; ++b) a[b] += w * sv[b * 512 + kk];
        }
#pragma unroll
        for (int b = 0; b < 9; ++b) *(LAS f32x4*)(red + (kr * 9 + b) * 128 + c4 * 4) = a[b];
        __syncthreads();
        for (int o = tid; o < 9 * 128; o += 512) { const int b = o >> 7, cidx = o & 127; float s = 0.f;
#pragma unroll
            for (int r = 0; r < 16; ++r) s += red[(r * 9 + b) * 128 + cidx];
            const int col = cb * 128 + cidx; if (ks == 0) s += p.b_mod[col];
            atomicAdd(mod + (size_t)b * MODW + col, s); }
        __syncthreads();
    }
    if (bid == G - 1) { float* rope = (float*)(p.ws + WS_ROPE);
        for (int i = tid; i < 2048; i += 512) { const int pos = i >> 5, idx = i & 31; const float inv = exp2f(-(float)idx * (13.287712379549449f / 32.0f)); const float ang = (float)pos * inv;
            rope[i] = cosf(ang); rope[2048 + i] = sinf(ang); } }
    { int t0 = bid, ts = G, t1 = 1 << 30; if (G == 256) { if (bid < 64) { ts = 64; t1 = 192; } else { t0 = 192 + (bid - 64); ts = 192; } }
      prep_weights(p, lds, 0, t0, ts, t1); }
}

template <int MODE>
__device__ __forceinline__ void phase_rows(const float* src_l, const float* src_c, int nrows, const float* g, const float* mod, int midx, bf16_t* outb, float* outf, const float* part,
                                           int rbase = -1, int rstride = 0) {
    const int wave = otid() >> 6, lane = otid() & 63;
    const int stride = rbase < 0 ? gridDim.x * 8 : rstride;
    for (int r0 = (rbase < 0 ? blockIdx.x * 8 : rbase) + wave; r0 < nrows; r0 += 2 * stride) {
        f32x4 v[2][8]; float ss[2] = {0.f, 0.f};
#pragma unroll
        for (int q = 0; q < 2; ++q) {
            const int r = r0 + q * stride;
            if (r < nrows) {
                const bool isctx = r >= NLAT; const float* xp = isctx ? src_c + (size_t)(r - NLAT) * DM : src_l + (size_t)r * DM;
#pragma unroll
                for (int k = 0; k < 8; ++k) v[q][k] = *(const f32x4*)(xp + (k * 64 + lane) * 4);
                if (isctx && part) {
                    const float* gt = mod + (size_t)(8 * NMOD + 2) * DM; const float* pp = part + (size_t)(r - NLAT) * DM;
#pragma unroll
                    for (int k = 0; k < 8; ++k) { const int c = (k * 64 + lane) * 4;
                        const f32x4 sum = (*(const f32x4*)(pp + c) + *(const f32x4*)(pp + (size_t)NCTX * DM + c)) + (*(const f32x4*)(pp + (size_t)2 * NCTX * DM + c) + *(const f32x4*)(pp + (size_t)3 * NCTX * DM + c));
                        v[q][k] += *(const f32x4*)(gt + c) * 0.5f * sum; }
                }
#pragma unroll
                for (int k = 0; k < 8; ++k) ss[q] += v[q][k][0] * v[q][k][0] + v[q][k][1] * v[q][k][1] + v[q][k][2] * v[q][k][2] + v[q][k][3] * v[q][k][3];
            }
        }
#pragma unroll
        for (int o = 32; o >= 1; o >>= 1) { ss[0] += __shfl_xor(ss[0], o); ss[1] += __shfl_xor(ss[1], o); }
#pragma unroll
        for (int q = 0; q < 2; ++q) {
            const int r = r0 + q * stride;
            if (r < nrows) {
                const float rs = rsqrtf(ss[q] * (1.0f / DM) + RMS_EPS);
                if (MODE == 0) {
                    const int b = r >= NLAT ? 8 : (r >> 11);
                    const float* sh = mod + (size_t)(b * NMOD + midx) * DM; const float* sc = sh + DM;
#pragma unroll
                    for (int k = 0; k < 8; ++k) { const int c = (k * 64 + lane) * 4; const f32x4 gg = *(const f32x4*)(g + c), s1 = *(const f32x4*)(sc + c), s0 = *(const f32x4*)(sh + c);
                        const f32x4 y = v[q][k] * rs * gg * (s1 + 1.0f) + s0; u32x2 w; w.x = cvt_pk_bf16(y[0], y[1]); w.y = cvt_pk_bf16(y[2], y[3]); *(u32x2*)(outb + (size_t)r * DM + c) = w; }
                } else {
#pragma unroll
                    for (int k = 0; k < 8; ++k) { const int c = (k * 64 + lane) * 4; const f32x4 gg = *(const f32x4*)(g + c); *(f32x4*)(outf + (size_t)r * DM + c) = v[q][k] * rs * gg; }
                }
            }
        }
    }
}

namespace att {
constexpr int D = 128, NW = 8, QBLK = 32, KVBLK = 64;
constexpr float SCALE = 0.088388347648318440f, THR = 8.f;
constexpr int LDQ = 1024, LDK = 256, LDO = 2048;
constexpr size_t SHM_V = KVBLK * D * 2, SHM_K = KVBLK * D * 2, SHM_ATTN = 2 * SHM_V + 2 * SHM_K + NW * 64 * 4;
#define KSWZ(row, colB) ((row) * 256 + ((colB) ^ (((row) & 7) << 4)))
#define SBAR() __builtin_amdgcn_sched_barrier(0)
__device__ __forceinline__ int crow(int r, int hi) { return (r & 3) + 8 * (r >> 2) + 4 * hi; }
__device__ __forceinline__ void partialSM(f32x16& p0, f32x16& p1, float& m_reg, float& mn, float& alpha) {
  constexpr float C = SCALE * 1.4426950408889634f;
  float pmax = p0[0]; for (int r = 1; r < 16; ++r) pmax = fmaxf(pmax, p0[r]); for (int r = 0; r < 16; ++r) pmax = fmaxf(pmax, p1[r]);
  { auto rr = __builtin_amdgcn_permlane32_swap(__float_as_uint(pmax), __float_as_uint(pmax), false, false);
    pmax = fmaxf(__uint_as_float(rr[0]), __uint_as_float(rr[1])); }
  if (__builtin_expect(__all(pmax - m_reg <= THR / SCALE), 1)) { mn = m_reg; alpha = 1.f; }
  else { mn = fmaxf(m_reg, pmax); alpha = __builtin_amdgcn_exp2f((m_reg - mn) * C); m_reg = mn; }
  float mnC = -mn * C;
  for (int r = 0; r < 16; ++r) p0[r] = fmaf(p0[r], C, mnC); for (int r = 0; r < 16; ++r) p1[r] = fmaf(p1[r], C, mnC);
  for (int r = 0; r < 16; ++r) p0[r] = __builtin_amdgcn_exp2f(p0[r]);
}
__device__ __forceinline__ void finishSM(f32x16& p0, f32x16& p1, float alpha, float& l_reg, bf16x8& pa0, bf16x8& pa1, bf16x8& pa2, bf16x8& pa3) {
  for (int r = 0; r < 16; ++r) p1[r] = __builtin_amdgcn_exp2f(p1[r]);
  float ps = 0; for (int r = 0; r < 16; ++r) ps += p0[r]; for (int r = 0; r < 16; ++r) ps += p1[r];
  { auto rr = __builtin_amdgcn_permlane32_swap(__float_as_uint(ps), __float_as_uint(ps), false, false);
    ps = __uint_as_float(rr[0]) + __uint_as_float(rr[1]); }
  l_reg = l_reg * alpha + ps;
#define PK4(P, BASE, OUT) do { unsigned a0 = cvt_pk_bf16(P[BASE + 0], P[BASE + 1]), a1 = cvt_pk_bf16(P[BASE + 2], P[BASE + 3]);   \
    unsigned b0 = cvt_pk_bf16(P[BASE + 4], P[BASE + 5]), b1 = cvt_pk_bf16(P[BASE + 6], P[BASE + 7]);                              \
    auto r0 = __builtin_amdgcn_permlane32_swap(a0, b0, false, false); auto r1 = __builtin_amdgcn_permlane32_swap(a1, b1, false, false); \
    u32x4 w = {r0[0], r1[0], r0[1], r1[1]}; OUT = *reinterpret_cast<bf16x8*>(&w); } while (0)
  PK4(p0, 0, pa0); PK4(p0, 8, pa1); PK4(p1, 0, pa2); PK4(p1, 8, pa3);
#undef PK4
}
__device__ __forceinline__ void qkt(f32x16& p0, f32x16& p1, const bf16_t* Ks, const bf16x8* qr, int r32, int hi) {
  p0 = f32x16{}; p1 = f32x16{};
  for (int d0 = 0; d0 < 8; ++d0) { int cb = (d0 * 16 + hi * 8) * 2;
    bf16x8 b0 = *reinterpret_cast<const bf16x8*>((const char*)Ks + KSWZ(r32, cb));
    bf16x8 b1 = *reinterpret_cast<const bf16x8*>((const char*)Ks + KSWZ(32 + r32, cb));
    p0 = __builtin_amdgcn_mfma_f32_32x32x16_bf16(b0, qr[d0], p0, 0, 0, 0);
    p1 = __builtin_amdgcn_mfma_f32_32x32x16_bf16(b1, qr[d0], p1, 0, 0, 0); }
}
__device__ __forceinline__ int v_st(int k, int c) { const int kk = (k & ~0xC) | ((k & 4) << 1) | ((k & 8) >> 1); return ((kk >> 3) * 4 + (c >> 5)) * 512 + ((kk & 7) * 32 + (c & 31)) * 2; }
__device__ __forceinline__ int v_rd_base(int lane) { return ((lane & 3) << 3) | (((lane >> 2) & 3) << 6) | (((lane >> 4) & 1) << 5) | (((lane >> 5) & 1) << 8); }
constexpr int v_rd_off(int d0, int ks, int half) { return d0 * 512 + ks * 4096 + half * 2048; }
template <int OFF> __device__ __forceinline__ s16x4 tr_read(int vb) {
  s16x4 r; asm volatile("ds_read_b64_tr_b16 %0, %1 offset:%2" : "=&v"(r) : "v"(vb), "i"(OFF) : "memory"); return r;
}
template <int D0> __device__ __forceinline__ void pv_one(f32x16& od, int vb, bf16x8 pa0, bf16x8 pa1, bf16x8 pa2, bf16x8 pa3) {
  const s16x4 l0 = tr_read<v_rd_off(D0, 0, 0)>(vb), h0 = tr_read<v_rd_off(D0, 0, 1)>(vb), l1 = tr_read<v_rd_off(D0, 1, 0)>(vb), h1 = tr_read<v_rd_off(D0, 1, 1)>(vb);
  const s16x4 l2 = tr_read<v_rd_off(D0, 2, 0)>(vb), h2 = tr_read<v_rd_off(D0, 2, 1)>(vb), l3 = tr_read<v_rd_off(D0, 3, 0)>(vb), h3 = tr_read<v_rd_off(D0, 3, 1)>(vb);
  asm volatile("s_waitcnt lgkmcnt(0)" ::: "memory"); SBAR();
#define PK(L, H) (bf16x8){L[0], L[1], L[2], L[3], H[0], H[1], H[2], H[3]}
  od = __builtin_amdgcn_mfma_f32_32x32x16_bf16(pa0, PK(l0, h0), od, 0, 0, 0);
  od = __builtin_amdgcn_mfma_f32_32x32x16_bf16(pa1, PK(l1, h1), od, 0, 0, 0);
  od = __builtin_amdgcn_mfma_f32_32x32x16_bf16(pa2, PK(l2, h2), od, 0, 0, 0);
  od = __builtin_amdgcn_mfma_f32_32x32x16_bf16(pa3, PK(l3, h3), od, 0, 0, 0);
#undef PK
}
__device__ __forceinline__ void pv_d0(f32x16* o, int vb, bf16x8 pa0, bf16x8 pa1, bf16x8 pa2, bf16x8 pa3) {
  pv_one<0>(o[0], vb, pa0, pa1, pa2, pa3); pv_one<1>(o[1], vb, pa0, pa1, pa2, pa3); pv_one<2>(o[2], vb, pa0, pa1, pa2, pa3); pv_one<3>(o[3], vb, pa0, pa1, pa2, pa3);
}
__device__ __forceinline__ void attn_dense_body(const bf16_t* __restrict__ Qb, const bf16_t* __restrict__ Kh, const bf16_t* __restrict__ Vh, bf16_t* __restrict__ Ob, int seq, char* lds) {
  const int tid = otid(), wid = tid >> 6, lane = tid & 63, r32 = lane & 31, hi = lane >> 5;
  bf16_t* V_lds = (bf16_t*)lds; bf16_t* K_lds = (bf16_t*)(lds + 2 * SHM_V);
  float* ws = (float*)(lds + 2 * SHM_V + 2 * SHM_K) + wid * 64; float* li_l = ws; float* al_l = ws + 32;
  float m_reg = -1e30f, l_reg = 0; f32x16 o[4] = {}; bf16x8 qr[8];
  const bf16_t* Qw = Qb + (long)(wid * QBLK + r32) * LDQ + hi * 8;
#pragma unroll
  for (int d0 = 0; d0 < 8; ++d0) qr[d0] = *reinterpret_cast<const bf16x8*>(Qw + d0 * 16);
  const int sr = tid >> 4, sc = (tid & 15) * 8, vst0 = v_st(sr, sc), vst1 = v_st(32 + sr, sc);
  const int vb0 = (int)(uintptr_t)V_lds + v_rd_base(lane);
  struct { bf16x8 vs0, vs1, ks0, ks1; } sr_[2];
#define SLOAD(i, k0) do { sr_[i].vs0 = *reinterpret_cast<const bf16x8*>(&Vh[(long)((k0) + sr) * LDK + sc]); sr_[i].vs1 = *reinterpret_cast<const bf16x8*>(&Vh[(long)((k0) + 32 + sr) * LDK + sc]); \
    sr_[i].ks0 = *reinterpret_cast<const bf16x8*>(&Kh[(long)((k0) + sr) * LDK + sc]); sr_[i].ks1 = *reinterpret_cast<const bf16x8*>(&Kh[(long)((k0) + 32 + sr) * LDK + sc]); } while (0)
#define SWRITE(b, i) do { *(bf16x8*)((char*)V_lds + (b) * SHM_V + vst0) = sr_[i].vs0;          \
    *(bf16x8*)((char*)V_lds + (b) * SHM_V + vst1) = sr_[i].vs1; int kc = sc * 2;               \
    *(bf16x8*)((char*)K_lds + (b) * SHM_K + KSWZ(sr, kc)) = sr_[i].ks0;                       \
    *(bf16x8*)((char*)K_lds + (b) * SHM_K + KSWZ(32 + sr, kc)) = sr_[i].ks1; } while (0)
#define SWAIT() asm volatile("s_waitcnt vmcnt(4)" ::: "memory")
#define RESC(a) do { if (__any((a) < 1.f)) { if (hi == 0) al_l[r32] = (a); asm volatile("s_waitcnt lgkmcnt(0)" ::: "memory"); \
    for (int d = 0; d < 4; ++d) for (int r = 0; r < 16; ++r) o[d][r] *= al_l[crow(r, hi)]; } } while (0)
  f32x16 pA0, pA1, pB0, pB1; float mnA, mnB, alA, alB; bf16x8 pa0, pa1, pa2, pa3; const int NT = seq / KVBLK;
  constexpr int SE = 0, SO = 1;
  SLOAD(SE, 0); asm volatile("s_waitcnt vmcnt(0)" ::: "memory"); SWRITE(0, SE); __syncthreads();
  qkt(pA0, pA1, K_lds, qr, r32, hi); partialSM(pA0, pA1, m_reg, mnA, alA);
  SLOAD(SO, KVBLK); if (2 < NT) SLOAD(SE, 2 * KVBLK);
  SWAIT(); SWRITE(1, SO); __syncthreads();
  for (int j = 1; j + 1 < NT; j += 2) {
    SBAR(); qkt(pB0, pB1, (bf16_t*)((char*)K_lds + SHM_K), qr, r32, hi);
    finishSM(pA0, pA1, alA, l_reg, pa0, pa1, pa2, pa3); SBAR();
    SLOAD(SO, (j + 2) * KVBLK); SBAR();
    pv_d0(o, vb0, pa0, pa1, pa2, pa3); partialSM(pB0, pB1, m_reg, mnB, alB);
    __syncthreads(); SWAIT(); SWRITE(0, SE);
    RESC(alB); __syncthreads();
    SBAR(); qkt(pA0, pA1, K_lds, qr, r32, hi);
    finishSM(pB0, pB1, alB, l_reg, pa0, pa1, pa2, pa3); SBAR();
    if (j + 3 < NT) SLOAD(SE, (j + 3) * KVBLK); SBAR();
    pv_d0(o, vb0 + (int)SHM_V, pa0, pa1, pa2, pa3); partialSM(pA0, pA1, m_reg, mnA, alA);
    __syncthreads(); SWAIT(); SWRITE(1, SO);
    RESC(alA); __syncthreads();
  }
  SBAR(); qkt(pB0, pB1, (bf16_t*)((char*)K_lds + SHM_K), qr, r32, hi);
  finishSM(pA0, pA1, alA, l_reg, pa0, pa1, pa2, pa3); SBAR();
  pv_d0(o, vb0, pa0, pa1, pa2, pa3); partialSM(pB0, pB1, m_reg, mnB, alB);
  __syncthreads(); RESC(alB);
  finishSM(pB0, pB1, alB, l_reg, pa0, pa1, pa2, pa3); SBAR();
  pv_d0(o, vb0 + (int)SHM_V, pa0, pa1, pa2, pa3);
  if (hi == 0) li_l[r32] = l_reg; asm volatile("s_waitcnt lgkmcnt(0)" ::: "memory");
  float rli[16];
#pragma unroll
  for (int r = 0; r < 16; ++r) rli[r] = __builtin_amdgcn_rcpf(li_l[crow(r, hi)]);
  bf16_t* Ow = Ob + (long)(wid * QBLK) * LDO;
#pragma unroll
  for (int r = 0; r < 16; ++r) { int orow = crow(r, hi);
    for (int d0 = 0; d0 < 4; ++d0) Ow[(long)orow * LDO + d0 * 32 + r32] = (bf16_t)(cvt_pk_bf16(o[d0][r] * rli[r], 0.f) & 0xffffu); }
#undef SLOAD
#undef SWRITE
#undef SWAIT
#undef RESC
}
}

__device__ __forceinline__ void attn_unit(const Params& p, unsigned char* lds_generic, int u) {
    const int qb = u & 7, g = (u >> 3) & 3, kvh = (u >> 5) & 1, b = u >> 6, hq = kvh * 4 + g;
    const bf16_t* Q = (const bf16_t*)(p.ws + WS_Q) + ((size_t)(b * TL + qb * 256)) * 1024 + hq * 128;
    const bf16_t* K = (const bf16_t*)(p.ws + WS_K) + (size_t)b * SKV * 256 + kvh * 128;
    const bf16_t* V = (const bf16_t*)(p.ws + WS_V) + (size_t)b * SKV * 256 + kvh * 128;
    bf16_t* O = (bf16_t*)(p.ws + WS_ATT) + ((size_t)(b * TL + qb * 256)) * 2048 + hq * 128;
    __syncthreads();
    att::attn_dense_body(Q, K, V, O, SKV, (char*)lds_generic);
}

__device__ __forceinline__ int jsw(int r, int c) { return r * 64 + ((((c) >> 3) ^ ((r ^ (r >> 3)) & 7)) << 3) + (c & 7); }
__device__ __forceinline__ f32x4 mfma16(bf16x8 a, bf16x8 b, f32x4 c) { return __builtin_amdgcn_mfma_f32_16x16x32_bf16(a, b, c, 0, 0, 0); }
__device__ __forceinline__ void mlstm_stream(const Params& p, LAS unsigned char* lds, int sid) {
    const int tid = otid(), w = __builtin_amdgcn_readfirstlane(tid >> 6), lane = tid & 63, fr = lane & 15, fq = lane >> 4;
    const int dir = sid & 1, h = (sid >> 1) & 7, b = sid >> 4;
    LAS bf16_t* Qs = (LAS bf16_t*)(lds + ML_QS); LAS bf16_t* Ks = (LAS bf16_t*)(lds + ML_KS); LAS bf16_t* KT = (LAS bf16_t*)(lds + ML_KT);
    LAS bf16_t* VT = (LAS bf16_t*)(lds + ML_VT); LAS bf16_t* Ps = (LAS bf16_t*)(lds + ML_PS); LAS bf16_t* C0 = (LAS bf16_t*)(lds + ML_C0);
    LAS float* sc_u = (LAS float*)(lds + ML_SC); LAS float* sc_pm = sc_u + 64; LAS float* sc_a = sc_u + 128; LAS float* sc_e = sc_u + 192;
    LAS float* cw = (LAS float*)(lds + ML_CW); LAS float* cbv = (LAS float*)(lds + ML_CB);
    const bf16_t* MQK = (const bf16_t*)(p.ws + WS_MQK); const bf16_t* MV = (const bf16_t*)(p.ws + WS_MV); const float* GT = (const float*)(p.ws + WS_GT);
    bf16_t* HO = (bf16_t*)(p.ws + WS_H) + (size_t)dir * NLAT * 1024;
    const int cg8 = (tid & 15) * 8, rg = tid >> 4, tl0 = 2 * rg;
    const int i0 = dir ? 63 - tl0 : tl0, i1 = dir ? i0 - 1 : i0 + 1, ie = dir ? i1 : i0;
    __syncthreads();
    for (int i = tid; i < 16 * 64; i += 512) VT[128 * 64 + i] = 0x3F80;
    for (int i = tid; i < 5 * 256; i += 512) { const int j = i >> 8, c = i & 255; cw[i] = p.conv_w[j * 2048 + (c < 128 ? h * 128 + c : 1024 + h * 128 + (c - 128))]; }
    for (int i = tid; i < 256; i += 512) cbv[i] = p.conv_b[i < 128 ? h * 128 + i : 1024 + h * 128 + (i - 128)];
    f32x4 C[9];
#pragma unroll
    for (int i = 0; i < 9; ++i) C[i] = (f32x4){0.f, 0.f, 0.f, 0.f};
    float m0 = 0.f;
    bf16x8 xq[6], xk[6], xv0, xv1; float g_ig, g_lf;
#define ML_CHUNK(ci_, lat_, chunk_, TS_, rbase_, t0_) const bool lat_ = (ci_) >= 4; const int chunk_ = lat_ ? (dir ? 35 - (ci_) : (ci_) - 4) : (dir ? 3 - (ci_) : (ci_)); \
        const int TS_ = lat_ ? TL : TCX; const size_t rbase_ = lat_ ? (size_t)b * TL : (size_t)NLAT + (size_t)b * TCX; const int t0_ = chunk_ * 64;
#define ML_LOAD(ci_) do { ML_CHUNK(ci_, l_, c_, ts_, rb_, t_) \
        { const int tl = dir ? 63 - lane : lane; const size_t row = rb_ + t_ + tl; g_ig = GT[row * 32 + dir * 16 + h]; g_lf = GT[row * 32 + dir * 16 + 8 + h]; } \
        _Pragma("unroll") for (int rr = 0; rr < 6; ++rr) { const int sl = t_ + tl0 - 2 + rr; xq[rr] = (bf16x8){0, 0, 0, 0, 0, 0, 0, 0}; xk[rr] = xq[rr]; \
            if (sl >= 0 && sl < ts_) { const bf16_t* src = MQK + (rb_ + sl) * 2048 + h * 128 + cg8; xq[rr] = *(const bf16x8*)src; xk[rr] = *(const bf16x8*)(src + 1024); } } \
        xv0 = *(const bf16x8*)(MV + (rb_ + t_ + tl0) * 1024 + h * 128 + cg8); xv1 = *(const bf16x8*)(MV + (rb_ + t_ + tl0 + 1) * 1024 + h * 128 + cg8); } while (0)
    ML_LOAD(0);
    __syncthreads();
    for (int ci = 0; ci < 36; ++ci) {
        ML_CHUNK(ci, lat, chunk, TS, rbase, t0)
        (void)TS;
        float wgt, decay, m0n;
        {
            float bc = g_lf;
#pragma unroll
            for (int d = 1; d < 64; d <<= 1) { const float v = __shfl_up(bc, d); if (lane >= d) bc += v; }
            const float uu = g_ig - bc; float px = uu;
#pragma unroll
            for (int d = 1; d < 64; d <<= 1) { const float v = __shfl_up(px, d); if (lane >= d) px = fmaxf(px, v); }
            const float pm = fmaxf(m0, px);
            const float bL = __shfl(bc, 63), pmL = __shfl(pm, 63);
            wgt = __expf(uu - pmL); decay = __expf(m0 - pmL); m0n = bL + pmL;
            if (w == 0) { sc_u[lane] = uu; sc_pm[lane] = pm; sc_a[lane] = __expf(m0 - pm); sc_e[lane] = __expf(-bc - pm); }
        }
        {
            const float w0 = __shfl(wgt, i0), w1 = __shfl(wgt, i1);
#pragma unroll
            for (int qk = 0; qk < 2; ++qk) {
                float y0[8], y1[8];
#pragma unroll
                for (int e = 0; e < 8; ++e) { y0[e] = cbv[qk * 128 + cg8 + e]; y1[e] = y0[e]; }
#pragma unroll
                for (int j = 0; j < 5; ++j) {
                    const f32x4 wa = *(const LAS f32x4*)(cw + j * 256 + qk * 128 + cg8), wb = *(const LAS f32x4*)(cw + j * 256 + qk * 128 + cg8 + 4);
#pragma unroll
                    for (int e = 0; e < 8; ++e) { const float wv = e < 4 ? wa[e] : wb[e - 4]; const bf16x8 xa = qk ? xk[j] : xq[j], xb = qk ? xk[j + 1] : xq[j + 1];
                        y0[e] += wv * bf2f((unsigned short)xa[e]); y1[e] += wv * bf2f((unsigned short)xb[e]); }
                }
                const float ksc = qk ? 0.08838834764831845f : 1.0f;
#pragma unroll
                for (int e = 0; e < 8; ++e) { y0[e] = silu_f(y0[e]) * ksc; y1[e] = silu_f(y1[e]) * ksc; }
                LAS bf16_t* dst = qk ? Ks : Qs;
                u32x4 p0, p1; p0.x = cvt_pk_bf16(y0[0], y0[1]); p0.y = cvt_pk_bf16(y0[2], y0[3]); p0.z = cvt_pk_bf16(y0[4], y0[5]); p0.w = cvt_pk_bf16(y0[6], y0[7]);
                p1.x = cvt_pk_bf16(y1[0], y1[1]); p1.y = cvt_pk_bf16(y1[2], y1[3]); p1.z = cvt_pk_bf16(y1[4], y1[5]); p1.w = cvt_pk_bf16(y1[6], y1[7]);
                *(LAS u32x4*)(dst + i0 * QS_LD + cg8) = p0; *(LAS u32x4*)(dst + i1 * QS_LD + cg8) = p1;
                if (qk) {
#pragma unroll
                    for (int e = 0; e < 8; ++e) { const float a0 = y0[e] * w0, a1 = y1[e] * w1; *(LAS unsigned*)(KT + jsw(cg8 + e, ie)) = dir ? cvt_pk_bf16(a1, a0) : cvt_pk_bf16(a0, a1); }
                }
            }
#pragma unroll
            for (int e = 0; e < 8; ++e) { const unsigned lo = (unsigned short)(dir ? xv1[e] : xv0[e]), hi = (unsigned short)(dir ? xv0[e] : xv1[e]); *(LAS unsigned*)(VT + jsw(cg8 + e, ie)) = lo | (hi << 16); }
        }
        if (ci + 1 < 36) ML_LOAD(ci + 1);
        __syncthreads();
        if (lat) {
            const int it = w >> 1;
#pragma unroll
            for (int jj = 0; jj < 2; ++jj) {
                const int jt = (w & 1) * 2 + jj;
                f32x4 s = (f32x4){0.f, 0.f, 0.f, 0.f};
                if (jt <= it) {
#pragma unroll
                    for (int ks = 0; ks < 4; ++ks) { const bf16x8 a = *(const LAS bf16x8*)(Ks + (jt * 16 + fr) * QS_LD + ks * 32 + fq * 8), bb = *(const LAS bf16x8*)(Qs + (it * 16 + fr) * QS_LD + ks * 32 + fq * 8); s = mfma16(a, bb, s); }
                    const int i = it * 16 + fr, j0 = jt * 16 + 4 * fq; const float pmi = sc_pm[i]; const f32x4 uj = *(const LAS f32x4*)(sc_u + j0);
#pragma unroll
                    for (int r = 0; r < 4; ++r) s[r] = (j0 + r <= i) ? s[r] * __expf(uj[r] - pmi) : 0.f;
                }
                u32x2 pw; pw.x = cvt_pk_bf16(s[0], s[1]); pw.y = cvt_pk_bf16(s[2], s[3]);
                *(LAS u32x2*)(Ps + (it * 16 + fr) * JS_LD + jt * 16 + 4 * fq) = pw;
            }
#pragma unroll
            for (int nt = 0; nt < 9; ++nt) { u32x2 cwd; cwd.x = cvt_pk_bf16(C[nt][0], C[nt][1]); cwd.y = cvt_pk_bf16(C[nt][2], C[nt][3]); *(LAS u32x2*)(C0 + (nt * 16 + fr) * QS_LD + w * 16 + 4 * fq) = cwd; }
        }
        {
            const bf16x8 a0 = *(const LAS bf16x8*)(KT + jsw(w * 16 + fr, fq * 8)), a1 = *(const LAS bf16x8*)(KT + jsw(w * 16 + fr, 32 + fq * 8));
#pragma unroll
            for (int nt = 0; nt < 9; ++nt) { C[nt] *= decay;
                C[nt] = mfma16(a0, *(const LAS bf16x8*)(VT + jsw(nt * 16 + fr, fq * 8)), C[nt]); C[nt] = mfma16(a1, *(const LAS bf16x8*)(VT + jsw(nt * 16 + fr, 32 + fq * 8)), C[nt]); }
        }
        __syncthreads();
        if (lat) {
            const int it = w >> 1, dvh = w & 1, i = it * 16 + fr;
            f32x4 ac[5];
#pragma unroll
            for (int t = 0; t < 5; ++t) ac[t] = (f32x4){0.f, 0.f, 0.f, 0.f};
#pragma unroll
            for (int ks = 0; ks < 4; ++ks) { const bf16x8 bq = *(const LAS bf16x8*)(Qs + i * QS_LD + ks * 32 + fq * 8);
#pragma unroll
                for (int t = 0; t < 5; ++t) { const int row = (t < 4 ? (dvh * 4 + t) * 16 : 128) + fr; ac[t] = mfma16(*(const LAS bf16x8*)(C0 + row * QS_LD + ks * 32 + fq * 8), bq, ac[t]); } }
            const float ai = sc_a[i];
#pragma unroll
            for (int t = 0; t < 5; ++t) ac[t] *= ai;
#pragma unroll
            for (int ks = 0; ks < 2; ++ks) { const bf16x8 bp = *(const LAS bf16x8*)(Ps + i * JS_LD + ks * 32 + fq * 8);
#pragma unroll
                for (int t = 0; t < 5; ++t) { const int row = (t < 4 ? (dvh * 4 + t) * 16 : 128) + fr; ac[t] = mfma16(*(const LAS bf16x8*)(VT + jsw(row, ks * 32 + fq * 8)), bp, ac[t]); } }
            const float den = fmaxf(fabsf(ac[4][0]), sc_e[i]); const float rd = 1.0f / den;
            const size_t row = rbase + t0 + (dir ? 63 - i : i);
#pragma unroll
            for (int t = 0; t < 4; ++t) { u32x2 hw; hw.x = cvt_pk_bf16(ac[t][0] * rd, ac[t][1] * rd); hw.y = cvt_pk_bf16(ac[t][2] * rd, ac[t][3] * rd);
                *(u32x2*)(HO + row * 1024 + h * 128 + (dvh * 4 + t) * 16 + 4 * fq) = hw; }
        }
        m0 = m0n;
        __syncthreads();
    }
#undef ML_LOAD
#undef ML_CHUNK
}

__device__ __forceinline__ void phase_combine(const Params& p) {
    const bf16_t* HF = (const bf16_t*)(p.ws + WS_H); const bf16_t* HB = HF + (size_t)NLAT * 1024; const bf16_t* MO = (const bf16_t*)(p.ws + WS_MO);
    bf16_t* AT = (bf16_t*)(p.ws + WS_ATT);
    const int tid = otid(), c8 = (tid & 127) * 8, rq = tid >> 7;
    f32x4 g0 = *(const f32x4*)(p.m_gain + c8), g1 = *(const f32x4*)(p.m_gain + c8 + 4);
    for (int r = blockIdx.x * 4 + rq; r < NLAT; r += gridDim.x * 4) {
        const bf16x8 a = *(const bf16x8*)(HF + (size_t)r * 1024 + c8), bb = *(const bf16x8*)(HB + (size_t)r * 1024 + c8), mo = *(const bf16x8*)(MO + (size_t)r * 1024 + c8);
        float x[8], ss = 0.f;
#pragma unroll
        for (int e = 0; e < 8; ++e) { x[e] = bf2f((unsigned short)a[e]) + bf2f((unsigned short)bb[e]); ss += x[e] * x[e]; }
        ss += __shfl_xor(ss, 1); ss += __shfl_xor(ss, 2); ss += __shfl_xor(ss, 4); ss += __shfl_xor(ss, 8);
        const float rs = rsqrtf(ss * (1.0f / 128.0f) + RMS_EPS);
        float y[8];
#pragma unroll
        for (int e = 0; e < 8; ++e) y[e] = x[e] * rs * (e < 4 ? g0[e] : g1[e - 4]) * bf2f((unsigned short)mo[e]);
        u32x4 wv; wv.x = cvt_pk_bf16(y[0], y[1]); wv.y = cvt_pk_bf16(y[2], y[3]); wv.z = cvt_pk_bf16(y[4], y[5]); wv.w = cvt_pk_bf16(y[6], y[7]);
        *(u32x4*)(AT + (size_t)r * 2048 + 1024 + c8) = wv;
    }
}

__device__ __forceinline__ void combine_item(const Params& p, int b, int h, int t0) {
    const bf16_t* HF = (const bf16_t*)(p.ws + WS_H); const bf16_t* HB = HF + (size_t)NLAT * 1024; const bf16_t* MO = (const bf16_t*)(p.ws + WS_MO);
    bf16_t* AT = (bf16_t*)(p.ws + WS_ATT);
    const int tid = otid(), c8 = (tid & 15) * 8, tr = tid >> 4;
    const f32x4 g0 = *(const f32x4*)(p.m_gain + h * 128 + c8), g1 = *(const f32x4*)(p.m_gain + h * 128 + c8 + 4);
    for (int it = 0; it < 16; it += 4) {
        bf16x8 a[4], bb[4], mo[4];
#pragma unroll
        for (int q = 0; q < 4; ++q) { const size_t r = (size_t)b * TL + t0 + (it + q) * 32 + tr; const size_t o = r * 1024 + h * 128 + c8;
            a[q] = *(const bf16x8*)(HF + o); bb[q] = *(const bf16x8*)(HB + o); mo[q] = *(const bf16x8*)(MO + o); }
#pragma unroll
        for (int q = 0; q < 4; ++q) {
            float x[8], ss = 0.f;
#pragma unroll
            for (int e = 0; e < 8; ++e) { x[e] = bf2f((unsigned short)a[q][e]) + bf2f((unsigned short)bb[q][e]); ss += x[e] * x[e]; }
            ss += __shfl_xor(ss, 1); ss += __shfl_xor(ss, 2); ss += __shfl_xor(ss, 4); ss += __shfl_xor(ss, 8);
            const float rs = rsqrtf(ss * (1.0f / 128.0f) + RMS_EPS);
            float y[8];
#pragma unroll
            for (int e = 0; e < 8; ++e) y[e] = x[e] * rs * (e < 4 ? g0[e] : g1[e - 4]) * bf2f((unsigned short)mo[q][e]);
            u32x4 wv; wv.x = cvt_pk_bf16(y[0], y[1]); wv.y = cvt_pk_bf16(y[2], y[3]); wv.z = cvt_pk_bf16(y[4], y[5]); wv.w = cvt_pk_bf16(y[6], y[7]);
            const size_t r = (size_t)b * TL + t0 + (it + q) * 32 + tr;
            *(u32x4*)(AT + r * 2048 + 1024 + h * 128 + c8) = wv;
        }
    }
}

#define XB_TMO      128
#define XB_XCNT(j)  (256  + 64 * (j))
#define XB_XSUB(j)  (1280 + 64 * (j))
#define XB_XGEN(j)  (2304 + 64 * (j))
#define XB_TOP      3328
#define XB_TOPGEN   3392
#define XCD_BAR_WORDS 3456
#define XB_SPIN_CAP (1u << 22)
__device__ __forceinline__ unsigned xb_ld(unsigned* p)              { return __hip_atomic_load(p, __ATOMIC_RELAXED, __HIP_MEMORY_SCOPE_AGENT); }
__device__ __forceinline__ unsigned xb_add(unsigned* p, unsigned v) { return __hip_atomic_fetch_add(p, v, __ATOMIC_RELAXED, __HIP_MEMORY_SCOPE_AGENT); }
__device__ __forceinline__ unsigned xb_xcc_id() { return (unsigned)__builtin_amdgcn_s_getreg((3 << 11) | 20) & 0xFu; }
#define XB_SPIN(cond, bar) do { unsigned _sp = 0; while (cond) { __builtin_amdgcn_s_sleep(1); \
    if ((++_sp & 255u) == 0u) { if (xb_ld(&(bar)[XB_TMO])) break; if (_sp > XB_SPIN_CAP) { atomicAdd(&(bar)[XB_TMO], 1u); break; } } } } while (0)
struct XcdBarrier { unsigned* bar; unsigned x; volatile LAS unsigned* st; };
__device__ __forceinline__ XcdBarrier xcd_barrier_post(unsigned* bar, volatile LAS unsigned* st) {
    XcdBarrier b; b.bar = bar; b.x = xb_xcc_id(); b.st = st;
    if (threadIdx.x == 0) (void)xb_add(&bar[XB_XCNT(b.x)], 1u);
    return b;
}
__device__ __forceinline__ void xcd_barrier_complete(unsigned* bar, unsigned x, unsigned& nloc, unsigned& nx) {
    const unsigned G = gridDim.x * gridDim.y * gridDim.z;
    unsigned sum, cnt, mine, sp = 0u;
    for (;;) {
        sum = 0u; cnt = 0u; mine = 0u;
#pragma unroll
        for (unsigned j = 0; j < 16; ++j) { const unsigned c = xb_ld(&bar[XB_XCNT(j)]); sum += c; cnt += (c > 0u) ? 1u : 0u; mine = (j == x) ? c : mine; }
        if (sum == G) break;
        __builtin_amdgcn_s_sleep(1);
        if ((++sp & 255u) == 0u) { if (xb_ld(&bar[XB_TMO])) break; if (sp > XB_SPIN_CAP) { atomicAdd(&bar[XB_TMO], 1u); break; } }
    }
    nloc = mine > 0u ? mine : 1u; nx = cnt > 0u ? cnt : 1u;
}
__device__ __forceinline__ void xcd_barrier(const XcdBarrier& b) {
    asm volatile("s_waitcnt vmcnt(0)" ::: "memory");
    __syncthreads();
    if (threadIdx.x == 0) {
        unsigned* bar = b.bar;
        __builtin_amdgcn_s_waitcnt(0);
        unsigned nloc = b.st[0], nx = b.st[1];
        if (nloc == 0u) { xcd_barrier_complete(bar, b.x, nloc, nx); b.st[0] = nloc; b.st[1] = nx; }
        const unsigned old = xb_add(&bar[XB_XSUB(b.x)], 1u);
        const unsigned gen = old / nloc;
        if (old + 1u == (gen + 1u) * nloc) {
            __builtin_amdgcn_fence(__ATOMIC_RELEASE, "agent");
            asm volatile("s_waitcnt vmcnt(0)" ::: "memory");
            const unsigned og = xb_add(&bar[XB_TOP], 1u);
            const unsigned tg = og / nx;
            if (og + 1u == (tg + 1u) * nx) xb_add(&bar[XB_TOPGEN], 1u);
            else XB_SPIN(xb_ld(&bar[XB_TOPGEN]) == tg, bar);
            __builtin_amdgcn_fence(__ATOMIC_ACQUIRE, "agent");
            xb_add(&bar[XB_XGEN(b.x)], 1u);
            asm volatile("s_waitcnt vmcnt(0)" ::: "memory");
        } else {
            XB_SPIN(xb_ld(&bar[XB_XGEN(b.x)]) == gen, bar);
            __builtin_amdgcn_fence(__ATOMIC_ACQUIRE, "agent");
            asm volatile("s_waitcnt vmcnt(0)" ::: "memory");
        }
    }
    __syncthreads();
}

__device__ __forceinline__ void panel_handoff(unsigned* cnt, unsigned need) {
    asm volatile("s_waitcnt vmcnt(0)" ::: "memory"); __syncthreads();
    if (threadIdx.x == 0) {
        __builtin_amdgcn_fence(__ATOMIC_RELEASE, "agent"); asm volatile("s_waitcnt vmcnt(0)" ::: "memory");
        (void)__hip_atomic_fetch_add(cnt, 1u, __ATOMIC_RELAXED, __HIP_MEMORY_SCOPE_AGENT);
        unsigned sp = 0u; while (__hip_atomic_load(cnt, __ATOMIC_RELAXED, __HIP_MEMORY_SCOPE_AGENT) < need) { __builtin_amdgcn_s_sleep(1); if (++sp > (1u << 22)) break; }
        __builtin_amdgcn_fence(__ATOMIC_ACQUIRE, "agent"); asm volatile("s_waitcnt vmcnt(0)" ::: "memory");
    }
    __syncthreads();
}

__global__ void __launch_bounds__(512, 2) fwd_megakernel(Params p0) {
    extern __shared__ __attribute__((aligned(16))) unsigned char lds_raw[];
    LAS unsigned char* lds = (LAS unsigned char*)lds_raw;
    if (threadIdx.x < 16) ((LAS unsigned*)(lds + LDS_CTL))[threadIdx.x] = 0u;
    __syncthreads();
    XcdBarrier xbar; xbar.bar = (unsigned*)(p0.ws + WS_BAR); xbar.x = 0; xbar.st = (volatile LAS unsigned*)(lds + LDS_CTL + 16);
    if (p0.ph_hi - p0.ph_lo > 1) xbar = xcd_barrier_post((unsigned*)(p0.ws + WS_BAR), (volatile LAS unsigned*)(lds + LDS_CTL + 16));
    for (int ph = p0.ph_lo; ph < p0.ph_hi; ++ph) {
#if defined(__HIP_DEVICE_COMPILE__)
        const __attribute__((address_space(4))) Params* pp = (const __attribute__((address_space(4))) Params*)__builtin_amdgcn_kernarg_segment_ptr();
        asm volatile("" : "+s"(pp));
        const Params p = *pp;
        int G = gridDim.x, bid = blockIdx.x; asm volatile("" : "+s"(G), "+s"(bid));
#else
        const Params p = p0; int G = 0, bid = 0;
#endif
        unsigned char* ws = p.ws;
        float* mod = (float*)(ws + WS_MOD);
        const bool fuse = (G == 256) && (p0.ph_hi - p0.ph_lo > 1);
        if (fuse && (ph == 4 || ph == 7 || ph == 9 || ph == 12)) continue;
        for (int rep = 0; rep < (((DUPMASK >> ph) & 1) ? 2 : 1); ++rep)
        if (HAS(0) && ph == 0) {
            phase_prep(p, lds, rep == 0);
        } else if (HAS(1) && (ph == 1 || ph == 4 || ph == 9)) {
            const float* sl = ph == 1 ? p.x : p.out; const float* scx = p.ctx;
            const int nrows = ph == 9 ? NLAT : MR, midx = ph == 1 ? 0 : (ph == 4 ? 3 : 6);
            if (fuse && ph == 4)
                phase_rows<0>(sl, scx, MR, p.g_norm + DM, mod, 3, (bf16_t*)(ws + WS_H), nullptr, (const float*)(ws + WS_PART), NLAT + bid * 8, G * 8);
            else
            phase_rows<0>(sl, scx, nrows, p.g_norm + (ph == 1 ? 0 : (ph == 4 ? 1 : 2)) * DM, mod, midx, (bf16_t*)(ws + WS_H), nullptr, ph == 4 ? (const float*)(ws + WS_PART) : nullptr);
        } else if (HAS(2) && (ph == 2 || ph == 10)) {
            pg8::Gemm g{(const bf16_t*)(ws + WS_H), (const bf16_t*)(ws + (ph == 2 ? WS_WUP1 : WS_WUP2)), ph == 2 ? MR : NLAT, NUP, DM, DM};
            pg8::StaticOrder S; S.init(g.M, g.N, G, bid);
            EpiSwiglu E{(bf16_t*)(ws + WS_HID)};
            pg8::gemm_phase<EpiSwiglu>(lds, g, S, E);
            if (ph == 2) { const int busy = S.nwg % G; if (busy != 0 && bid >= busy) prep_weights(p, lds, 1, bid - busy, G - busy); else if (busy == 0) prep_weights(p, lds, 1, bid, G); }
        } else if (HAS(3) && (ph == 3 || ph == 8 || ph == 11)) {
            pg8::Gemm g;
            if (ph == 3) g = pg8::Gemm{(const bf16_t*)(ws + WS_HID), (const bf16_t*)(ws + WS_WDN1), NLAT, DM, DFF, DFF};
            else if (ph == 8) g = pg8::Gemm{(const bf16_t*)(ws + WS_ATT), (const bf16_t*)(ws + WS_WOUT), NLAT, DM, DM, DM};
            else g = pg8::Gemm{(const bf16_t*)(ws + WS_HID), (const bf16_t*)(ws + WS_WDN2), NLAT, DM, DFF, DFF};
            pg8::StaticOrder S; S.init(g.M, g.N, G, bid);
            EpiResid E{ph == 3 ? p.x : p.out, p.ctx, p.out, nullptr, mod, ph == 3 ? 2 : (ph == 8 ? 5 : 8), ph == 8 ? 1.0f : 0.5f};
            pg8::gemm_phase<EpiResid>(lds, g, S, E);
            if (fuse) {
                pg8::Unit u0; S.next(0, u0);
                unsigned* cnt = (unsigned*)(ws + WS_PCNT) + ((ph == 3 ? 0 : (ph == 8 ? 1 : 2)) * 64 + u0.pm) * 64;
                panel_handoff(cnt, 4u);
                const int r0 = u0.pm * 256 + (u0.pn & 3) * 64;
                if (ph == 11) phase_rows<1>(p.out, nullptr, r0 + 64, p.g_final, nullptr, 0, nullptr, p.out, nullptr, r0, 8);
                else phase_rows<0>(p.out, nullptr, r0 + 64, p.g_norm + (ph == 3 ? 1 : 2) * DM, mod, ph == 3 ? 3 : 6, (bf16_t*)(ws + WS_H), nullptr, nullptr, r0, 8);
            }
            if (ph == 3) {
                pg8::Gemm g2{(const bf16_t*)(ws + WS_HID), (const bf16_t*)(ws + WS_WDN1), NCTX, DM, DFF / 4, DFF};
                pg8::StaticOrder S2; S2.init(NCTX, DM, G, bid, 64, 4);
                EpiPartial E2{(float*)(ws + WS_PART)};
                pg8::gemm_phase<EpiPartial>(lds, g2, S2, E2);
                if (fuse) {
                    pg8::Unit u2; S2.next(0, u2);
                    panel_handoff((unsigned*)(ws + WS_PCNT) + (4 * 64 + (u2.pm - 64)) * 64, 32u);
                    const int rc = NLAT + (u2.pm - 64) * 256 + (u2.ks * 8 + u2.pn) * 8;
                    phase_rows<0>(p.out, p.ctx, rc + 8, p.g_norm + DM, mod, 3, (bf16_t*)(ws + WS_H), nullptr, (const float*)(ws + WS_PART), rc, 8);
                }
            }
        } else if (HAS(5) && ph == 5) {
            pg8::Gemm g{(const bf16_t*)(ws + WS_H), (const bf16_t*)(ws + WS_WIN), MR, PWP, DM, DM};
            pg8::StaticOrder S; S.init(g.M, g.N, G, bid);
            EpiWin E{(bf16_t*)(ws + WS_Q), (bf16_t*)(ws + WS_K), (bf16_t*)(ws + WS_V), (bf16_t*)(ws + WS_MQK), (bf16_t*)(ws + WS_MV), (bf16_t*)(ws + WS_MO), (float*)(ws + WS_GT),
                     p.q_gain, p.k_gain, p.gate_b, (const float*)(ws + WS_ROPE), (LAS float*)(lds + LDS_RED)};
            pg8::gemm_phase<EpiWin>(lds, g, S, E);
            { const int busy = S.nwg % G; if (busy != 0 && bid >= busy) prep_weights(p, lds, 2, bid - busy, G - busy); else if (busy == 0) prep_weights(p, lds, 2, bid, G); }
        } else if (HAS(6) && ph == 6) {
#if !defined(NO_MLSTM)
            for (int s = bid; s < 128 && rep == 0; s += G) { mlstm_stream(p, lds, s);
                if (fuse) {
                    asm volatile("s_waitcnt vmcnt(0)" ::: "memory"); __syncthreads();
                    if (otid() == 0) { __builtin_amdgcn_fence(__ATOMIC_RELEASE, "agent"); asm volatile("s_waitcnt vmcnt(0)" ::: "memory");
                        (void)__hip_atomic_fetch_add((unsigned*)(ws + WS_PCNT) + (3 * 64 + (s >> 1)) * 64, 1u, __ATOMIC_RELAXED, __HIP_MEMORY_SCOPE_AGENT); } } }
#endif
#if !defined(NO_ATTN)
            {
                int* ctr = (int*)(ws + WS_CTR) + rep * 8;
                for (int qi = 0; qi < 8; ++qi) {
                    const int bq = (bid + qi) & 7;
                    for (;;) {
                        __syncthreads();
                        if (otid() == 0) { int v = __hip_atomic_load(ctr + bq, __ATOMIC_RELAXED, __HIP_MEMORY_SCOPE_AGENT); if (v < 64) v = atomicAdd(ctr + bq, 1); *(LAS int*)(lds + LDS_CTL) = v; }
                        __syncthreads();
                        const int u = *(LAS int*)(lds + LDS_CTL);
                        if (u >= 64) break;
                        attn_unit(p, lds_raw, bq * 64 + u);
                    }
                }
            }
#endif
            if (fuse) {
                unsigned* pc = (unsigned*)(ws + WS_PCNT);
                for (;;) {
                    __syncthreads();
                    if (otid() == 0) { unsigned v = __hip_atomic_fetch_add(pc + 5 * 64 * 64, 1u, __ATOMIC_RELAXED, __HIP_MEMORY_SCOPE_AGENT);
                        if (v < 256u) { unsigned* c2 = pc + (3 * 64 + (v >> 2)) * 64; unsigned sp = 0u;
                            while (__hip_atomic_load(c2, __ATOMIC_RELAXED, __HIP_MEMORY_SCOPE_AGENT) < 2u) { __builtin_amdgcn_s_sleep(1); if (++sp > (1u << 22)) break; }
                            __builtin_amdgcn_fence(__ATOMIC_ACQUIRE, "agent"); asm volatile("s_waitcnt vmcnt(0)" ::: "memory"); }
                        *(LAS int*)(lds + LDS_CTL) = (int)v; }
                    __syncthreads();
                    const int v = *(LAS int*)(lds + LDS_CTL);
                    if (v >= 256) break;
                    combine_item(p, v >> 5, (v >> 2) & 7, (v & 3) * 512);
                }
            }
        } else if (HAS(7) && ph == 7) {
            phase_combine(p);
        } else if (HAS(12) && ph == 12) {
            phase_rows<1>(p.out, nullptr, NLAT, p.g_final, nullptr, 0, nullptr, p.out, nullptr);
        }
        if (ph + 1 < p0.ph_hi && !(fuse && ph == 11)) {
            if (p0.ph_hi > 1000) cg::this_grid().sync(); else xcd_barrier(xbar);
        }
    }
}

extern "C" void kernel_launch(void* const* d_in, const int* in_sizes, int n_in, void* d_out, int out_size, void* d_ws, size_t ws_size, hipStream_t stream) {
    static int grid = 0;
    if (grid == 0) {
        if (n_in != 20 || out_size != NLAT * DM || ws_size < WS_END) { fprintf(stderr, "kernel_launch: unexpected shapes (n_in %d out %d ws %zu need %zu)\n", n_in, out_size, ws_size, (size_t)WS_END); grid = -1; return; }
        int dev = 0, cus = 0, per_cu = 0;
        hipGetDevice(&dev); hipDeviceGetAttribute(&cus, hipDeviceAttributeMultiprocessorCount, dev);
        if (hipFuncSetAttribute((const void*)fwd_megakernel, hipFuncAttributeMaxDynamicSharedMemorySize, LDS_BYTES) != hipSuccess) { fprintf(stderr, "kernel_launch: hipFuncSetAttribute failed\n"); grid = -1; return; }
        hipOccupancyMaxActiveBlocksPerMultiprocessor(&per_cu, (const void*)fwd_megakernel, 512, LDS_BYTES);
        if (per_cu < 1) { fprintf(stderr, "kernel_launch: occupancy query says %d blocks per CU\n", per_cu); per_cu = 1; }
        (void)hipGetLastError();
        grid = cus * 1;
    }
    if (grid < 0) return;
    (void)hipMemsetAsync((char*)d_ws + WS_MOD, 0, (size_t)(WS_ROPE - WS_MOD), stream);
    Params p{};
    p.x = (const float*)d_in[0]; p.c = (const float*)d_in[1]; p.ctx = (const float*)d_in[2]; p.c_ctx = (const float*)d_in[3]; p.w_mod = (const float*)d_in[4]; p.b_mod = (const float*)d_in[5];
    p.g_norm = (const float*)d_in[6]; p.w_up1 = (const float*)d_in[7]; p.w_dn1 = (const float*)d_in[8]; p.w_up2 = (const float*)d_in[9]; p.w_dn2 = (const float*)d_in[10]; p.w_in = (const float*)d_in[11];
    p.q_gain = (const float*)d_in[12]; p.k_gain = (const float*)d_in[13]; p.conv_w = (const float*)d_in[14]; p.conv_b = (const float*)d_in[15]; p.gate_b = (const float*)d_in[16]; p.m_gain = (const float*)d_in[17];
    p.w_out = (const float*)d_in[18]; p.g_final = (const float*)d_in[19]; p.out = (float*)d_out; p.ws = (unsigned char*)d_ws;
#if MK_MULTI
    for (int ph = 0; ph < NPH; ++ph) { p.ph_lo = ph; p.ph_hi = ph + 1; hipLaunchKernelGGL(fwd_megakernel, dim3(grid), dim3(512), LDS_BYTES, stream, p); }
#else
    p.ph_lo = 0; p.ph_hi = NPH;
    void* args[] = {&p};
    hipError_t e = hipLaunchCooperativeKernel((const void*)fwd_megakernel, dim3(grid), dim3(512), args, LDS_BYTES, stream);
    if (e != hipSuccess) fprintf(stderr, "cooperative launch failed: %s (grid %d)\n", hipGetErrorString(e), grid);
#endif
}
```

```cpp
#include <hip/hip_runtime.h>
#include <hip/hip_cooperative_groups.h>
#include <cstdio>
#include <cstdint>
namespace cg = cooperative_groups;

#define LAS __attribute__((address_space(3)))
typedef unsigned short bf16_t;
typedef short bf16x8 __attribute__((ext_vector_type(8)));
typedef short s16x4 __attribute__((ext_vector_type(4)));
typedef float f32x4 __attribute__((ext_vector_type(4)));
typedef float f32x16 __attribute__((ext_vector_type(16)));
typedef unsigned u32x4 __attribute__((ext_vector_type(4)));
typedef unsigned u32x2 __attribute__((ext_vector_type(2)));

#ifndef PHMASK
#define PHMASK 0x1fff
#endif
#define HAS(k) ((PHMASK >> (k)) & 1)
#ifndef DUPMASK
#define DUPMASK 0
#endif
#ifndef MK_MULTI
#define MK_MULTI 0
#endif

constexpr int DM = 2048, NB = 8, TL = 2048, TCX = 256, NLAT = NB * TL, NCTX = NB * TCX, MR = NLAT + NCTX;
constexpr int DFF = 5632, NUP = 2 * DFF, PW = 5664, PWP = 5888, NMOD = 9, MODW = NMOD * DM;
constexpr int SKV = TCX + TL;
constexpr float RMS_EPS = 1e-6f;
constexpr int NPH = 13;

constexpr size_t al256(size_t x) { return (x + 255) / 256 * 256; }
constexpr size_t WS_MOD = 0;
constexpr size_t WS_CTR = WS_MOD + (size_t)9 * MODW * 4;
constexpr size_t WS_BAR = WS_CTR + 256;
constexpr size_t WS_PCNT = al256(WS_BAR + 3456 * 4);
constexpr size_t WS_ROPE = WS_PCNT + (size_t)(5 * 64 + 1) * 256;
constexpr size_t WS_WUP1 = al256(WS_ROPE + 4096 * 4);
constexpr size_t WS_WDN1 = WS_WUP1 + (size_t)NUP * DM * 2;
constexpr size_t WS_WIN = WS_WDN1 + (size_t)DM * DFF * 2;
constexpr size_t WS_WOUT = WS_WIN + (size_t)PWP * DM * 2;
constexpr size_t WS_WUP2 = WS_WOUT + (size_t)DM * DM * 2;
constexpr size_t WS_WDN2 = WS_WUP2 + (size_t)NUP * DM * 2;
constexpr size_t WS_H = WS_WDN2 + (size_t)DM * DFF * 2;
constexpr size_t WS_HID = WS_H + (size_t)MR * DM * 2;
constexpr size_t WS_Q = WS_HID;
constexpr size_t WS_K = WS_Q + (size_t)NLAT * 1024 * 2;
constexpr size_t WS_V = WS_K + (size_t)NB * SKV * 256 * 2;
constexpr size_t WS_MQK = WS_V + (size_t)NB * SKV * 256 * 2;
constexpr size_t WS_MV = WS_MQK + (size_t)MR * 2048 * 2;
constexpr size_t WS_MO = WS_MV + (size_t)MR * 1024 * 2;
constexpr size_t WS_GT = WS_MO + (size_t)NLAT * 1024 * 2;
constexpr size_t WS_PROJ_END = WS_GT + (size_t)MR * 32 * 4;
constexpr size_t WS_ATT = WS_HID + (size_t)MR * DFF * 2;
constexpr size_t WS_PART = WS_ATT;
constexpr size_t WS_XC = WS_ATT + (size_t)NLAT * 2048 * 2;
constexpr size_t WS_END = WS_XC + (size_t)NCTX * DM * 4;
static_assert(WS_PROJ_END <= WS_ATT, "projection outputs must fit in the hidden buffer");

constexpr int LDS_STAGE = 131072;
constexpr int LDS_RED = LDS_STAGE;
constexpr int LDS_CTL = LDS_STAGE + 8192;
constexpr int LDS_BYTES = LDS_CTL + 64;
constexpr int QS_LD = 136, JS_LD = 72;
constexpr int ML_QS = 0, ML_KS = ML_QS + 64 * QS_LD * 2, ML_KT = ML_KS + 64 * QS_LD * 2, ML_VT = ML_KT + 128 * 64 * 2, ML_PS = ML_VT + 144 * 64 * 2,
              ML_C0 = ML_PS + 64 * JS_LD * 2, ML_SC = ML_C0 + 144 * QS_LD * 2, ML_CW = ML_SC + 5 * 64 * 4, ML_CB = ML_CW + 5 * 256 * 4, ML_END = ML_CB + 256 * 4;
static_assert(ML_END <= LDS_BYTES, "mLSTM LDS");

struct Params {
    const float *x, *c, *ctx, *c_ctx, *w_mod, *b_mod, *g_norm, *w_up1, *w_dn1, *w_up2, *w_dn2, *w_in, *q_gain, *k_gain, *conv_w, *conv_b, *gate_b, *m_gain, *w_out, *g_final;
    float* out; unsigned char* ws; int ph_lo, ph_hi;
};

__device__ __forceinline__ int otid() { int t = threadIdx.x; asm volatile("" : "+v"(t)); return t; }
__device__ __forceinline__ unsigned cvt_pk_bf16(float lo, float hi) { unsigned r; asm volatile("v_cvt_pk_bf16_f32 %0, %1, %2" : "=v"(r) : "v"(lo), "v"(hi)); return r; }
__device__ __forceinline__ float bf2f(unsigned short v) { return __uint_as_float(((unsigned)v) << 16); }
__device__ __forceinline__ float silu_f(float x) { return x * __builtin_amdgcn_rcpf(1.0f + __expf(-x)); }
__device__ __forceinline__ float sigmoid_f(float x) { return __builtin_amdgcn_rcpf(1.0f + __expf(-x)); }
__device__ __forceinline__ float logsigmoid_f(float x) { return fminf(x, 0.f) - __logf(1.0f + __expf(-fabsf(x))); }

namespace pg8 {
constexpr int BM = 256, BK = 64, HALF = 128, HTB = HALF * BK * 2, NXCD = 8, WGM = 8;
__device__ __forceinline__ int lds_byte(int r, int c) { const int st = (r >> 4) * 2 + (c >> 5), rr = r & 15, cc = c & 31, ob = rr * 64 + cc * 2; return st * 1024 + (ob ^ (((ob >> 9) & 1) << 5)); }
__device__ __forceinline__ void stage_rc(int b, int& R, int& C) { const int st = b / 1024, sb = b % 1024, swz = sb ^ (((sb >> 9) & 1) << 5); R = (st >> 1) * 16 + swz / 64; C = (st & 1) * 32 + (swz % 64) / 2; }
__device__ __forceinline__ int perm32(int rho) { const int n = rho >> 4, i = rho & 15; return 8 * (i >> 2) + 4 * n + (i & 3); }
struct Unit { int pm, pn, ks; };
struct Gemm { const bf16_t* A; const bf16_t* Bt; int M, N, K, ld; };
struct StaticOrder {
    int nM, nN, nwg, G, c, pm0, nNr;
    __device__ void init(int M, int N, int G_, int c_, int pm0_ = 0, int ksplit = 1) { nM = M / BM; nNr = N / BM; nN = nNr * ksplit; nwg = nM * nN; G = G_; c = c_; pm0 = pm0_; }
    __device__ bool next(int i, Unit& u) const {
        const long L = (long)i * G + c; if (L >= nwg) return false;
        int wgid = (int)L; { const int q = nwg / NXCD, r = nwg % NXCD, xcd = wgid % NXCD, off = wgid / NXCD; wgid = (xcd < r ? xcd * (q + 1) : r * (q + 1) + (xcd - r) * q) + off; }
        const int nig = WGM * nN, gid = wgid / nig, fm = gid * WGM, gsz = (nM - fm) < WGM ? (nM - fm) : WGM;
        u.pm = pm0 + fm + ((wgid % nig) % gsz); const int pe = (wgid % nig) / gsz; u.pn = pe % nNr; u.ks = pe / nNr; return true;
    }
};

template <class Epi>
__device__ __forceinline__ void gemm_phase(LAS unsigned char* lds, const Gemm g, const StaticOrder& S, const Epi& E) {
    const int tid = otid(), wid = __builtin_amdgcn_readfirstlane(tid >> 6), lane = tid & 63, wr = wid >> 2, wc = wid & 3, fr = lane & 15, fq = lane >> 4;
    const int K = g.K, nt = K / BK;
    unsigned voffA[2], voffB[2];
#pragma unroll
    for (int i = 0; i < 2; ++i) { int R, C; stage_rc(tid * 16 + i * 8192, R, C); const int Rb = Epi::PERM ? ((R & ~31) + perm32(R & 31)) : R;
        voffA[i] = (unsigned)(R * g.ld + C) * 2u; voffB[i] = (unsigned)(Rb * g.ld + C) * 2u; }
    const size_t kstep = (size_t)(BK * 2);
    const size_t hstep = (size_t)HALF * g.ld * 2;
    const size_t ksB = (size_t)K * 2;
    const size_t tstep = 2 * hstep;
    const unsigned ldsw = (unsigned)wid * 1024u;
    const int aoff = lds_byte(wr * 64 + fr, fq * 8), boff = lds_byte(wc * 32 + fr, fq * 8);
#define PG8_SA(b, h) (((b) * 2 + (h)) * HTB)
#define PG8_SB(b, h) ((4 + (b) * 2 + (h)) * HTB)
#define PG8_STAGE(bufoff, gbase, voff) do { _Pragma("unroll") for (int _i = 0; _i < 2; ++_i) \
        __builtin_amdgcn_global_load_lds((const unsigned*)((const char*)(gbase) + (voff)[_i]), (LAS unsigned*)(lds + (bufoff) + ldsw + _i * 8192), 16, 0, 0); } while (0)
#define PG8_LDA(dst, b, h) do { _Pragma("unroll") for (int m = 0; m < 4; ++m) _Pragma("unroll") for (int k = 0; k < 2; ++k) dst[m][k] = *(const LAS bf16x8*)(lds + PG8_SA(b, h) + aoff + m * 2048 + k * 1024); } while (0)
#define PG8_LDB(dst, b, h) do { _Pragma("unroll") for (int n = 0; n < 2; ++n) _Pragma("unroll") for (int k = 0; k < 2; ++k) dst[n][k] = *(const LAS bf16x8*)(lds + PG8_SB(b, h) + boff + n * 2048 + k * 1024); } while (0)
#define PG8_MMA(ai, bj, At, Bt) do { __builtin_amdgcn_s_setprio(1); _Pragma("unroll") for (int m = 0; m < 4; ++m) _Pragma("unroll") for (int n = 0; n < 2; ++n) _Pragma("unroll") for (int k = 0; k < 2; ++k) \
        acc[ai][bj][m][n] = __builtin_amdgcn_mfma_f32_16x16x32_bf16(Bt[n][k], At[m][k], acc[ai][bj][m][n], 0, 0, 0); __builtin_amdgcn_s_setprio(0); } while (0)
#define PG8_WAIT_V(n) asm volatile("s_waitcnt vmcnt(" #n ")" ::: "memory")
#define PG8_WAIT_L(n) asm volatile("s_waitcnt lgkmcnt(" #n ")" ::: "memory")
#define PG8_BAR __builtin_amdgcn_s_barrier()
#define PG8_SCHED __builtin_amdgcn_sched_barrier(0)
    Unit cur, nxt; int ui = 0;
    if (!S.next(0, cur)) return;
    f32x4 acc[2][2][4][2];
#pragma unroll
    for (int a = 0; a < 2; ++a)
#pragma unroll
        for (int b = 0; b < 2; ++b)
#pragma unroll
            for (int m = 0; m < 4; ++m)
#pragma unroll
                for (int n = 0; n < 2; ++n) acc[a][b][m][n] = (f32x4){0.f, 0.f, 0.f, 0.f};
    bf16x8 At[4][2], B0[2][2], B1[2][2];
    const char* cA = (const char*)g.A + (size_t)cur.pm * tstep + cur.ks * ksB; const char* cB = (const char*)g.Bt + (size_t)cur.pn * tstep + cur.ks * ksB;
    PG8_STAGE(PG8_SB(0, 0), cB, voffB); PG8_STAGE(PG8_SA(0, 0), cA, voffA); PG8_STAGE(PG8_SB(0, 1), cB + hstep, voffB); PG8_STAGE(PG8_SA(0, 1), cA + hstep, voffA);
    if (wr == 1) PG8_BAR;
    PG8_WAIT_V(4); PG8_BAR;
    PG8_STAGE(PG8_SB(1, 0), cB + kstep, voffB); PG8_STAGE(PG8_SA(1, 0), cA + kstep, voffA); PG8_STAGE(PG8_SB(1, 1), cB + hstep + kstep, voffB);
    PG8_WAIT_V(6); PG8_BAR;
    for (;;) {
        const bool has_next = S.next(ui + 1, nxt);
        const char* nA = has_next ? (const char*)g.A + (size_t)nxt.pm * tstep + nxt.ks * ksB : cA; const char* nB = has_next ? (const char*)g.Bt + (size_t)nxt.pn * tstep + nxt.ks * ksB : cB;
        for (int t = 0; t < nt; t += 2) {
            const bool last = (t == nt - 2);
            const char* a1 = cA + (size_t)(t + 1) * kstep;
            const char* a2 = last ? nA : cA + (size_t)(t + 2) * kstep; const char* b2 = last ? nB : cB + (size_t)(t + 2) * kstep;
            const char* a3 = a2 + kstep; const char* b3 = b2 + kstep;
            PG8_LDB(B0, 0, 0); PG8_SCHED; PG8_LDA(At, 0, 0); PG8_STAGE(PG8_SA(1, 1), a1 + hstep, voffA);
            PG8_WAIT_L(8); PG8_BAR; PG8_WAIT_L(0); PG8_MMA(0, 0, At, B0); PG8_BAR; PG8_SCHED;
            PG8_LDB(B1, 0, 1); PG8_STAGE(PG8_SB(0, 0), b2, voffB);
            PG8_BAR; PG8_WAIT_L(0); PG8_MMA(0, 1, At, B1); PG8_BAR;
            PG8_LDA(At, 0, 1); PG8_STAGE(PG8_SA(0, 0), a2, voffA);
            PG8_BAR; PG8_WAIT_L(0); PG8_MMA(1, 0, At, B0); PG8_BAR; PG8_SCHED;
            PG8_STAGE(PG8_SB(0, 1), b2 + hstep, voffB);
            PG8_WAIT_V(6); PG8_BAR; PG8_MMA(1, 1, At, B1); PG8_BAR;
            PG8_LDB(B0, 1, 0); PG8_SCHED; PG8_LDA(At, 1, 0); PG8_STAGE(PG8_SA(0, 1), a2 + hstep, voffA);
            PG8_WAIT_L(8); PG8_BAR; PG8_WAIT_L(0); PG8_MMA(0, 0, At, B0); PG8_BAR; PG8_SCHED;
            PG8_LDB(B1, 1, 1); PG8_STAGE(PG8_SB(1, 0), b3, voffB);
            PG8_BAR; PG8_WAIT_L(0); PG8_MMA(0, 1, At, B1); PG8_BAR;
            PG8_LDA(At, 1, 1); PG8_STAGE(PG8_SA(1, 0), a3, voffA);
            PG8_BAR; PG8_WAIT_L(0); PG8_MMA(1, 0, At, B0); PG8_BAR; PG8_SCHED;
            PG8_STAGE(PG8_SB(1, 1), b3 + hstep, voffB);
            PG8_WAIT_V(6); PG8_BAR; PG8_MMA(1, 1, At, B1); PG8_BAR;
        }
        E(acc, cur, wr, wc, fr, fq);
        if (!has_next) break;
#pragma unroll
        for (int a = 0; a < 2; ++a)
#pragma unroll
            for (int b = 0; b < 2; ++b)
#pragma unroll
                for (int m = 0; m < 4; ++m)
#pragma unroll
                    for (int n = 0; n < 2; ++n) acc[a][b][m][n] = (f32x4){0.f, 0.f, 0.f, 0.f};
        cur = nxt; cA = nA; cB = nB; ++ui;
    }
    PG8_WAIT_V(0);
    if (wr == 0) PG8_BAR;
    PG8_BAR;
#undef PG8_SA
#undef PG8_SB
#undef PG8_STAGE
#undef PG8_LDA
#undef PG8_LDB
#undef PG8_MMA
#undef PG8_WAIT_V
#undef PG8_WAIT_L
#undef PG8_BAR
#undef PG8_SCHED
}
}

struct EpiSwiglu {
    static constexpr bool PERM = true;
    bf16_t* H;
    __device__ __forceinline__ void operator()(const f32x4 (&acc)[2][2][4][2], const pg8::Unit& u, int wr, int wc, int fr, int fq) const {
        const int row0 = u.pm * 256 + wr * 64 + fr, col0 = u.pn * 128 + wc * 32 + 8 * fq;
#pragma unroll
        for (int ai = 0; ai < 2; ++ai)
#pragma unroll
            for (int m = 0; m < 4; ++m) {
                bf16_t* rowp = H + (size_t)(row0 + ai * 128 + m * 16) * DFF + col0;
                const f32x4 a0 = acc[ai][0][m][0], a1 = acc[ai][0][m][1], b0 = acc[ai][1][m][0], b1 = acc[ai][1][m][1];
                float v[8];
#pragma unroll
                for (int j = 0; j < 4; ++j) { v[j] = silu_f(a0[j]) * b0[j]; v[4 + j] = silu_f(a1[j]) * b1[j]; }
                u32x4 w; w.x = cvt_pk_bf16(v[0], v[1]); w.y = cvt_pk_bf16(v[2], v[3]); w.z = cvt_pk_bf16(v[4], v[5]); w.w = cvt_pk_bf16(v[6], v[7]);
                *(u32x4*)rowp = w;
            }
    }
};
struct EpiResid {
    static constexpr bool PERM = false;
    const float* resid_l; const float* resid_c; float* out_l; float* out_c; const float* mod; int gidx; float coef;
    __device__ __forceinline__ void operator()(const f32x4 (&acc)[2][2][4][2], const pg8::Unit& u, int wr, int wc, int fr, int fq) const {
        const bool isctx = u.pm >= 64; const int b = isctx ? 8 : (u.pm >> 3);
        const int row0 = (isctx ? (u.pm - 64) : u.pm) * 256 + wr * 64 + fr, col0 = u.pn * 256 + wc * 32 + 4 * fq;
        const float* gp = mod + (size_t)(b * NMOD + gidx) * DM + col0;
        const float* rb = isctx ? resid_c : resid_l; float* ob = isctx ? out_c : out_l;
        f32x4 gv[2][2];
#pragma unroll
        for (int bj = 0; bj < 2; ++bj)
#pragma unroll
            for (int n = 0; n < 2; ++n) gv[bj][n] = *(const f32x4*)(gp + bj * 128 + n * 16) * coef;
#pragma unroll
        for (int ai = 0; ai < 2; ++ai)
#pragma unroll
            for (int m = 0; m < 4; ++m) {
                const size_t o = (size_t)(row0 + ai * 128 + m * 16) * DM + col0;
#pragma unroll
                for (int bj = 0; bj < 2; ++bj)
#pragma unroll
                    for (int n = 0; n < 2; ++n) { const f32x4 r = *(const f32x4*)(rb + o + bj * 128 + n * 16); *(f32x4*)(ob + o + bj * 128 + n * 16) = r + gv[bj][n] * acc[ai][bj][m][n]; }
            }
    }
};
struct EpiPartial {
    static constexpr bool PERM = false;
    float* P;
    __device__ __forceinline__ void operator()(const f32x4 (&acc)[2][2][4][2], const pg8::Unit& u, int wr, int wc, int fr, int fq) const {
        const int row0 = (u.pm - 64) * 256 + wr * 64 + fr, col0 = u.pn * 256 + wc * 32 + 4 * fq;
        float* ob = P + (size_t)u.ks * NCTX * DM;
#pragma unroll
        for (int ai = 0; ai < 2; ++ai)
#pragma unroll
            for (int m = 0; m < 4; ++m) {
                const size_t o = (size_t)(row0 + ai * 128 + m * 16) * DM + col0;
#pragma unroll
                for (int bj = 0; bj < 2; ++bj)
#pragma unroll
                    for (int n = 0; n < 2; ++n) *(f32x4*)(ob + o + bj * 128 + n * 16) = acc[ai][bj][m][n];
            }
    }
};
__device__ __forceinline__ int win_src(int slot) {
    if (slot >= PW) return -1;
    if (slot >= 1280) return slot;
    const int head = slot >> 7, s = slot & 127, wc = s >> 5, n = (s >> 4) & 1, fq = (s >> 2) & 3, j = s & 3;
    return head * 128 + (wc >> 1) * 64 + n * 32 + (wc & 1) * 16 + fq * 4 + j;
}
struct EpiWin {
    static constexpr bool PERM = false;
    bf16_t *Q, *K, *V, *MQK, *MV, *MO; float* GT; const float *qg, *kg, *gb, *rope; LAS float* red;
    __device__ __forceinline__ void st4(bf16_t* p, f32x4 v) const { u32x2 w; w.x = cvt_pk_bf16(v[0], v[1]); w.y = cvt_pk_bf16(v[2], v[3]); *(u32x2*)p = w; }
    __device__ __forceinline__ void operator()(const f32x4 (&acc)[2][2][4][2], const pg8::Unit& u, int wr, int wc, int fr, int fq) const {
        asm volatile("" : "+v"(fr), "+v"(fq));
        const int pn = u.pn; const bool isctx = u.pm >= 64;
        const int rt0 = wr * 64 + fr;
        const int grow0 = u.pm * 256 + rt0;
        if (pn <= 4) {
            const float* gain = pn < 4 ? qg : kg;
            const int d1 = (wc >> 1) * 64 + (wc & 1) * 16 + 4 * fq;
            const f32x4 g1 = *(const f32x4*)(gain + d1), g2 = *(const f32x4*)(gain + d1 + 32);
#pragma unroll
            for (int ai = 0; ai < 2; ++ai)
#pragma unroll
                for (int m = 0; m < 4; ++m)
#pragma unroll
                    for (int bj = 0; bj < 2; ++bj) {
                        const f32x4 a = acc[ai][bj][m][0], c = acc[ai][bj][m][1];
                        float ss = a[0] * a[0] + a[1] * a[1] + a[2] * a[2] + a[3] * a[3] + c[0] * c[0] + c[1] * c[1] + c[2] * c[2] + c[3] * c[3];
                        ss += __shfl_xor(ss, 16); ss += __shfl_xor(ss, 32);
                        if (fq == 0) red[((rt0 + ai * 128 + m * 16) * 2 + bj) * 4 + wc] = ss;
                    }
            asm volatile("s_waitcnt lgkmcnt(0)" ::: "memory"); __builtin_amdgcn_s_barrier(); asm volatile("" ::: "memory");
#pragma unroll
            for (int ai = 0; ai < 2; ++ai)
#pragma unroll
                for (int m = 0; m < 4; ++m) {
                    const int rl = rt0 + ai * 128 + m * 16, gr = grow0 + ai * 128 + m * 16;
                    int bidx, tok; if (isctx) { bidx = (gr - NLAT) >> 8; tok = (gr - NLAT) & 255; } else { bidx = gr >> 11; tok = gr & 2047; }
                    f32x4 cs = (f32x4){1.f, 1.f, 1.f, 1.f}, sn = (f32x4){0.f, 0.f, 0.f, 0.f};
                    if (!isctx) { const int pos = (wc >> 1) ? (tok & 63) : (tok >> 6); const int ro = pos * 32 + (wc & 1) * 16 + 4 * fq; cs = *(const f32x4*)(rope + ro); sn = *(const f32x4*)(rope + 2048 + ro); }
#pragma unroll
                    for (int bj = 0; bj < 2; ++bj) {
                        const f32x4 pr = *(const LAS f32x4*)(red + (rl * 2 + bj) * 4);
                        const float rs = __builtin_amdgcn_rsqf((pr[0] + pr[1] + pr[2] + pr[3]) * (1.0f / 128.0f) + RMS_EPS);
                        const f32x4 x1 = acc[ai][bj][m][0] * rs * g1, x2 = acc[ai][bj][m][1] * rs * g2;
                        const f32x4 y1 = x1 * cs - x2 * sn, y2 = x2 * cs + x1 * sn;
                        if (pn < 4) { if (!isctx) { bf16_t* qp = Q + (size_t)gr * 1024 + (pn * 2 + bj) * 128 + d1; st4(qp, y1); st4(qp + 32, y2); } }
                        else { bf16_t* kp = K + ((size_t)bidx * SKV + (isctx ? tok : TCX + tok)) * 256 + bj * 128 + d1; st4(kp, y1); st4(kp + 32, y2); }
                    }
                    __builtin_amdgcn_sched_barrier(0);
                }
        } else {
            const int cc0 = wc * 32 + 4 * fq;
#pragma unroll
            for (int ai = 0; ai < 2; ++ai)
#pragma unroll
                for (int m = 0; m < 4; ++m) {
                    const int gr = grow0 + ai * 128 + m * 16;
                    int bidx, tok; if (isctx) { bidx = (gr - NLAT) >> 8; tok = (gr - NLAT) & 255; } else { bidx = gr >> 11; tok = gr & 2047; }
#pragma unroll
                    for (int bj = 0; bj < 2; ++bj)
#pragma unroll
                        for (int n = 0; n < 2; ++n) {
                            const int cc = cc0 + bj * 128 + n * 16; const f32x4 v = acc[ai][bj][m][n];
                            if (pn == 5) st4(V + ((size_t)bidx * SKV + (isctx ? tok : TCX + tok)) * 256 + cc, v);
                            else if (pn < 14) st4(MQK + (size_t)gr * 2048 + (pn - 6) * 256 + cc, v);
                            else if (pn < 18) st4(MV + (size_t)gr * 1024 + (pn - 14) * 256 + cc, v);
                            else if (pn < 22) { if (!isctx) { f32x4 s; s[0] = sigmoid_f(v[0]); s[1] = sigmoid_f(v[1]); s[2] = sigmoid_f(v[2]); s[3] = sigmoid_f(v[3]); st4(MO + (size_t)gr * 1024 + (pn - 18) * 256 + cc, s); } }
                            else if (cc < 32) {
                                f32x4 t = v + *(const f32x4*)(gb + cc);
                                if (fq >= 2) { t[0] = logsigmoid_f(t[0]); t[1] = logsigmoid_f(t[1]); t[2] = logsigmoid_f(t[2]); t[3] = logsigmoid_f(t[3]); }
                                *(f32x4*)(GT + (size_t)gr * 32 + cc) = t;
                            }
                        }
                    __builtin_amdgcn_sched_barrier(0);
                }
        }
    }
};

__device__ __forceinline__ int up_src(int slot) { const int pn = slot >> 8, r = slot & 255; return (r >> 7) * DFF + pn * 128 + (r & 127); }
template <int MAP  >
__device__ __forceinline__ void prep_tile(const float* __restrict__ W, int Nsrc, bf16_t* __restrict__ Bt, int Kdim, int nt, int kt, LAS float* tl) {
    const int tid = otid();
    { const int n4 = tid & 63, kk = tid >> 6; const int slot = nt * 256 + 4 * n4;
      const int src = MAP == 0 ? slot : (MAP == 1 ? up_src(slot) : win_src(slot));
      f32x4 v[8];
#pragma unroll
      for (int pss = 0; pss < 8; ++pss) { v[pss] = (f32x4){0.f, 0.f, 0.f, 0.f}; if (src >= 0) v[pss] = *(const f32x4*)(W + (size_t)(kt * 64 + kk + pss * 8) * Nsrc + src); }
#pragma unroll
      for (int pss = 0; pss < 8; ++pss) *(LAS f32x4*)(tl + (kk + pss * 8) * 260 + 4 * n4) = v[pss]; }
    __syncthreads();
    { const int n = tid >> 1, kh = (tid & 1) * 32;
#pragma unroll
      for (int q = 0; q < 4; ++q) { float v[8];
#pragma unroll
          for (int e = 0; e < 8; ++e) v[e] = tl[(kh + q * 8 + e) * 260 + n];
          u32x4 w; w.x = cvt_pk_bf16(v[0], v[1]); w.y = cvt_pk_bf16(v[2], v[3]); w.z = cvt_pk_bf16(v[4], v[5]); w.w = cvt_pk_bf16(v[6], v[7]);
          *(u32x4*)(Bt + (size_t)(nt * 256 + n) * Kdim + kt * 64 + kh + q * 8) = w; } }
    __syncthreads();
}
__device__ __forceinline__ void prep_weights(const Params& p, LAS unsigned char* lds, int grp, int t0, int ts, int t1 = 1 << 30) {
    LAS float* tl = (LAS float*)lds;
    constexpr int T_UP = (NUP / 256) * (DM / 64), T_DN = (DM / 256) * (DFF / 64), T_IN = (PWP / 256) * (DM / 64), T_OUT = (DM / 256) * (DM / 64);
    int tot = grp == 0 ? T_UP : (grp == 1 ? T_DN + T_IN + T_OUT : T_UP + T_DN); if (t1 < tot) tot = t1;
    for (int t = t0; t < tot; t += ts) {
        int q = t;
        if (grp == 1) {
            if (q < T_DN) { prep_tile<0>(p.w_dn1, DM, (bf16_t*)(p.ws + WS_WDN1), DFF, q % (DM / 256), q / (DM / 256), tl); continue; } q -= T_DN;
            if (q < T_IN) { prep_tile<2>(p.w_in, PW, (bf16_t*)(p.ws + WS_WIN), DM, q % (PWP / 256), q / (PWP / 256), tl); continue; } q -= T_IN;
            prep_tile<0>(p.w_out, DM, (bf16_t*)(p.ws + WS_WOUT), DM, q % (DM / 256), q / (DM / 256), tl);
        } else {
            const float* wu = grp == 0 ? p.w_up1 : p.w_up2;
            if (q < T_UP) { prep_tile<1>(wu, NUP, (bf16_t*)(p.ws + (grp == 0 ? WS_WUP1 : WS_WUP2)), DM, q % (NUP / 256), q / (NUP / 256), tl); continue; } q -= T_UP;
            prep_tile<0>(p.w_dn2, DM, (bf16_t*)(p.ws + WS_WDN2), DFF, q % (DM / 256), q / (DM / 256), tl);
        }
    }
}
__device__ __forceinline__ void phase_prep(const Params& p, LAS unsigned char* lds, bool do_mod) {
    const int tid = otid(), G = gridDim.x, bid = blockIdx.x;
    float* mod = (float*)(p.ws + WS_MOD);
    LAS float* sv = (LAS float*)lds;
    LAS float* red = (LAS float*)(lds + 9 * 512 * 4);
    for (int item = bid; do_mod && item < 576; item += G) {
        const int cb = item >> 2, ks = item & 3;
        for (int i = tid; i < 9 * 512; i += 512) { const int b = i >> 9, k = i & 511; const float cv = b < 8 ? p.c[b * DM + ks * 512 + k] : p.c_ctx[ks * 512 + k]; sv[i] = silu_f(cv); }
        __syncthreads();
        const int c4 = tid & 31, kr = tid >> 5;
        f32x4 a[9];
#pragma unroll
        for (int b = 0; b < 9; ++b) a[b] = (f32x4){0.f, 0.f, 0.f, 0.f};
        for (int kk = kr; kk < 512; kk += 16) {
            const f32x4 w = *(const f32x4*)(p.w_mod + (size_t)(ks * 512 + kk) * MODW + cb * 128 + c4 * 4);
#pragma unroll
            for (int b = 0; b < 9; ++b) a[b] += w * sv[b * 512 + kk];
        }
#pragma unroll
        for (int b = 0; b < 9; ++b) *(LAS f32x4*)(red + (kr * 9 + b) * 128 + c4 * 4) = a[b];
        __syncthreads();
        for (int o = tid; o < 9 * 128; o += 512) { const int b = o >> 7, cidx = o & 127; float s = 0.f;
#pragma unroll
            for (int r = 0; r < 16; ++r) s += red[(r * 9 + b) * 128 + cidx];
            const int col = cb * 128 + cidx; if (ks == 0) s += p.b_mod[col];
            atomicAdd(mod + (size_t)b * MODW + col, s); }
        __syncthreads();
    }
    if (bid == G - 1) { float* rope = (float*)(p.ws + WS_ROPE);
        for (int i = tid; i < 2048; i += 512) { const int pos = i >> 5, idx = i & 31; const float inv = exp2f(-(float)idx * (13.287712379549449f / 32.0f)); const float ang = (float)pos * inv;
            rope[i] = cosf(ang); rope[2048 + i] = sinf(ang); } }
    { int t0 = bid, ts = G, t1 = 1 << 30; if (G == 256) { if (bid < 64) { ts = 64; t1 = 192; } else { t0 = 192 + (bid - 64); ts = 192; } }
      prep_weights(p, lds, 0, t0, ts, t1); }
}

template <int MODE>
__device__ __forceinline__ void phase_rows(const float* src_l, const float* src_c, int nrows, const float* g, const float* mod, int midx, bf16_t* outb, float* outf, const float* part,
                                           int rbase = -1, int rstride = 0) {
    const int wave = otid() >> 6, lane = otid() & 63;
    const int stride = rbase < 0 ? gridDim.x * 8 : rstride;
    for (int r0 = (rbase < 0 ? blockIdx.x * 8 : rbase) + wave; r0 < nrows; r0 += 2 * stride) {
        f32x4 v[2][8]; float ss[2] = {0.f, 0.f};
#pragma unroll
        for (int q = 0; q < 2; ++q) {
            const int r = r0 + q * stride;
            if (r < nrows) {
                const bool isctx = r >= NLAT; const float* xp = isctx ? src_c + (size_t)(r - NLAT) * DM : src_l + (size_t)r * DM;
#pragma unroll
                for (int k = 0; k < 8; ++k) v[q][k] = *(const f32x4*)(xp + (k * 64 + lane) * 4);
                if (isctx && part) {
                    const float* gt = mod + (size_t)(8 * NMOD + 2) * DM; const float* pp = part + (size_t)(r - NLAT) * DM;
#pragma unroll
                    for (int k = 0; k < 8; ++k) { const int c = (k * 64 + lane) * 4;
                        const f32x4 sum = (*(const f32x4*)(pp + c) + *(const f32x4*)(pp + (size_t)NCTX * DM + c)) + (*(const f32x4*)(pp + (size_t)2 * NCTX * DM + c) + *(const f32x4*)(pp + (size_t)3 * NCTX * DM + c));
                        v[q][k] += *(const f32x4*)(gt + c) * 0.5f * sum; }
                }
#pragma unroll
                for (int k = 0; k < 8; ++k) ss[q] += v[q][k][0] * v[q][k][0] + v[q][k][1] * v[q][k][1] + v[q][k][2] * v[q][k][2] + v[q][k][3] * v[q][k][3];
            }
        }
#pragma unroll
        for (int o = 32; o >= 1; o >>= 1) { ss[0] += __shfl_xor(ss[0], o); ss[1] += __shfl_xor(ss[1], o); }
#pragma unroll
        for (int q = 0; q < 2; ++q) {
            const int r = r0 + q * stride;
            if (r < nrows) {
                const float rs = rsqrtf(ss[q] * (1.0f / DM) + RMS_EPS);
                if (MODE == 0) {
                    const int b = r >= NLAT ? 8 : (r >> 11);
                    const float* sh = mod + (size_t)(b * NMOD + midx) * DM; const float* sc = sh + DM;
#pragma unroll
                    for (int k = 0; k < 8; ++k) { const int c = (k * 64 + lane) * 4; const f32x4 gg = *(const f32x4*)(g + c), s1 = *(const f32x4*)(sc + c), s0 = *(const f32x4*)(sh + c);
                        const f32x4 y = v[q][k] * rs * gg * (s1 + 1.0f) + s0; u32x2 w; w.x = cvt_pk_bf16(y[0], y[1]); w.y = cvt_pk_bf16(y[2], y[3]); *(u32x2*)(outb + (size_t)r * DM + c) = w; }
                } else {
#pragma unroll
                    for (int k = 0; k < 8; ++k) { const int c = (k * 64 + lane) * 4; const f32x4 gg = *(const f32x4*)(g + c); *(f32x4*)(outf + (size_t)r * DM + c) = v[q][k] * rs * gg; }
                }
            }
        }
    }
}

namespace att {
constexpr int D = 128, NW = 8, QBLK = 32, KVBLK = 64;
constexpr float SCALE = 0.088388347648318440f, THR = 8.f;
constexpr int LDQ = 1024, LDK = 256, LDO = 2048;
constexpr size_t SHM_V = KVBLK * D * 2, SHM_K = KVBLK * D * 2, SHM_ATTN = 2 * SHM_V + 2 * SHM_K + NW * 64 * 4;
#define KSWZ(row, colB) ((row) * 256 + ((colB) ^ (((row) & 7) << 4)))
#define SBAR() __builtin_amdgcn_sched_barrier(0)
__device__ __forceinline__ int crow(int r, int hi) { return (r & 3) + 8 * (r >> 2) + 4 * hi; }
__device__ __forceinline__ void partialSM(f32x16& p0, f32x16& p1, float& m_reg, float& mn, float& alpha) {
  constexpr float C = SCALE * 1.4426950408889634f;
  float pmax = p0[0]; for (int r = 1; r < 16; ++r) pmax = fmaxf(pmax, p0[r]); for (int r = 0; r < 16; ++r) pmax = fmaxf(pmax, p1[r]);
  { auto rr = __builtin_amdgcn_permlane32_swap(__float_as_uint(pmax), __float_as_uint(pmax), false, false);
    pmax = fmaxf(__uint_as_float(rr[0]), __uint_as_float(rr[1])); }
  if (__builtin_expect(__all(pmax - m_reg <= THR / SCALE), 1)) { mn = m_reg; alpha = 1.f; }
  else { mn = fmaxf(m_reg, pmax); alpha = __builtin_amdgcn_exp2f((m_reg - mn) * C); m_reg = mn; }
  float mnC = -mn * C;
  for (int r = 0; r < 16; ++r) p0[r] = fmaf(p0[r], C, mnC); for (int r = 0; r < 16; ++r) p1[r] = fmaf(p1[r], C, mnC);
  for (int r = 0; r < 16; ++r) p0[r] = __builtin_amdgcn_exp2f(p0[r]);
}
__device__ __forceinline__ void finishSM(f32x16& p0, f32x16& p1, float alpha, float& l_reg, bf16x8& pa0, bf16x8& pa1, bf16x8& pa2, bf16x8& pa3) {
  for (int r = 0; r < 16; ++r) p1[r] = __builtin_amdgcn_exp2f(p1[r]);
  float ps = 0; for (int r = 0; r < 16; ++r) ps += p0[r]; for (int r = 0; r < 16; ++r) ps += p1[r];
  { auto rr = __builtin_amdgcn_permlane32_swap(__float_as_uint(ps), __float_as_uint(ps), false, false);
    ps = __uint_as_float(rr[0]) + __uint_as_float(rr[1]); }
  l_reg = l_reg * alpha + ps;
#define PK4(P, BASE, OUT) do { unsigned a0 = cvt_pk_bf16(P[BASE + 0], P[BASE + 1]), a1 = cvt_pk_bf16(P[BASE + 2], P[BASE + 3]);   \
    unsigned b0 = cvt_pk_bf16(P[BASE + 4], P[BASE + 5]), b1 = cvt_pk_bf16(P[BASE + 6], P[BASE + 7]);                              \
    auto r0 = __builtin_amdgcn_permlane32_swap(a0, b0, false, false); auto r1 = __builtin_amdgcn_permlane32_swap(a1, b1, false, false); \
    u32x4 w = {r0[0], r1[0], r0[1], r1[1]}; OUT = *reinterpret_cast<bf16x8*>(&w); } while (0)
  PK4(p0, 0, pa0); PK4(p0, 8, pa1); PK4(p1, 0, pa2); PK4(p1, 8, pa3);
#undef PK4
}
__device__ __forceinline__ void qkt(f32x16& p0, f32x16& p1, const bf16_t* Ks, const bf16x8* qr, int r32, int hi) {
  p0 = f32x16{}; p1 = f32x16{};
  for (int d0 = 0; d0 < 8; ++d0) { int cb = (d0 * 16 + hi * 8) * 2;
    bf16x8 b0 = *reinterpret_cast<const bf16x8*>((const char*)Ks + KSWZ(r32, cb));
    bf16x8 b1 = *reinterpret_cast<const bf16x8*>((const char*)Ks + KSWZ(32 + r32, cb));
    p0 = __builtin_amdgcn_mfma_f32_32x32x16_bf16(b0, qr[d0], p0, 0, 0, 0);
    p1 = __builtin_amdgcn_mfma_f32_32x32x16_bf16(b1, qr[d0], p1, 0, 0, 0); }
}
__device__ __forceinline__ int v_st(int k, int c) { const int kk = (k & ~0xC) | ((k & 4) << 1) | ((k & 8) >> 1); return ((kk >> 3) * 4 + (c >> 5)) * 512 + ((kk & 7) * 32 + (c & 31)) * 2; }
__device__ __forceinline__ int v_rd_base(int lane) { return ((lane & 3) << 3) | (((lane >> 2) & 3) << 6) | (((lane >> 4) & 1) << 5) | (((lane >> 5) & 1) << 8); }
constexpr int v_rd_off(int d0, int ks, int half) { return d0 * 512 + ks * 4096 + half * 2048; }
template <int OFF> __device__ __forceinline__ s16x4 tr_read(int vb) {
  s16x4 r; asm volatile("ds_read_b64_tr_b16 %0, %1 offset:%2" : "=&v"(r) : "v"(vb), "i"(OFF) : "memory"); return r;
}
template <int D0> __device__ __forceinline__ void pv_one(f32x16& od, int vb, bf16x8 pa0, bf16x8 pa1, bf16x8 pa2, bf16x8 pa3) {
  const s16x4 l0 = tr_read<v_rd_off(D0, 0, 0)>(vb), h0 = tr_read<v_rd_off(D0, 0, 1)>(vb), l1 = tr_read<v_rd_off(D0, 1, 0)>(vb), h1 = tr_read<v_rd_off(D0, 1, 1)>(vb);
  const s16x4 l2 = tr_read<v_rd_off(D0, 2, 0)>(vb), h2 = tr_read<v_rd_off(D0, 2, 1)>(vb), l3 = tr_read<v_rd_off(D0, 3, 0)>(vb), h3 = tr_read<v_rd_off(D0, 3, 1)>(vb);
  asm volatile("s_waitcnt lgkmcnt(0)" ::: "memory"); SBAR();
#define PK(L, H) (bf16x8){L[0], L[1], L[2], L[3], H[0], H[1], H[2], H[3]}
  od = __builtin_amdgcn_mfma_f32_32x32x16_bf16(pa0, PK(l0, h0), od, 0, 0, 0);
  od = __builtin_amdgcn_mfma_f32_32x32x16_bf16(pa1, PK(l1, h1), od, 0, 0, 0);
  od = __builtin_amdgcn_mfma_f32_32x32x16_bf16(pa2, PK(l2, h2), od, 0, 0, 0);
  od = __builtin_amdgcn_mfma_f32_32x32x16_bf16(pa3, PK(l3, h3), od, 0, 0, 0);
#undef PK
}
__device__ __forceinline__ void pv_d0(f32x16* o, int vb, bf16x8 pa0, bf16x8 pa1, bf16x8 pa2, bf16x8 pa3) {
  pv_one<0>(o[0], vb, pa0, pa1, pa2, pa3); pv_one<1>(o[1], vb, pa0, pa1, pa2, pa3); pv_one<2>(o[2], vb, pa0, pa1, pa2, pa3); pv_one<3>(o[3], vb, pa0, pa1, pa2, pa3);
}
__device__ __forceinline__ void attn_dense_body(const bf16_t* __restrict__ Qb, const bf16_t* __restrict__ Kh, const bf16_t* __restrict__ Vh, bf16_t* __restrict__ Ob, int seq, char* lds) {
  const int tid = otid(), wid = tid >> 6, lane = tid & 63, r32 = lane & 31, hi = lane >> 5;
  bf16_t* V_lds = (bf16_t*)lds; bf16_t* K_lds = (bf16_t*)(lds + 2 * SHM_V);
  float* ws = (float*)(lds + 2 * SHM_V + 2 * SHM_K) + wid * 64; float* li_l = ws; float* al_l = ws + 32;
  float m_reg = -1e30f, l_reg = 0; f32x16 o[4] = {}; bf16x8 qr[8];
  const bf16_t* Qw = Qb + (long)(wid * QBLK + r32) * LDQ + hi * 8;
#pragma unroll
  for (int d0 = 0; d0 < 8; ++d0) qr[d0] = *reinterpret_cast<const bf16x8*>(Qw + d0 * 16);
  const int sr = tid >> 4, sc = (tid & 15) * 8, vst0 = v_st(sr, sc), vst1 = v_st(32 + sr, sc);
  const int vb0 = (int)(uintptr_t)V_lds + v_rd_base(lane);
  struct { bf16x8 vs0, vs1, ks0, ks1; } sr_[2];
#define SLOAD(i, k0) do { sr_[i].vs0 = *reinterpret_cast<const bf16x8*>(&Vh[(long)((k0) + sr) * LDK + sc]); sr_[i].vs1 = *reinterpret_cast<const bf16x8*>(&Vh[(long)((k0) + 32 + sr) * LDK + sc]); \
    sr_[i].ks0 = *reinterpret_cast<const bf16x8*>(&Kh[(long)((k0) + sr) * LDK + sc]); sr_[i].ks1 = *reinterpret_cast<const bf16x8*>(&Kh[(long)((k0) + 32 + sr) * LDK + sc]); } while (0)
#define SWRITE(b, i) do { *(bf16x8*)((char*)V_lds + (b) * SHM_V + vst0) = sr_[i].vs0;          \
    *(bf16x8*)((char*)V_lds + (b) * SHM_V + vst1) = sr_[i].vs1; int kc = sc * 2;               \
    *(bf16x8*)((char*)K_lds + (b) * SHM_K + KSWZ(sr, kc)) = sr_[i].ks0;                       \
    *(bf16x8*)((char*)K_lds + (b) * SHM_K + KSWZ(32 + sr, kc)) = sr_[i].ks1; } while (0)
#define SWAIT() asm volatile("s_waitcnt vmcnt(4)" ::: "memory")
#define RESC(a) do { if (__any((a) < 1.f)) { if (hi == 0) al_l[r32] = (a); asm volatile("s_waitcnt lgkmcnt(0)" ::: "memory"); \
    for (int d = 0; d < 4; ++d) for (int r = 0; r < 16; ++r) o[d][r] *= al_l[crow(r, hi)]; } } while (0)
  f32x16 pA0, pA1, pB0, pB1; float mnA, mnB, alA, alB; bf16x8 pa0, pa1, pa2, pa3; const int NT = seq / KVBLK;
  constexpr int SE = 0, SO = 1;
  SLOAD(SE, 0); asm volatile("s_waitcnt vmcnt(0)" ::: "memory"); SWRITE(0, SE); __syncthreads();
  qkt(pA0, pA1, K_lds, qr, r32, hi); partialSM(pA0, pA1, m_reg, mnA, alA);
  SLOAD(SO, KVBLK); if (2 < NT) SLOAD(SE, 2 * KVBLK);
  SWAIT(); SWRITE(1, SO); __syncthreads();
  for (int j = 1; j + 1 < NT; j += 2) {
    SBAR(); qkt(pB0, pB1, (bf16_t*)((char*)K_lds + SHM_K), qr, r32, hi);
    finishSM(pA0, pA1, alA, l_reg, pa0, pa1, pa2, pa3); SBAR();
    SLOAD(SO, (j + 2) * KVBLK); SBAR();
    pv_d0(o, vb0, pa0, pa1, pa2, pa3); partialSM(pB0, pB1, m_reg, mnB, alB);
    __syncthreads(); SWAIT(); SWRITE(0, SE);
    RESC(alB); __syncthreads();
    SBAR(); qkt(pA0, pA1, K_lds, qr, r32, hi);
    finishSM(pB0, pB1, alB, l_reg, pa0, pa1, pa2, pa3); SBAR();
    if (j + 3 < NT) SLOAD(SE, (j + 3) * KVBLK); SBAR();
    pv_d0(o, vb0 + (int)SHM_V, pa0, pa1, pa2, pa3); partialSM(pA0, pA1, m_reg, mnA, alA);
    __syncthreads(); SWAIT(); SWRITE(1, SO);
    RESC(alA); __syncthreads();
  }
  SBAR(); qkt(pB0, pB1, (bf16_t*)((char*)K_lds + SHM_K), qr, r32, hi);
  finishSM(pA0, pA1, alA, l_reg, pa0, pa1, pa2, pa3); SBAR();
  pv_d0(o, vb0, pa0, pa1, pa2, pa3); partialSM(pB0, pB1, m_reg, mnB, alB);
  __syncthreads(); RESC(alB);
  finishSM(pB0, pB1, alB, l_reg, pa0, pa1, pa2, pa3); SBAR();
  pv_d0(o, vb0 + (int)SHM_V, pa0, pa1, pa2, pa3);
  if (hi == 0) li_l[r32] = l_reg; asm volatile("s_waitcnt lgkmcnt(0)" ::: "memory");
  float rli[16];
#pragma unroll
  for (int r = 0; r < 16; ++r) rli[r] = __builtin_amdgcn_rcpf(li_l[crow(r, hi)]);
  bf16_t* Ow = Ob + (long)(wid * QBLK) * LDO;
#pragma unroll
  for (int r = 0; r < 16; ++r) { int orow = crow(r, hi);
    for (int d0 = 0; d0 < 4; ++d0) Ow[(long)orow * LDO + d0 * 32 + r32] = (bf16_t)(cvt_pk_bf16(o[d0][r] * rli[r], 0.f) & 0xffffu); }
#undef SLOAD
#undef SWRITE
#undef SWAIT
#undef RESC
}
}

__device__ __forceinline__ void attn_unit(const Params& p, unsigned char* lds_generic, int u) {
    const int qb = u & 7, g = (u >> 3) & 3, kvh = (u >> 5) & 1, b = u >> 6, hq = kvh * 4 + g;
    const bf16_t* Q = (const bf16_t*)(p.ws + WS_Q) + ((size_t)(b * TL + qb * 256)) * 1024 + hq * 128;
    const bf16_t* K = (const bf16_t*)(p.ws + WS_K) + (size_t)b * SKV * 256 + kvh * 128;
    const bf16_t* V = (const bf16_t*)(p.ws + WS_V) + (size_t)b * SKV * 256 + kvh * 128;
    bf16_t* O = (bf16_t*)(p.ws + WS_ATT) + ((size_t)(b * TL + qb * 256)) * 2048 + hq * 128;
    __syncthreads();
    att::attn_dense_body(Q, K, V, O, SKV, (char*)lds_generic);
}

__device__ __forceinline__ int jsw(int r, int c) { return r * 64 + ((((c) >> 3) ^ ((r ^ (r >> 3)) & 7)) << 3) + (c & 7); }
#define DPPF(idv, v, ctrl, rowmask) __builtin_bit_cast(float, __builtin_amdgcn_update_dpp(__builtin_bit_cast(int, (float)(idv)), __builtin_bit_cast(int, (float)(v)), ctrl, rowmask, 0xf, false))
__device__ __forceinline__ f32x4 mfma16(bf16x8 a, bf16x8 b, f32x4 c) { return __builtin_amdgcn_mfma_f32_16x16x32_bf16(a, b, c, 0, 0, 0); }
__device__ __forceinline__ void mlstm_stream(const Params& p, LAS unsigned char* lds, int sid) {
    const int tid = otid(), w = __builtin_amdgcn_readfirstlane(tid >> 6), lane = tid & 63, fr = lane & 15, fq = lane >> 4;
    const int dir = sid & 1, h = (sid >> 1) & 7, b = sid >> 4;
    LAS bf16_t* Qs = (LAS bf16_t*)(lds + ML_QS); LAS bf16_t* Ks = (LAS bf16_t*)(lds + ML_KS); LAS bf16_t* KT = (LAS bf16_t*)(lds + ML_KT);
    LAS bf16_t* VT = (LAS bf16_t*)(lds + ML_VT); LAS bf16_t* Ps = (LAS bf16_t*)(lds + ML_PS); LAS bf16_t* C0 = (LAS bf16_t*)(lds + ML_C0);
    LAS float* sc_u = (LAS float*)(lds + ML_SC); LAS float* sc_pm = sc_u + 64; LAS float* sc_a = sc_u + 128; LAS float* sc_e = sc_u + 192;
    LAS float* cw = (LAS float*)(lds + ML_CW); LAS float* cbv = (LAS float*)(lds + ML_CB);
    const bf16_t* MQK = (const bf16_t*)(p.ws + WS_MQK); const bf16_t* MV = (const bf16_t*)(p.ws + WS_MV); const float* GT = (const float*)(p.ws + WS_GT);
    bf16_t* HO = (bf16_t*)(p.ws + WS_H) + (size_t)dir * NLAT * 1024;
    const int cg8 = (tid & 15) * 8, rg = tid >> 4, tl0 = 2 * rg;
    const int i0 = dir ? 63 - tl0 : tl0, i1 = dir ? i0 - 1 : i0 + 1, ie = dir ? i1 : i0;
    __syncthreads();
    for (int i = tid; i < 16 * 64; i += 512) VT[128 * 64 + i] = 0x3F80;
    for (int i = tid; i < 5 * 256; i += 512) { const int j = i >> 8, c = i & 255; cw[i] = p.conv_w[j * 2048 + (c < 128 ? h * 128 + c : 1024 + h * 128 + (c - 128))]; }
    for (int i = tid; i < 256; i += 512) cbv[i] = p.conv_b[i < 128 ? h * 128 + i : 1024 + h * 128 + (i - 128)];
    f32x4 C[9];
#pragma unroll
    for (int i = 0; i < 9; ++i) C[i] = (f32x4){0.f, 0.f, 0.f, 0.f};
    float m0 = 0.f;
    bf16x8 xq[6], xk[6], xv0, xv1; float g_ig, g_lf;
#define ML_CHUNK(ci_, lat_, chunk_, TS_, rbase_, t0_) const bool lat_ = (ci_) >= 4; const int chunk_ = lat_ ? (dir ? 35 - (ci_) : (ci_) - 4) : (dir ? 3 - (ci_) : (ci_)); \
        const int TS_ = lat_ ? TL : TCX; const size_t rbase_ = lat_ ? (size_t)b * TL : (size_t)NLAT + (size_t)b * TCX; const int t0_ = chunk_ * 64;
#define ML_LOAD(ci_) do { ML_CHUNK(ci_, l_, c_, ts_, rb_, t_) \
        { const int tl = dir ? 63 - lane : lane; const size_t row = rb_ + t_ + tl; g_ig = GT[row * 32 + dir * 16 + h]; g_lf = GT[row * 32 + dir * 16 + 8 + h]; } \
        _Pragma("unroll") for (int rr = 0; rr < 6; ++rr) { const int sl = t_ + tl0 - 2 + rr; xq[rr] = (bf16x8){0, 0, 0, 0, 0, 0, 0, 0}; xk[rr] = xq[rr]; \
            if (sl >= 0 && sl < ts_) { const bf16_t* src = MQK + (rb_ + sl) * 2048 + h * 128 + cg8; xq[rr] = *(const bf16x8*)src; xk[rr] = *(const bf16x8*)(src + 1024); } } \
        xv0 = *(const bf16x8*)(MV + (rb_ + t_ + tl0) * 1024 + h * 128 + cg8); xv1 = *(const bf16x8*)(MV + (rb_ + t_ + tl0 + 1) * 1024 + h * 128 + cg8); } while (0)
    ML_LOAD(0);
    __syncthreads();
    for (int ci = 0; ci < 36; ++ci) {
        ML_CHUNK(ci, lat, chunk, TS, rbase, t0)
        (void)TS;
        float wgt, decay, m0n;
        {
            float bc = g_lf;
            bc += DPPF(0.f, bc, 0x111, 0xf); bc += DPPF(0.f, bc, 0x112, 0xf); bc += DPPF(0.f, bc, 0x114, 0xf); bc += DPPF(0.f, bc, 0x118, 0xf);
            bc += DPPF(0.f, bc, 0x142, 0xa); bc += DPPF(0.f, bc, 0x143, 0xc);
            const float uu = g_ig - bc; float px = uu;
            px = fmaxf(px, DPPF(-INFINITY, px, 0x111, 0xf)); px = fmaxf(px, DPPF(-INFINITY, px, 0x112, 0xf)); px = fmaxf(px, DPPF(-INFINITY, px, 0x114, 0xf)); px = fmaxf(px, DPPF(-INFINITY, px, 0x118, 0xf));
            px = fmaxf(px, DPPF(-INFINITY, px, 0x142, 0xa)); px = fmaxf(px, DPPF(-INFINITY, px, 0x143, 0xc));
            const float pm = fmaxf(m0, px);
            const float bL = __builtin_bit_cast(float, __builtin_amdgcn_readlane(__builtin_bit_cast(int, bc), 63)), pmL = __builtin_bit_cast(float, __builtin_amdgcn_readlane(__builtin_bit_cast(int, pm), 63));
            wgt = __expf(uu - pmL); decay = __expf(m0 - pmL); m0n = bL + pmL;
            if (w == 0) { sc_u[lane] = uu; sc_pm[lane] = pm; sc_a[lane] = __expf(m0 - pm); sc_e[lane] = __expf(-bc - pm); }
        }
        {
            const float w0 = __shfl(wgt, i0), w1 = __shfl(wgt, i1);
#pragma unroll
            for (int qk = 0; qk < 2; ++qk) {
                float y0[8], y1[8];
#pragma unroll
                for (int e = 0; e < 8; ++e) { y0[e] = cbv[qk * 128 + cg8 + e]; y1[e] = y0[e]; }
#pragma unroll
                for (int j = 0; j < 5; ++j) {
                    const f32x4 wa = *(const LAS f32x4*)(cw + j * 256 + qk * 128 + cg8), wb = *(const LAS f32x4*)(cw + j * 256 + qk * 128 + cg8 + 4);
#pragma unroll
                    for (int e = 0; e < 8; ++e) { const float wv = e < 4 ? wa[e] : wb[e - 4]; const bf16x8 xa = qk ? xk[j] : xq[j], xb = qk ? xk[j + 1] : xq[j + 1];
                        y0[e] += wv * bf2f((unsigned short)xa[e]); y1[e] += wv * bf2f((unsigned short)xb[e]); }
                }
                const float ksc = qk ? 0.08838834764831845f : 1.0f;
#pragma unroll
                for (int e = 0; e < 8; ++e) { y0[e] = silu_f(y0[e]) * ksc; y1[e] = silu_f(y1[e]) * ksc; }
                LAS bf16_t* dst = qk ? Ks : Qs;
                u32x4 p0, p1; p0.x = cvt_pk_bf16(y0[0], y0[1]); p0.y = cvt_pk_bf16(y0[2], y0[3]); p0.z = cvt_pk_bf16(y0[4], y0[5]); p0.w = cvt_pk_bf16(y0[6], y0[7]);
                p1.x = cvt_pk_bf16(y1[0], y1[1]); p1.y = cvt_pk_bf16(y1[2], y1[3]); p1.z = cvt_pk_bf16(y1[4], y1[5]); p1.w = cvt_pk_bf16(y1[6], y1[7]);
                *(LAS u32x4*)(dst + i0 * QS_LD + cg8) = p0; *(LAS u32x4*)(dst + i1 * QS_LD + cg8) = p1;
                if (qk) {
#pragma unroll
                    for (int e = 0; e < 8; ++e) { const float a0 = y0[e] * w0, a1 = y1[e] * w1; *(LAS unsigned*)(KT + jsw(cg8 + e, ie)) = dir ? cvt_pk_bf16(a1, a0) : cvt_pk_bf16(a0, a1); }
                }
            }
#pragma unroll
            for (int e = 0; e < 8; ++e) { const unsigned lo = (unsigned short)(dir ? xv1[e] : xv0[e]), hi = (unsigned short)(dir ? xv0[e] : xv1[e]); *(LAS unsigned*)(VT + jsw(cg8 + e, ie)) = lo | (hi << 16); }
        }
        if (ci + 1 < 36) ML_LOAD(ci + 1);
        __syncthreads();
        if (lat) {
            const int it = w >> 1;
#pragma unroll
            for (int jj = 0; jj < 2; ++jj) {
                const int jt = (w & 1) * 2 + jj;
                f32x4 s = (f32x4){0.f, 0.f, 0.f, 0.f};
                if (jt <= it) {
#pragma unroll
                    for (int ks = 0; ks < 4; ++ks) { const bf16x8 a = *(const LAS bf16x8*)(Ks + (jt * 16 + fr) * QS_LD + ks * 32 + fq * 8), bb = *(const LAS bf16x8*)(Qs + (it * 16 + fr) * QS_LD + ks * 32 + fq * 8); s = mfma16(a, bb, s); }
                    const int i = it * 16 + fr, j0 = jt * 16 + 4 * fq; const float pmi = sc_pm[i]; const f32x4 uj = *(const LAS f32x4*)(sc_u + j0);
#pragma unroll
                    for (int r = 0; r < 4; ++r) s[r] = (j0 + r <= i) ? s[r] * __expf(uj[r] - pmi) : 0.f;
                }
                u32x2 pw; pw.x = cvt_pk_bf16(s[0], s[1]); pw.y = cvt_pk_bf16(s[2], s[3]);
                *(LAS u32x2*)(Ps + (it * 16 + fr) * JS_LD + jt * 16 + 4 * fq) = pw;
            }
#pragma unroll
            for (int nt = 0; nt < 9; ++nt) { u32x2 cwd; cwd.x = cvt_pk_bf16(C[nt][0], C[nt][1]); cwd.y = cvt_pk_bf16(C[nt][2], C[nt][3]); *(LAS u32x2*)(C0 + (nt * 16 + fr) * QS_LD + w * 16 + 4 * fq) = cwd; }
        }
        {
            const bf16x8 a0 = *(const LAS bf16x8*)(KT + jsw(w * 16 + fr, fq * 8)), a1 = *(const LAS bf16x8*)(KT + jsw(w * 16 + fr, 32 + fq * 8));
#pragma unroll
            for (int nt = 0; nt < 9; ++nt) { C[nt] *= decay;
                C[nt] = mfma16(a0, *(const LAS bf16x8*)(VT + jsw(nt * 16 + fr, fq * 8)), C[nt]); C[nt] = mfma16(a1, *(const LAS bf16x8*)(VT + jsw(nt * 16 + fr, 32 + fq * 8)), C[nt]); }
        }
        __syncthreads();
        if (lat) {
            const int it = w >> 1, dvh = w & 1, i = it * 16 + fr;
            f32x4 ac[5];
#pragma unroll
            for (int t = 0; t < 5; ++t) ac[t] = (f32x4){0.f, 0.f, 0.f, 0.f};
#pragma unroll
            for (int ks = 0; ks < 4; ++ks) { const bf16x8 bq = *(const LAS bf16x8*)(Qs + i * QS_LD + ks * 32 + fq * 8);
#pragma unroll
                for (int t = 0; t < 5; ++t) { const int row = (t < 4 ? (dvh * 4 + t) * 16 : 128) + fr; ac[t] = mfma16(*(const LAS bf16x8*)(C0 + row * QS_LD + ks * 32 + fq * 8), bq, ac[t]); } }
            const float ai = sc_a[i];
#pragma unroll
            for (int t = 0; t < 5; ++t) ac[t] *= ai;
#pragma unroll
            for (int ks = 0; ks < 2; ++ks) { const bf16x8 bp = *(const LAS bf16x8*)(Ps + i * JS_LD + ks * 32 + fq * 8);
#pragma unroll
                for (int t = 0; t < 5; ++t) { const int row = (t < 4 ? (dvh * 4 + t) * 16 : 128) + fr; ac[t] = mfma16(*(const LAS bf16x8*)(VT + jsw(row, ks * 32 + fq * 8)), bp, ac[t]); } }
            const float den = fmaxf(fabsf(ac[4][0]), sc_e[i]); const float rd = 1.0f / den;
            const size_t row = rbase + t0 + (dir ? 63 - i : i);
#pragma unroll
            for (int t = 0; t < 4; ++t) { u32x2 hw; hw.x = cvt_pk_bf16(ac[t][0] * rd, ac[t][1] * rd); hw.y = cvt_pk_bf16(ac[t][2] * rd, ac[t][3] * rd);
                *(u32x2*)(HO + row * 1024 + h * 128 + (dvh * 4 + t) * 16 + 4 * fq) = hw; }
        }
        m0 = m0n;
        __syncthreads();
    }
#undef ML_LOAD
#undef ML_CHUNK
}

__device__ __forceinline__ void phase_combine(const Params& p) {
    const bf16_t* HF = (const bf16_t*)(p.ws + WS_H); const bf16_t* HB = HF + (size_t)NLAT * 1024; const bf16_t* MO = (const bf16_t*)(p.ws + WS_MO);
    bf16_t* AT = (bf16_t*)(p.ws + WS_ATT);
    const int tid = otid(), c8 = (tid & 127) * 8, rq = tid >> 7;
    f32x4 g0 = *(const f32x4*)(p.m_gain + c8), g1 = *(const f32x4*)(p.m_gain + c8 + 4);
    for (int r = blockIdx.x * 4 + rq; r < NLAT; r += gridDim.x * 4) {
        const bf16x8 a = *(const bf16x8*)(HF + (size_t)r * 1024 + c8), bb = *(const bf16x8*)(HB + (size_t)r * 1024 + c8), mo = *(const bf16x8*)(MO + (size_t)r * 1024 + c8);
        float x[8], ss = 0.f;
#pragma unroll
        for (int e = 0; e < 8; ++e) { x[e] = bf2f((unsigned short)a[e]) + bf2f((unsigned short)bb[e]); ss += x[e] * x[e]; }
        ss += __shfl_xor(ss, 1); ss += __shfl_xor(ss, 2); ss += __shfl_xor(ss, 4); ss += __shfl_xor(ss, 8);
        const float rs = rsqrtf(ss * (1.0f / 128.0f) + RMS_EPS);
        float y[8];
#pragma unroll
        for (int e = 0; e < 8; ++e) y[e] = x[e] * rs * (e < 4 ? g0[e] : g1[e - 4]) * bf2f((unsigned short)mo[e]);
        u32x4 wv; wv.x = cvt_pk_bf16(y[0], y[1]); wv.y = cvt_pk_bf16(y[2], y[3]); wv.z = cvt_pk_bf16(y[4], y[5]); wv.w = cvt_pk_bf16(y[6], y[7]);
        *(u32x4*)(AT + (size_t)r * 2048 + 1024 + c8) = wv;
    }
}

__device__ __forceinline__ void combine_item(const Params& p, int b, int h, int t0) {
    const bf16_t* HF = (const bf16_t*)(p.ws + WS_H); const bf16_t* HB = HF + (size_t)NLAT * 1024; const bf16_t* MO = (const bf16_t*)(p.ws + WS_MO);
    bf16_t* AT = (bf16_t*)(p.ws + WS_ATT);
    const int tid = otid(), c8 = (tid & 15) * 8, tr = tid >> 4;
    const f32x4 g0 = *(const f32x4*)(p.m_gain + h * 128 + c8), g1 = *(const f32x4*)(p.m_gain + h * 128 + c8 + 4);
    for (int it = 0; it < 16; it += 4) {
        bf16x8 a[4], bb[4], mo[4];
#pragma unroll
        for (int q = 0; q < 4; ++q) { const size_t r = (size_t)b * TL + t0 + (it + q) * 32 + tr; const size_t o = r * 1024 + h * 128 + c8;
            a[q] = *(const bf16x8*)(HF + o); bb[q] = *(const bf16x8*)(HB + o); mo[q] = *(const bf16x8*)(MO + o); }
#pragma unroll
        for (int q = 0; q < 4; ++q) {
            float x[8], ss = 0.f;
#pragma unroll
            for (int e = 0; e < 8; ++e) { x[e] = bf2f((unsigned short)a[q][e]) + bf2f((unsigned short)bb[q][e]); ss += x[e] * x[e]; }
            ss += __shfl_xor(ss, 1); ss += __shfl_xor(ss, 2); ss += __shfl_xor(ss, 4); ss += __shfl_xor(ss, 8);
            const float rs = rsqrtf(ss * (1.0f / 128.0f) + RMS_EPS);
            float y[8];
#pragma unroll
            for (int e = 0; e < 8; ++e) y[e] = x[e] * rs * (e < 4 ? g0[e] : g1[e - 4]) * bf2f((unsigned short)mo[q][e]);
            u32x4 wv; wv.x = cvt_pk_bf16(y[0], y[1]); wv.y = cvt_pk_bf16(y[2], y[3]); wv.z = cvt_pk_bf16(y[4], y[5]); wv.w = cvt_pk_bf16(y[6], y[7]);
            const size_t r = (size_t)b * TL + t0 + (it + q) * 32 + tr;
            *(u32x4*)(AT + r * 2048 + 1024 + h * 128 + c8) = wv;
        }
    }
}

#define XB_TMO      128
#define XB_XCNT(j)  (256  + 64 * (j))
#define XB_XSUB(j)  (1280 + 64 * (j))
#define XB_XGEN(j)  (2304 + 64 * (j))
#define XB_TOP      3328
#define XB_TOPGEN   3392
#define XCD_BAR_WORDS 3456
#define XB_SPIN_CAP (1u << 22)
__device__ __forceinline__ unsigned xb_ld(unsigned* p)              { return __hip_atomic_load(p, __ATOMIC_RELAXED, __HIP_MEMORY_SCOPE_AGENT); }
__device__ __forceinline__ unsigned xb_add(unsigned* p, unsigned v) { return __hip_atomic_fetch_add(p, v, __ATOMIC_RELAXED, __HIP_MEMORY_SCOPE_AGENT); }
__device__ __forceinline__ unsigned xb_xcc_id() { return (unsigned)__builtin_amdgcn_s_getreg((3 << 11) | 20) & 0xFu; }
#define XB_SPIN(cond, bar) do { unsigned _sp = 0; while (cond) { __builtin_amdgcn_s_sleep(1); \
    if ((++_sp & 255u) == 0u) { if (xb_ld(&(bar)[XB_TMO])) break; if (_sp > XB_SPIN_CAP) { atomicAdd(&(bar)[XB_TMO], 1u); break; } } } } while (0)
struct XcdBarrier { unsigned* bar; unsigned x; volatile LAS unsigned* st; };
__device__ __forceinline__ XcdBarrier xcd_barrier_post(unsigned* bar, volatile LAS unsigned* st) {
    XcdBarrier b; b.bar = bar; b.x = xb_xcc_id(); b.st = st;
    if (threadIdx.x == 0) (void)xb_add(&bar[XB_XCNT(b.x)], 1u);
    return b;
}
__device__ __forceinline__ void xcd_barrier_complete(unsigned* bar, unsigned x, unsigned& nloc, unsigned& nx) {
    const unsigned G = gridDim.x * gridDim.y * gridDim.z;
    unsigned sum, cnt, mine, sp = 0u;
    for (;;) {
        sum = 0u; cnt = 0u; mine = 0u;
#pragma unroll
        for (unsigned j = 0; j < 16; ++j) { const unsigned c = xb_ld(&bar[XB_XCNT(j)]); sum += c; cnt += (c > 0u) ? 1u : 0u; mine = (j == x) ? c : mine; }
        if (sum == G) break;
        __builtin_amdgcn_s_sleep(1);
        if ((++sp & 255u) == 0u) { if (xb_ld(&bar[XB_TMO])) break; if (sp > XB_SPIN_CAP) { atomicAdd(&bar[XB_TMO], 1u); break; } }
    }
    nloc = mine > 0u ? mine : 1u; nx = cnt > 0u ? cnt : 1u;
}
__device__ __forceinline__ void xcd_barrier(const XcdBarrier& b) {
    asm volatile("s_waitcnt vmcnt(0)" ::: "memory");
    __syncthreads();
    if (threadIdx.x == 0) {
        unsigned* bar = b.bar;
        __builtin_amdgcn_s_waitcnt(0);
        unsigned nloc = b.st[0], nx = b.st[1];
        if (nloc == 0u) { xcd_barrier_complete(bar, b.x, nloc, nx); b.st[0] = nloc; b.st[1] = nx; }
        const unsigned old = xb_add(&bar[XB_XSUB(b.x)], 1u);
        const unsigned gen = old / nloc;
        if (old + 1u == (gen + 1u) * nloc) {
            __builtin_amdgcn_fence(__ATOMIC_RELEASE, "agent");
            asm volatile("s_waitcnt vmcnt(0)" ::: "memory");
            const unsigned og = xb_add(&bar[XB_TOP], 1u);
            const unsigned tg = og / nx;
            if (og + 1u == (tg + 1u) * nx) xb_add(&bar[XB_TOPGEN], 1u);
            else XB_SPIN(xb_ld(&bar[XB_TOPGEN]) == tg, bar);
            __builtin_amdgcn_fence(__ATOMIC_ACQUIRE, "agent");
            xb_add(&bar[XB_XGEN(b.x)], 1u);
            asm volatile("s_waitcnt vmcnt(0)" ::: "memory");
        } else {
            XB_SPIN(xb_ld(&bar[XB_XGEN(b.x)]) == gen, bar);
            __builtin_amdgcn_fence(__ATOMIC_ACQUIRE, "agent");
            asm volatile("s_waitcnt vmcnt(0)" ::: "memory");
        }
    }
    __syncthreads();
}

__device__ __forceinline__ void panel_handoff(unsigned* cnt, unsigned need) {
    asm volatile("s_waitcnt vmcnt(0)" ::: "memory"); __syncthreads();
    if (threadIdx.x == 0) {
        __builtin_amdgcn_fence(__ATOMIC_RELEASE, "agent"); asm volatile("s_waitcnt vmcnt(0)" ::: "memory");
        (void)__hip_atomic_fetch_add(cnt, 1u, __ATOMIC_RELAXED, __HIP_MEMORY_SCOPE_AGENT);
        unsigned sp = 0u; while (__hip_atomic_load(cnt, __ATOMIC_RELAXED, __HIP_MEMORY_SCOPE_AGENT) < need) { __builtin_amdgcn_s_sleep(1); if (++sp > (1u << 22)) break; }
        __builtin_amdgcn_fence(__ATOMIC_ACQUIRE, "agent"); asm volatile("s_waitcnt vmcnt(0)" ::: "memory");
    }
    __syncthreads();
}

__global__ void __launch_bounds__(512, 2) fwd_megakernel(Params p0) {
    extern __shared__ __attribute__((aligned(16))) unsigned char lds_raw[];
    LAS unsigned char* lds = (LAS unsigned char*)lds_raw;
    if (threadIdx.x < 16) ((LAS unsigned*)(lds + LDS_CTL))[threadIdx.x] = 0u;
    __syncthreads();
    XcdBarrier xbar; xbar.bar = (unsigned*)(p0.ws + WS_BAR); xbar.x = 0; xbar.st = (volatile LAS unsigned*)(lds + LDS_CTL + 16);
    if (p0.ph_hi - p0.ph_lo > 1) xbar = xcd_barrier_post((unsigned*)(p0.ws + WS_BAR), (volatile LAS unsigned*)(lds + LDS_CTL + 16));
    for (int ph = p0.ph_lo; ph < p0.ph_hi; ++ph) {
#if defined(__HIP_DEVICE_COMPILE__)
        const __attribute__((address_space(4))) Params* pp = (const __attribute__((address_space(4))) Params*)__builtin_amdgcn_kernarg_segment_ptr();
        asm volatile("" : "+s"(pp));
        const Params p = *pp;
        int G = gridDim.x, bid = blockIdx.x; asm volatile("" : "+s"(G), "+s"(bid));
#else
        const Params p = p0; int G = 0, bid = 0;
#endif
        unsigned char* ws = p.ws;
        float* mod = (float*)(ws + WS_MOD);
        const bool fuse = (G == 256) && (p0.ph_hi - p0.ph_lo > 1);
        if (fuse && (ph == 4 || ph == 7 || ph == 9 || ph == 12)) continue;
        for (int rep = 0; rep < (((DUPMASK >> ph) & 1) ? 2 : 1); ++rep)
        if (HAS(0) && ph == 0) {
            phase_prep(p, lds, rep == 0);
        } else if (HAS(1) && (ph == 1 || ph == 4 || ph == 9)) {
            const float* sl = ph == 1 ? p.x : p.out; const float* scx = p.ctx;
            const int nrows = ph == 9 ? NLAT : MR, midx = ph == 1 ? 0 : (ph == 4 ? 3 : 6);
            if (fuse && ph == 4)
                phase_rows<0>(sl, scx, MR, p.g_norm + DM, mod, 3, (bf16_t*)(ws + WS_H), nullptr, (const float*)(ws + WS_PART), NLAT + bid * 8, G * 8);
            else
            phase_rows<0>(sl, scx, nrows, p.g_norm + (ph == 1 ? 0 : (ph == 4 ? 1 : 2)) * DM, mod, midx, (bf16_t*)(ws + WS_H), nullptr, ph == 4 ? (const float*)(ws + WS_PART) : nullptr);
        } else if (HAS(2) && (ph == 2 || ph == 10)) {
            pg8::Gemm g{(const bf16_t*)(ws + WS_H), (const bf16_t*)(ws + (ph == 2 ? WS_WUP1 : WS_WUP2)), ph == 2 ? MR : NLAT, NUP, DM, DM};
            pg8::StaticOrder S; S.init(g.M, g.N, G, bid);
            EpiSwiglu E{(bf16_t*)(ws + WS_HID)};
            pg8::gemm_phase<EpiSwiglu>(lds, g, S, E);
            if (ph == 2) { const int busy = S.nwg % G; if (busy != 0 && bid >= busy) prep_weights(p, lds, 1, bid - busy, G - busy); else if (busy == 0) prep_weights(p, lds, 1, bid, G); }
        } else if (HAS(3) && (ph == 3 || ph == 8 || ph == 11)) {
            pg8::Gemm g;
            if (ph == 3) g = pg8::Gemm{(const bf16_t*)(ws + WS_HID), (const bf16_t*)(ws + WS_WDN1), NLAT, DM, DFF, DFF};
            else if (ph == 8) g = pg8::Gemm{(const bf16_t*)(ws + WS_ATT), (const bf16_t*)(ws + WS_WOUT), NLAT, DM, DM, DM};
            else g = pg8::Gemm{(const bf16_t*)(ws + WS_HID), (const bf16_t*)(ws + WS_WDN2), NLAT, DM, DFF, DFF};
            pg8::StaticOrder S; S.init(g.M, g.N, G, bid);
            EpiResid E{ph == 3 ? p.x : p.out, p.ctx, p.out, nullptr, mod, ph == 3 ? 2 : (ph == 8 ? 5 : 8), ph == 8 ? 1.0f : 0.5f};
            pg8::gemm_phase<EpiResid>(lds, g, S, E);
            if (fuse) {
                pg8::Unit u0; S.next(0, u0);
                unsigned* cnt = (unsigned*)(ws + WS_PCNT) + ((ph == 3 ? 0 : (ph == 8 ? 1 : 2)) * 64 + u0.pm) * 64;
                panel_handoff(cnt, 4u);
                const int r0 = u0.pm * 256 + (u0.pn & 3) * 64;
                if (ph == 11) phase_rows<1>(p.out, nullptr, r0 + 64, p.g_final, nullptr, 0, nullptr, p.out, nullptr, r0, 8);
                else phase_rows<0>(p.out, nullptr, r0 + 64, p.g_norm + (ph == 3 ? 1 : 2) * DM, mod, ph == 3 ? 3 : 6, (bf16_t*)(ws + WS_H), nullptr, nullptr, r0, 8);
            }
            if (ph == 3) {
                pg8::Gemm g2{(const bf16_t*)(ws + WS_HID), (const bf16_t*)(ws + WS_WDN1), NCTX, DM, DFF / 4, DFF};
                pg8::StaticOrder S2; S2.init(NCTX, DM, G, bid, 64, 4);
                EpiPartial E2{(float*)(ws + WS_PART)};
                pg8::gemm_phase<EpiPartial>(lds, g2, S2, E2);
                if (fuse) {
                    pg8::Unit u2; S2.next(0, u2);
                    panel_handoff((unsigned*)(ws + WS_PCNT) + (4 * 64 + (u2.pm - 64)) * 64, 32u);
                    const int rc = NLAT + (u2.pm - 64) * 256 + (u2.ks * 8 + u2.pn) * 8;
                    phase_rows<0>(p.out, p.ctx, rc + 8, p.g_norm + DM, mod, 3, (bf16_t*)(ws + WS_H), nullptr, (const float*)(ws + WS_PART), rc, 8);
                }
            }
        } else if (HAS(5) && ph == 5) {
            pg8::Gemm g{(const bf16_t*)(ws + WS_H), (const bf16_t*)(ws + WS_WIN), MR, PWP, DM, DM};
            pg8::StaticOrder S; S.init(g.M, g.N, G, bid);
            EpiWin E{(bf16_t*)(ws + WS_Q), (bf16_t*)(ws + WS_K), (bf16_t*)(ws + WS_V), (bf16_t*)(ws + WS_MQK), (bf16_t*)(ws + WS_MV), (bf16_t*)(ws + WS_MO), (float*)(ws + WS_GT),
                     p.q_gain, p.k_gain, p.gate_b, (const float*)(ws + WS_ROPE), (LAS float*)(lds + LDS_RED)};
            pg8::gemm_phase<EpiWin>(lds, g, S, E);
            { const int busy = S.nwg % G; if (busy != 0 && bid >= busy) prep_weights(p, lds, 2, bid - busy, G - busy); else if (busy == 0) prep_weights(p, lds, 2, bid, G); }
        } else if (HAS(6) && ph == 6) {
#if !defined(NO_MLSTM)
            for (int s = bid; s < 128 && rep == 0; s += G) { mlstm_stream(p, lds, s);
                if (fuse) {
                    asm volatile("s_waitcnt vmcnt(0)" ::: "memory"); __syncthreads();
                    if (otid() == 0) { __builtin_amdgcn_fence(__ATOMIC_RELEASE, "agent"); asm volatile("s_waitcnt vmcnt(0)" ::: "memory");
                        (void)__hip_atomic_fetch_add((unsigned*)(ws + WS_PCNT) + (3 * 64 + (s >> 1)) * 64, 1u, __ATOMIC_RELAXED, __HIP_MEMORY_SCOPE_AGENT); } } }
#endif
#if !defined(NO_ATTN)
            {
                int* ctr = (int*)(ws + WS_CTR) + rep * 8;
                for (int qi = 0; qi < 8; ++qi) {
                    const int bq = (bid + qi) & 7;
                    for (;;) {
                        __syncthreads();
                        if (otid() == 0) { int v = __hip_atomic_load(ctr + bq, __ATOMIC_RELAXED, __HIP_MEMORY_SCOPE_AGENT); if (v < 64) v = atomicAdd(ctr + bq, 1); *(LAS int*)(lds + LDS_CTL) = v; }
                        __syncthreads();
                        const int u = *(LAS int*)(lds + LDS_CTL);
                        if (u >= 64) break;
                        attn_unit(p, lds_raw, bq * 64 + u);
                    }
                }
            }
#endif
            if (fuse) {
                unsigned* pc = (unsigned*)(ws + WS_PCNT);
                for (;;) {
                    __syncthreads();
                    if (otid() == 0) { unsigned v = __hip_atomic_fetch_add(pc + 5 * 64 * 64, 1u, __ATOMIC_RELAXED, __HIP_MEMORY_SCOPE_AGENT);
                        if (v < 256u) { unsigned* c2 = pc + (3 * 64 + (v >> 2)) * 64; unsigned sp = 0u;
                            while (__hip_atomic_load(c2, __ATOMIC_RELAXED, __HIP_MEMORY_SCOPE_AGENT) < 2u) { __builtin_amdgcn_s_sleep(1); if (++sp > (1u << 22)) break; }
                            __builtin_amdgcn_fence(__ATOMIC_ACQUIRE, "agent"); asm volatile("s_waitcnt vmcnt(0)" ::: "memory"); }
                        *(LAS int*)(lds + LDS_CTL) = (int)v; }
                    __syncthreads();
                    const int v = *(LAS int*)(lds + LDS_CTL);
                    if (v >= 256) break;
                    combine_item(p, v >> 5, (v >> 2) & 7, (v & 3) * 512);
                }
            }
        } else if (HAS(7) && ph == 7) {
            phase_combine(p);
        } else if (HAS(12) && ph == 12) {
            phase_rows<1>(p.out, nullptr, NLAT, p.g_final, nullptr, 0, nullptr, p.out, nullptr);
        }
        if (ph + 1 < p0.ph_hi && !(fuse && ph == 11)) {
            if (p0.ph_hi > 1000) cg::this_grid().sync(); else xcd_barrier(xbar);
        }
    }
}

extern "C" void kernel_launch(void* const* d_in, const int* in_sizes, int n_in, void* d_out, int out_size, void* d_ws, size_t ws_size, hipStream_t stream) {
    static int grid = 0;
    if (grid == 0) {
        if (n_in != 20 || out_size != NLAT * DM || ws_size < WS_END) { fprintf(stderr, "kernel_launch: unexpected shapes (n_in %d out %d ws %zu need %zu)\n", n_in, out_size, ws_size, (size_t)WS_END); grid = -1; return; }
        int dev = 0, cus = 0, per_cu = 0;
        hipGetDevice(&dev); hipDeviceGetAttribute(&cus, hipDeviceAttributeMultiprocessorCount, dev);
        if (hipFuncSetAttribute((const void*)fwd_megakernel, hipFuncAttributeMaxDynamicSharedMemorySize, LDS_BYTES) != hipSuccess) { fprintf(stderr, "kernel_launch: hipFuncSetAttribute failed\n"); grid = -1; return; }
        hipOccupancyMaxActiveBlocksPerMultiprocessor(&per_cu, (const void*)fwd_megakernel, 512, LDS_BYTES);
        if (per_cu < 1) { fprintf(stderr, "kernel_launch: occupancy query says %d blocks per CU\n", per_cu); per_cu = 1; }
        (void)hipGetLastError();
        grid = cus * 1;
    }
    if (grid < 0) return;
    (void)hipMemsetAsync((char*)d_ws + WS_MOD, 0, (size_t)(WS_ROPE - WS_MOD), stream);
    Params p{};
    p.x = (const float*)d_in[0]; p.c = (const float*)d_in[1]; p.ctx = (const float*)d_in[2]; p.c_ctx = (const float*)d_in[3]; p.w_mod = (const float*)d_in[4]; p.b_mod = (const float*)d_in[5];
    p.g_norm = (const float*)d_in[6]; p.w_up1 = (const float*)d_in[7]; p.w_dn1 = (const float*)d_in[8]; p.w_up2 = (const float*)d_in[9]; p.w_dn2 = (const float*)d_in[10]; p.w_in = (const float*)d_in[11];
    p.q_gain = (const float*)d_in[12]; p.k_gain = (const float*)d_in[13]; p.conv_w = (const float*)d_in[14]; p.conv_b = (const float*)d_in[15]; p.gate_b = (const float*)d_in[16]; p.m_gain = (const float*)d_in[17];
    p.w_out = (const float*)d_in[18]; p.g_final = (const float*)d_in[19]; p.out = (float*)d_out; p.ws = (unsigned char*)d_ws;
#if MK_MULTI
    for (int ph = 0; ph < NPH; ++ph) { p.ph_lo = ph; p.ph_hi = ph + 1; hipLaunchKernelGGL(fwd_megakernel, dim3(grid), dim3(512), LDS_BYTES, stream, p); }
#else
    p.ph_lo = 0; p.ph_hi = NPH;
    void* args[] = {&p};
    hipError_t e = hipLaunchCooperativeKernel((const void*)fwd_megakernel, dim3(grid), dim3(512), args, LDS_BYTES, stream);
    if (e != hipSuccess) fprintf(stderr, "cooperative launch failed: %s (grid %d)\n", hipGetErrorString(e), grid);
#endif
}
```

```cpp
#include <hip/hip_runtime.h>
#include <hip/hip_cooperative_groups.h>
#include <cstdio>
#include <cstdint>
namespace cg = cooperative_groups;

#define LAS __attribute__((address_space(3)))
typedef unsigned short bf16_t;
typedef short bf16x8 __attribute__((ext_vector_type(8)));
typedef short s16x4 __attribute__((ext_vector_type(4)));
typedef float f32x4 __attribute__((ext_vector_type(4)));
typedef float f32x16 __attribute__((ext_vector_type(16)));
typedef unsigned u32x4 __attribute__((ext_vector_type(4)));
typedef unsigned u32x2 __attribute__((ext_vector_type(2)));

#ifndef PHMASK
#define PHMASK 0x1fff
#endif
#define HAS(k) ((PHMASK >> (k)) & 1)
#ifndef DUPMASK
#define DUPMASK 0
#endif
#ifndef MK_MULTI
#define MK_MULTI 0
#endif

constexpr int DM = 2048, NB = 8, TL = 2048, TCX = 256, NLAT = NB * TL, NCTX = NB * TCX, MR = NLAT + NCTX;
constexpr int DFF = 5632, NUP = 2 * DFF, PW = 5664, PWP = 5888, NMOD = 9, MODW = NMOD * DM;
constexpr int SKV = TCX + TL;
constexpr float RMS_EPS = 1e-6f;
constexpr int NPH = 13;

constexpr size_t al256(size_t x) { return (x + 255) / 256 * 256; }
constexpr size_t WS_MOD = 0;
constexpr size_t WS_CTR = WS_MOD + (size_t)9 * MODW * 4;
constexpr size_t WS_BAR = WS_CTR + 256;
constexpr size_t WS_PCNT = al256(WS_BAR + 3456 * 4);
constexpr size_t WS_ROPE = WS_PCNT + (size_t)(5 * 64 + 1) * 256;
constexpr size_t WS_WUP1 = al256(WS_ROPE + 4096 * 4);
constexpr size_t WS_WDN1 = WS_WUP1 + (size_t)NUP * DM * 2;
constexpr size_t WS_WIN = WS_WDN1 + (size_t)DM * DFF * 2;
constexpr size_t WS_WOUT = WS_WIN + (size_t)PWP * DM * 2;
constexpr size_t WS_WUP2 = WS_WOUT + (size_t)DM * DM * 2;
constexpr size_t WS_WDN2 = WS_WUP2 + (size_t)NUP * DM * 2;
constexpr size_t WS_H = WS_WDN2 + (size_t)DM * DFF * 2;
constexpr size_t WS_HID = WS_H + (size_t)MR * DM * 2;
constexpr size_t WS_Q = WS_HID;
constexpr size_t WS_K = WS_Q + (size_t)NLAT * 1024 * 2;
constexpr size_t WS_V = WS_K + (size_t)NB * SKV * 256 * 2;
constexpr size_t WS_MQK = WS_V + (size_t)NB * SKV * 256 * 2;
constexpr size_t WS_MV = WS_MQK + (size_t)MR * 2048 * 2;
constexpr size_t WS_MO = WS_MV + (size_t)MR * 1024 * 2;
constexpr size_t WS_GT = WS_MO + (size_t)NLAT * 1024 * 2;
constexpr size_t WS_PROJ_END = WS_GT + (size_t)MR * 32 * 4;
constexpr size_t WS_ATT = WS_HID + (size_t)MR * DFF * 2;
constexpr size_t WS_PART = WS_ATT;
constexpr size_t WS_XC = WS_ATT + (size_t)NLAT * 2048 * 2;
constexpr size_t WS_END = WS_XC + (size_t)NCTX * DM * 4;
static_assert(WS_PROJ_END <= WS_ATT, "projection outputs must fit in the hidden buffer");

constexpr int LDS_STAGE = 131072;
constexpr int LDS_RED = LDS_STAGE;
constexpr int LDS_CTL = LDS_STAGE + 8192;
constexpr int LDS_BYTES = LDS_CTL + 64;
constexpr int QS_LD = 136, JS_LD = 72;
constexpr int ML_QS = 0, ML_KS = ML_QS + 64 * QS_LD * 2, ML_KT = ML_KS + 64 * QS_LD * 2, ML_VT = ML_KT + 128 * 64 * 2, ML_PS = ML_VT + 144 * 64 * 2,
              ML_C0 = ML_PS + 64 * JS_LD * 2, ML_SC = ML_C0 + 144 * QS_LD * 2, ML_CW = ML_SC + 5 * 64 * 4, ML_CB = ML_CW + 5 * 256 * 4, ML_END = ML_CB + 256 * 4;
static_assert(ML_END <= LDS_BYTES, "mLSTM LDS");

struct Params {
    const float *x, *c, *ctx, *c_ctx, *w_mod, *b_mod, *g_norm, *w_up1, *w_dn1, *w_up2, *w_dn2, *w_in, *q_gain, *k_gain, *conv_w, *conv_b, *gate_b, *m_gain, *w_out, *g_final;
    float* out; unsigned char* ws; int ph_lo, ph_hi;
};

__device__ __forceinline__ int otid() { int t = threadIdx.x; asm volatile("" : "+v"(t)); return t; }
__device__ __forceinline__ unsigned cvt_pk_bf16(float lo, float hi) { unsigned r; asm volatile("v_cvt_pk_bf16_f32 %0, %1, %2" : "=v"(r) : "v"(lo), "v"(hi)); return r; }
__device__ __forceinline__ float bf2f(unsigned short v) { return __uint_as_float(((unsigned)v) << 16); }
__device__ __forceinline__ float silu_f(float x) { return x * __builtin_amdgcn_rcpf(1.0f + __expf(-x)); }
__device__ __forceinline__ float sigmoid_f(float x) { return __builtin_amdgcn_rcpf(1.0f + __expf(-x)); }
__device__ __forceinline__ float logsigmoid_f(float x) { return fminf(x, 0.f) - __logf(1.0f + __expf(-fabsf(x))); }

namespace pg8 {
constexpr int BM = 256, BK = 64, HALF = 128, HTB = HALF * BK * 2, NXCD = 8, WGM = 8;
__device__ __forceinline__ int lds_byte(int r, int c) { const int st = (r >> 4) * 2 + (c >> 5), rr = r & 15, cc = c & 31, ob = rr * 64 + cc * 2; return st * 1024 + (ob ^ (((ob >> 9) & 1) << 5)); }
__device__ __forceinline__ void stage_rc(int b, int& R, int& C) { const int st = b / 1024, sb = b % 1024, swz = sb ^ (((sb >> 9) & 1) << 5); R = (st >> 1) * 16 + swz / 64; C = (st & 1) * 32 + (swz % 64) / 2; }
__device__ __forceinline__ int perm32(int rho) { const int n = rho >> 4, i = rho & 15; return 8 * (i >> 2) + 4 * n + (i & 3); }
struct Unit { int pm, pn, ks; };
struct Gemm { const bf16_t* A; const bf16_t* Bt; int M, N, K, ld; int tiledA; };
struct StaticOrder {
    int nM, nN, nwg, G, c, pm0, nNr;
    __device__ void init(int M, int N, int G_, int c_, int pm0_ = 0, int ksplit = 1) { nM = M / BM; nNr = N / BM; nN = nNr * ksplit; nwg = nM * nN; G = G_; c = c_; pm0 = pm0_; }
    __device__ bool next(int i, Unit& u) const {
        const long L = (long)i * G + c; if (L >= nwg) return false;
        int wgid = (int)L; { const int q = nwg / NXCD, r = nwg % NXCD, xcd = wgid % NXCD, off = wgid / NXCD; wgid = (xcd < r ? xcd * (q + 1) : r * (q + 1) + (xcd - r) * q) + off; }
        const int nig = WGM * nN, gid = wgid / nig, fm = gid * WGM, gsz = (nM - fm) < WGM ? (nM - fm) : WGM;
        u.pm = pm0 + fm + ((wgid % nig) % gsz); const int pe = (wgid % nig) / gsz; u.pn = pe % nNr; u.ks = pe / nNr; return true;
    }
};

template <class Epi>
__device__ __forceinline__ void gemm_phase(LAS unsigned char* lds, const Gemm g, const StaticOrder& S, const Epi& E) {
    const int tid = otid(), wid = __builtin_amdgcn_readfirstlane(tid >> 6), lane = tid & 63, wr = wid >> 2, wc = wid & 3, fr = lane & 15, fq = lane >> 4;
    const int K = g.K, nt = K / BK;
    unsigned voffA[2], voffB[2];
#pragma unroll
    for (int i = 0; i < 2; ++i) { int R, C; stage_rc(tid * 16 + i * 8192, R, C); const int Rb = Epi::PERM ? ((R & ~31) + perm32(R & 31)) : R;
        voffA[i] = (unsigned)(R * (g.tiledA ? BK : g.ld) + C) * 2u; voffB[i] = (unsigned)(Rb * g.ld + C) * 2u; }
    const size_t kstep = (size_t)(BK * 2);
    const size_t hstep = (size_t)HALF * g.ld * 2;
    const size_t ksB = (size_t)K * 2;
    const size_t tstep = 2 * hstep;
    const size_t kstepA = g.tiledA ? (size_t)(BM * BK * 2) : kstep, hstepA = g.tiledA ? (size_t)(HALF * BK * 2) : hstep;
    const size_t tstepA = g.tiledA ? (size_t)(g.ld / BK) * kstepA : tstep, ksA = g.tiledA ? (size_t)(K / BK) * kstepA : ksB;
    const unsigned ldsw = (unsigned)wid * 1024u;
    const int aoff = lds_byte(wr * 64 + fr, fq * 8), boff = lds_byte(wc * 32 + fr, fq * 8);
#define PG8_SA(b, h) (((b) * 2 + (h)) * HTB)
#define PG8_SB(b, h) ((4 + (b) * 2 + (h)) * HTB)
#define PG8_STAGE(bufoff, gbase, voff) do { _Pragma("unroll") for (int _i = 0; _i < 2; ++_i) \
        __builtin_amdgcn_global_load_lds((const unsigned*)((const char*)(gbase) + (voff)[_i]), (LAS unsigned*)(lds + (bufoff) + ldsw + _i * 8192), 16, 0, 0); } while (0)
#define PG8_LDA(dst, b, h) do { _Pragma("unroll") for (int m = 0; m < 4; ++m) _Pragma("unroll") for (int k = 0; k < 2; ++k) dst[m][k] = *(const LAS bf16x8*)(lds + PG8_SA(b, h) + aoff + m * 2048 + k * 1024); } while (0)
#define PG8_LDB(dst, b, h) do { _Pragma("unroll") for (int n = 0; n < 2; ++n) _Pragma("unroll") for (int k = 0; k < 2; ++k) dst[n][k] = *(const LAS bf16x8*)(lds + PG8_SB(b, h) + boff + n * 2048 + k * 1024); } while (0)
#define PG8_MMA(ai, bj, At, Bt) do { __builtin_amdgcn_s_setprio(1); _Pragma("unroll") for (int m = 0; m < 4; ++m) _Pragma("unroll") for (int n = 0; n < 2; ++n) _Pragma("unroll") for (int k = 0; k < 2; ++k) \
        acc[ai][bj][m][n] = __builtin_amdgcn_mfma_f32_16x16x32_bf16(Bt[n][k], At[m][k], acc[ai][bj][m][n], 0, 0, 0); __builtin_amdgcn_s_setprio(0); } while (0)
#define PG8_WAIT_V(n) asm volatile("s_waitcnt vmcnt(" #n ")" ::: "memory")
#define PG8_WAIT_L(n) asm volatile("s_waitcnt lgkmcnt(" #n ")" ::: "memory")
#define PG8_BAR __builtin_amdgcn_s_barrier()
#define PG8_SCHED __builtin_amdgcn_sched_barrier(0)
    Unit cur, nxt; int ui = 0;
    if (!S.next(0, cur)) return;
    f32x4 acc[2][2][4][2];
#pragma unroll
    for (int a = 0; a < 2; ++a)
#pragma unroll
        for (int b = 0; b < 2; ++b)
#pragma unroll
            for (int m = 0; m < 4; ++m)
#pragma unroll
                for (int n = 0; n < 2; ++n) acc[a][b][m][n] = (f32x4){0.f, 0.f, 0.f, 0.f};
    bf16x8 At[4][2], B0[2][2], B1[2][2];
    const char* cA = (const char*)g.A + (size_t)cur.pm * tstepA + cur.ks * ksA; const char* cB = (const char*)g.Bt + (size_t)cur.pn * tstep + cur.ks * ksB;
    PG8_STAGE(PG8_SB(0, 0), cB, voffB); PG8_STAGE(PG8_SA(0, 0), cA, voffA); PG8_STAGE(PG8_SB(0, 1), cB + hstep, voffB); PG8_STAGE(PG8_SA(0, 1), cA + hstepA, voffA);
    if (wr == 1) PG8_BAR;
    PG8_WAIT_V(4); PG8_BAR;
    PG8_STAGE(PG8_SB(1, 0), cB + kstep, voffB); PG8_STAGE(PG8_SA(1, 0), cA + kstepA, voffA); PG8_STAGE(PG8_SB(1, 1), cB + hstep + kstep, voffB);
    PG8_WAIT_V(6); PG8_BAR;
    for (;;) {
        const bool has_next = S.next(ui + 1, nxt);
        const char* nA = has_next ? (const char*)g.A + (size_t)nxt.pm * tstepA + nxt.ks * ksA : cA; const char* nB = has_next ? (const char*)g.Bt + (size_t)nxt.pn * tstep + nxt.ks * ksB : cB;
        for (int t = 0; t < nt; t += 2) {
            const bool last = (t == nt - 2);
            const char* a1 = cA + (size_t)(t + 1) * kstepA;
            const char* a2 = last ? nA : cA + (size_t)(t + 2) * kstepA; const char* b2 = last ? nB : cB + (size_t)(t + 2) * kstep;
            const char* a3 = a2 + kstepA; const char* b3 = b2 + kstep;
            PG8_LDB(B0, 0, 0); PG8_SCHED; PG8_LDA(At, 0, 0); PG8_STAGE(PG8_SA(1, 1), a1 + hstepA, voffA);
            PG8_WAIT_L(8); PG8_BAR; PG8_WAIT_L(0); PG8_MMA(0, 0, At, B0); PG8_BAR; PG8_SCHED;
            PG8_LDB(B1, 0, 1); PG8_STAGE(PG8_SB(0, 0), b2, voffB);
            PG8_BAR; PG8_WAIT_L(0); PG8_MMA(0, 1, At, B1); PG8_BAR;
            PG8_LDA(At, 0, 1); PG8_STAGE(PG8_SA(0, 0), a2, voffA);
            PG8_BAR; PG8_WAIT_L(0); PG8_MMA(1, 0, At, B0); PG8_BAR; PG8_SCHED;
            PG8_STAGE(PG8_SB(0, 1), b2 + hstep, voffB);
            PG8_WAIT_V(6); PG8_BAR; PG8_MMA(1, 1, At, B1); PG8_BAR;
            PG8_LDB(B0, 1, 0); PG8_SCHED; PG8_LDA(At, 1, 0); PG8_STAGE(PG8_SA(0, 1), a2 + hstepA, voffA);
            PG8_WAIT_L(8); PG8_BAR; PG8_WAIT_L(0); PG8_MMA(0, 0, At, B0); PG8_BAR; PG8_SCHED;
            PG8_LDB(B1, 1, 1); PG8_STAGE(PG8_SB(1, 0), b3, voffB);
            PG8_BAR; PG8_WAIT_L(0); PG8_MMA(0, 1, At, B1); PG8_BAR;
            PG8_LDA(At, 1, 1); PG8_STAGE(PG8_SA(1, 0), a3, voffA);
            PG8_BAR; PG8_WAIT_L(0); PG8_MMA(1, 0, At, B0); PG8_BAR; PG8_SCHED;
            PG8_STAGE(PG8_SB(1, 1), b3 + hstep, voffB);
            PG8_WAIT_V(6); PG8_BAR; PG8_MMA(1, 1, At, B1); PG8_BAR;
        }
        E(acc, cur, wr, wc, fr, fq);
        if (!has_next) break;
#pragma unroll
        for (int a = 0; a < 2; ++a)
#pragma unroll
            for (int b = 0; b < 2; ++b)
#pragma unroll
                for (int m = 0; m < 4; ++m)
#pragma unroll
                    for (int n = 0; n < 2; ++n) acc[a][b][m][n] = (f32x4){0.f, 0.f, 0.f, 0.f};
        cur = nxt; cA = nA; cB = nB; ++ui;
    }
    PG8_WAIT_V(0);
    if (wr == 0) PG8_BAR;
    PG8_BAR;
#undef PG8_SA
#undef PG8_SB
#undef PG8_STAGE
#undef PG8_LDA
#undef PG8_LDB
#undef PG8_MMA
#undef PG8_WAIT_V
#undef PG8_WAIT_L
#undef PG8_BAR
#undef PG8_SCHED
}
}

struct EpiSwiglu {
    static constexpr bool PERM = true;
    bf16_t* H;
    __device__ __forceinline__ void operator()(const f32x4 (&acc)[2][2][4][2], const pg8::Unit& u, int wr, int wc, int fr, int fq) const {
        const int row0 = u.pm * 256 + wr * 64 + fr, col0 = u.pn * 128 + wc * 32 + 8 * fq;
#pragma unroll
        for (int ai = 0; ai < 2; ++ai)
#pragma unroll
            for (int m = 0; m < 4; ++m) {
                const int rr = row0 + ai * 128 + m * 16;
                bf16_t* rowp = H + ((((size_t)(rr >> 8) * (DFF / 64) + (col0 >> 6)) * 256 + (rr & 255)) * 64 + (col0 & 63));
                const f32x4 a0 = acc[ai][0][m][0], a1 = acc[ai][0][m][1], b0 = acc[ai][1][m][0], b1 = acc[ai][1][m][1];
                float v[8];
#pragma unroll
                for (int j = 0; j < 4; ++j) { v[j] = silu_f(a0[j]) * b0[j]; v[4 + j] = silu_f(a1[j]) * b1[j]; }
                u32x4 w; w.x = cvt_pk_bf16(v[0], v[1]); w.y = cvt_pk_bf16(v[2], v[3]); w.z = cvt_pk_bf16(v[4], v[5]); w.w = cvt_pk_bf16(v[6], v[7]);
                *(u32x4*)rowp = w;
            }
    }
};
struct EpiResid {
    static constexpr bool PERM = false;
    const float* resid_l; const float* resid_c; float* out_l; float* out_c; const float* mod; int gidx; float coef;
    __device__ __forceinline__ void operator()(const f32x4 (&acc)[2][2][4][2], const pg8::Unit& u, int wr, int wc, int fr, int fq) const {
        const bool isctx = u.pm >= 64; const int b = isctx ? 8 : (u.pm >> 3);
        const int row0 = (isctx ? (u.pm - 64) : u.pm) * 256 + wr * 64 + fr, col0 = u.pn * 256 + wc * 32 + 4 * fq;
        const float* gp = mod + (size_t)(b * NMOD + gidx) * DM + col0;
        const float* rb = isctx ? resid_c : resid_l; float* ob = isctx ? out_c : out_l;
        f32x4 gv[2][2];
#pragma unroll
        for (int bj = 0; bj < 2; ++bj)
#pragma unroll
            for (int n = 0; n < 2; ++n) gv[bj][n] = *(const f32x4*)(gp + bj * 128 + n * 16) * coef;
#pragma unroll
        for (int ai = 0; ai < 2; ++ai)
#pragma unroll
            for (int m = 0; m < 4; ++m) {
                const size_t o = (size_t)(row0 + ai * 128 + m * 16) * DM + col0;
#pragma unroll
                for (int bj = 0; bj < 2; ++bj)
#pragma unroll
                    for (int n = 0; n < 2; ++n) { const f32x4 r = *(const f32x4*)(rb + o + bj * 128 + n * 16); *(f32x4*)(ob + o + bj * 128 + n * 16) = r + gv[bj][n] * acc[ai][bj][m][n]; }
            }
    }
};
struct EpiPartial {
    static constexpr bool PERM = false;
    float* P;
    __device__ __forceinline__ void operator()(const f32x4 (&acc)[2][2][4][2], const pg8::Unit& u, int wr, int wc, int fr, int fq) const {
        const int row0 = (u.pm - 64) * 256 + wr * 64 + fr, col0 = u.pn * 256 + wc * 32 + 4 * fq;
        float* ob = P + (size_t)u.ks * NCTX * DM;
#pragma unroll
        for (int ai = 0; ai < 2; ++ai)
#pragma unroll
            for (int m = 0; m < 4; ++m) {
                const size_t o = (size_t)(row0 + ai * 128 + m * 16) * DM + col0;
#pragma unroll
                for (int bj = 0; bj < 2; ++bj)
#pragma unroll
                    for (int n = 0; n < 2; ++n) *(f32x4*)(ob + o + bj * 128 + n * 16) = acc[ai][bj][m][n];
            }
    }
};
__device__ __forceinline__ int win_src(int slot) {
    if (slot >= PW) return -1;
    if (slot >= 1280) return slot;
    const int head = slot >> 7, s = slot & 127, wc = s >> 5, n = (s >> 4) & 1, fq = (s >> 2) & 3, j = s & 3;
    return head * 128 + (wc >> 1) * 64 + n * 32 + (wc & 1) * 16 + fq * 4 + j;
}
struct EpiWin {
    static constexpr bool PERM = false;
    bf16_t *Q, *K, *V, *MQK, *MV, *MO; float* GT; const float *qg, *kg, *gb, *rope; LAS float* red;
    __device__ __forceinline__ void st4(bf16_t* p, f32x4 v) const { u32x2 w; w.x = cvt_pk_bf16(v[0], v[1]); w.y = cvt_pk_bf16(v[2], v[3]); *(u32x2*)p = w; }
    __device__ __forceinline__ void operator()(const f32x4 (&acc)[2][2][4][2], const pg8::Unit& u, int wr, int wc, int fr, int fq) const {
        asm volatile("" : "+v"(fr), "+v"(fq));
        const int pn = u.pn; const bool isctx = u.pm >= 64;
        const int rt0 = wr * 64 + fr;
        const int grow0 = u.pm * 256 + rt0;
        if (pn <= 4) {
            const float* gain = pn < 4 ? qg : kg;
            const int d1 = (wc >> 1) * 64 + (wc & 1) * 16 + 4 * fq;
            const f32x4 g1 = *(const f32x4*)(gain + d1), g2 = *(const f32x4*)(gain + d1 + 32);
#pragma unroll
            for (int ai = 0; ai < 2; ++ai)
#pragma unroll
                for (int m = 0; m < 4; ++m)
#pragma unroll
                    for (int bj = 0; bj < 2; ++bj) {
                        const f32x4 a = acc[ai][bj][m][0], c = acc[ai][bj][m][1];
                        float ss = a[0] * a[0] + a[1] * a[1] + a[2] * a[2] + a[3] * a[3] + c[0] * c[0] + c[1] * c[1] + c[2] * c[2] + c[3] * c[3];
                        ss += __shfl_xor(ss, 16); ss += __shfl_xor(ss, 32);
                        if (fq == 0) red[((rt0 + ai * 128 + m * 16) * 2 + bj) * 4 + wc] = ss;
                    }
            asm volatile("s_waitcnt lgkmcnt(0)" ::: "memory"); __builtin_amdgcn_s_barrier(); asm volatile("" ::: "memory");
#pragma unroll
            for (int ai = 0; ai < 2; ++ai)
#pragma unroll
                for (int m = 0; m < 4; ++m) {
                    const int rl = rt0 + ai * 128 + m * 16, gr = grow0 + ai * 128 + m * 16;
                    int bidx, tok; if (isctx) { bidx = (gr - NLAT) >> 8; tok = (gr - NLAT) & 255; } else { bidx = gr >> 11; tok = gr & 2047; }
                    f32x4 cs = (f32x4){1.f, 1.f, 1.f, 1.f}, sn = (f32x4){0.f, 0.f, 0.f, 0.f};
                    if (!isctx) { const int pos = (wc >> 1) ? (tok & 63) : (tok >> 6); const int ro = pos * 32 + (wc & 1) * 16 + 4 * fq; cs = *(const f32x4*)(rope + ro); sn = *(const f32x4*)(rope + 2048 + ro); }
#pragma unroll
                    for (int bj = 0; bj < 2; ++bj) {
                        const f32x4 pr = *(const LAS f32x4*)(red + (rl * 2 + bj) * 4);
                        const float rs = __builtin_amdgcn_rsqf((pr[0] + pr[1] + pr[2] + pr[3]) * (1.0f / 128.0f) + RMS_EPS);
                        const f32x4 x1 = acc[ai][bj][m][0] * rs * g1, x2 = acc[ai][bj][m][1] * rs * g2;
                        const f32x4 y1 = x1 * cs - x2 * sn, y2 = x2 * cs + x1 * sn;
                        if (pn < 4) { if (!isctx) { bf16_t* qp = Q + (size_t)gr * 1024 + (pn * 2 + bj) * 128 + d1; st4(qp, y1); st4(qp + 32, y2); } }
                        else { bf16_t* kp = K + ((size_t)bidx * SKV + (isctx ? tok : TCX + tok)) * 256 + bj * 128 + d1; st4(kp, y1); st4(kp + 32, y2); }
                    }
                    __builtin_amdgcn_sched_barrier(0);
                }
        } else {
            const int cc0 = wc * 32 + 4 * fq;
#pragma unroll
            for (int ai = 0; ai < 2; ++ai)
#pragma unroll
                for (int m = 0; m < 4; ++m) {
                    const int gr = grow0 + ai * 128 + m * 16;
                    int bidx, tok; if (isctx) { bidx = (gr - NLAT) >> 8; tok = (gr - NLAT) & 255; } else { bidx = gr >> 11; tok = gr & 2047; }
#pragma unroll
                    for (int bj = 0; bj < 2; ++bj)
#pragma unroll
                        for (int n = 0; n < 2; ++n) {
                            const int cc = cc0 + bj * 128 + n * 16; const f32x4 v = acc[ai][bj][m][n];
                            if (pn == 5) st4(V + ((size_t)bidx * SKV + (isctx ? tok : TCX + tok)) * 256 + cc, v);
                            else if (pn < 14) st4(MQK + (size_t)gr * 2048 + (pn - 6) * 256 + cc, v);
                            else if (pn < 18) st4(MV + (size_t)gr * 1024 + (pn - 14) * 256 + cc, v);
                            else if (pn < 22) { if (!isctx) { f32x4 s; s[0] = sigmoid_f(v[0]); s[1] = sigmoid_f(v[1]); s[2] = sigmoid_f(v[2]); s[3] = sigmoid_f(v[3]); st4(MO + (size_t)gr * 1024 + (pn - 18) * 256 + cc, s); } }
                            else if (cc < 32) {
                                f32x4 t = v + *(const f32x4*)(gb + cc);
                                if (fq >= 2) { t[0] = logsigmoid_f(t[0]); t[1] = logsigmoid_f(t[1]); t[2] = logsigmoid_f(t[2]); t[3] = logsigmoid_f(t[3]); }
                                *(f32x4*)(GT + (size_t)gr * 32 + cc) = t;
                            }
                        }
                    __builtin_amdgcn_sched_barrier(0);
                }
        }
    }
};

__device__ __forceinline__ int up_src(int slot) { const int pn = slot >> 8, r = slot & 255; return (r >> 7) * DFF + pn * 128 + (r & 127); }
template <int MAP  >
__device__ __forceinline__ void prep_tile(const float* __restrict__ W, int Nsrc, bf16_t* __restrict__ Bt, int Kdim, int nt, int kt, LAS float* tl) {
    const int tid = otid();
    { const int n4 = tid & 63, kk = tid >> 6; const int slot = nt * 256 + 4 * n4;
      const int src = MAP == 0 ? slot : (MAP == 1 ? up_src(slot) : win_src(slot));
      f32x4 v[8];
#pragma unroll
      for (int pss = 0; pss < 8; ++pss) { v[pss] = (f32x4){0.f, 0.f, 0.f, 0.f}; if (src >= 0) v[pss] = *(const f32x4*)(W + (size_t)(kt * 64 + kk + pss * 8) * Nsrc + src); }
#pragma unroll
      for (int pss = 0; pss < 8; ++pss) *(LAS f32x4*)(tl + (kk + pss * 8) * 260 + 4 * n4) = v[pss]; }
    __syncthreads();
    { const int n = tid >> 1, kh = (tid & 1) * 32;
#pragma unroll
      for (int q = 0; q < 4; ++q) { float v[8];
#pragma unroll
          for (int e = 0; e < 8; ++e) v[e] = tl[(kh + q * 8 + e) * 260 + n];
          u32x4 w; w.x = cvt_pk_bf16(v[0], v[1]); w.y = cvt_pk_bf16(v[2], v[3]); w.z = cvt_pk_bf16(v[4], v[5]); w.w = cvt_pk_bf16(v[6], v[7]);
          *(u32x4*)(Bt + (size_t)(nt * 256 + n) * Kdim + kt * 64 + kh + q * 8) = w; } }
    __syncthreads();
}
__device__ __forceinline__ void prep_weights(const Params& p, LAS unsigned char* lds, int grp, int t0, int ts, int t1 = 1 << 30) {
    LAS float* tl = (LAS float*)lds;
    constexpr int T_UP = (NUP / 256) * (DM / 64), T_DN = (DM / 256) * (DFF / 64), T_IN = (PWP / 256) * (DM / 64), T_OUT = (DM / 256) * (DM / 64);
    int tot = grp == 0 ? T_UP : (grp == 1 ? T_DN + T_IN + T_OUT : T_UP + T_DN); if (t1 < tot) tot = t1;
    for (int t = t0; t < tot; t += ts) {
        int q = t;
        if (grp == 1) {
            if (q < T_DN) { prep_tile<0>(p.w_dn1, DM, (bf16_t*)(p.ws + WS_WDN1), DFF, q % (DM / 256), q / (DM / 256), tl); continue; } q -= T_DN;
            if (q < T_IN) { prep_tile<2>(p.w_in, PW, (bf16_t*)(p.ws + WS_WIN), DM, q % (PWP / 256), q / (PWP / 256), tl); continue; } q -= T_IN;
            prep_tile<0>(p.w_out, DM, (bf16_t*)(p.ws + WS_WOUT), DM, q % (DM / 256), q / (DM / 256), tl);
        } else {
            const float* wu = grp == 0 ? p.w_up1 : p.w_up2;
            if (q < T_UP) { prep_tile<1>(wu, NUP, (bf16_t*)(p.ws + (grp == 0 ? WS_WUP1 : WS_WUP2)), DM, q % (NUP / 256), q / (NUP / 256), tl); continue; } q -= T_UP;
            prep_tile<0>(p.w_dn2, DM, (bf16_t*)(p.ws + WS_WDN2), DFF, q % (DM / 256), q / (DM / 256), tl);
        }
    }
}
__device__ __forceinline__ void phase_prep(const Params& p, LAS unsigned char* lds, bool do_mod) {
    const int tid = otid(), G = gridDim.x, bid = blockIdx.x;
    float* mod = (float*)(p.ws + WS_MOD);
    LAS float* sv = (LAS float*)lds;
    LAS float* red = (LAS float*)(lds + 9 * 512 * 4);
    for (int item = bid; do_mod && item < 576; item += G) {
        const int cb = item >> 2, ks = item & 3;
        for (int i = tid; i < 9 * 512; i += 512) { const int b = i >> 9, k = i & 511; const float cv = b < 8 ? p.c[b * DM + ks * 512 + k] : p.c_ctx[ks * 512 + k]; sv[i] = silu_f(cv); }
        __syncthreads();
        const int c4 = tid & 31, kr = tid >> 5;
        f32x4 a[9];
#pragma unroll
        for (int b = 0; b < 9; ++b) a[b] = (f32x4){0.f, 0.f, 0.f, 0.f};
        for (int kk = kr; kk < 512; kk += 16) {
            const f32x4 w = *(const f32x4*)(p.w_mod + (size_t)(ks * 512 + kk) * MODW + cb * 128 + c4 * 4);
#pragma unroll
            for (int b = 0; b < 9; ++b) a[b] += w * sv[b * 512 + kk];
        }
#pragma unroll
        for (int b = 0; b < 9; ++b) *(LAS f32x4*)(red + (kr * 9 + b) * 128 + c4 * 4) = a[b];
        __syncthreads();
        for (int o = tid; o < 9 * 128; o += 512) { const int b = o >> 7, cidx = o & 127; float s = 0.f;
#pragma unroll
            for (int r = 0; r < 16; ++r) s += red[(r * 9 + b) * 128 + cidx];
            const int col = cb * 128 + cidx; if (ks == 0) s += p.b_mod[col];
            atomicAdd(mod + (size_t)b * MODW + col, s); }
        __syncthreads();
    }
    if (bid == G - 1) { float* rope = (float*)(p.ws + WS_ROPE);
        for (int i = tid; i < 2048; i += 512) { const int pos = i >> 5, idx = i & 31; const float inv = exp2f(-(float)idx * (13.287712379549449f / 32.0f)); const float ang = (float)pos * inv;
            rope[i] = cosf(ang); rope[2048 + i] = sinf(ang); } }
    { int t0 = bid, ts = G, t1 = 1 << 30; if (G == 256) { if (bid < 64) { ts = 64; t1 = 192; } else { t0 = 192 + (bid - 64); ts = 192; } }
      prep_weights(p, lds, 0, t0, ts, t1); }
}

template <int MODE>
__device__ __forceinline__ void phase_rows(const float* src_l, const float* src_c, int nrows, const float* g, const float* mod, int midx, bf16_t* outb, float* outf, const float* part,
                                           int rbase = -1, int rstride = 0) {
    const int wave = otid() >> 6, lane = otid() & 63;
    const int stride = rbase < 0 ? gridDim.x * 8 : rstride;
    for (int r0 = (rbase < 0 ? blockIdx.x * 8 : rbase) + wave; r0 < nrows; r0 += 2 * stride) {
        f32x4 v[2][8]; float ss[2] = {0.f, 0.f};
#pragma unroll
        for (int q = 0; q < 2; ++q) {
            const int r = r0 + q * stride;
            if (r < nrows) {
                const bool isctx = r >= NLAT; const float* xp = isctx ? src_c + (size_t)(r - NLAT) * DM : src_l + (size_t)r * DM;
#pragma unroll
                for (int k = 0; k < 8; ++k) v[q][k] = *(const f32x4*)(xp + (k * 64 + lane) * 4);
                if (isctx && part) {
                    const float* gt = mod + (size_t)(8 * NMOD + 2) * DM; const float* pp = part + (size_t)(r - NLAT) * DM;
#pragma unroll
                    for (int k = 0; k < 8; ++k) { const int c = (k * 64 + lane) * 4;
                        const f32x4 sum = (*(const f32x4*)(pp + c) + *(const f32x4*)(pp + (size_t)NCTX * DM + c)) + (*(const f32x4*)(pp + (size_t)2 * NCTX * DM + c) + *(const f32x4*)(pp + (size_t)3 * NCTX * DM + c));
                        v[q][k] += *(const f32x4*)(gt + c) * 0.5f * sum; }
                }
#pragma unroll
                for (int k = 0; k < 8; ++k) ss[q] += v[q][k][0] * v[q][k][0] + v[q][k][1] * v[q][k][1] + v[q][k][2] * v[q][k][2] + v[q][k][3] * v[q][k][3];
            }
        }
#pragma unroll
        for (int o = 32; o >= 1; o >>= 1) { ss[0] += __shfl_xor(ss[0], o); ss[1] += __shfl_xor(ss[1], o); }
#pragma unroll
        for (int q = 0; q < 2; ++q) {
            const int r = r0 + q * stride;
            if (r < nrows) {
                const float rs = rsqrtf(ss[q] * (1.0f / DM) + RMS_EPS);
                if (MODE == 0) {
                    const int b = r >= NLAT ? 8 : (r >> 11);
                    const float* sh = mod + (size_t)(b * NMOD + midx) * DM; const float* sc = sh + DM;
#pragma unroll
                    for (int k = 0; k < 8; ++k) { const int c = (k * 64 + lane) * 4; const f32x4 gg = *(const f32x4*)(g + c), s1 = *(const f32x4*)(sc + c), s0 = *(const f32x4*)(sh + c);
                        const f32x4 y = v[q][k] * rs * gg * (s1 + 1.0f) + s0; u32x2 w; w.x = cvt_pk_bf16(y[0], y[1]); w.y = cvt_pk_bf16(y[2], y[3]); *(u32x2*)(outb + (size_t)r * DM + c) = w; }
                } else {
#pragma unroll
                    for (int k = 0; k < 8; ++k) { const int c = (k * 64 + lane) * 4; const f32x4 gg = *(const f32x4*)(g + c); *(f32x4*)(outf + (size_t)r * DM + c) = v[q][k] * rs * gg; }
                }
            }
        }
    }
}

namespace att {
constexpr int D = 128, NW = 8, QBLK = 32, KVBLK = 64;
constexpr float SCALE = 0.088388347648318440f, THR = 8.f;
constexpr int LDQ = 1024, LDK = 256, LDO = 2048;
constexpr size_t SHM_V = KVBLK * D * 2, SHM_K = KVBLK * D * 2, SHM_ATTN = 2 * SHM_V + 2 * SHM_K + NW * 64 * 4;
#define KSWZ(row, colB) ((row) * 256 + ((colB) ^ (((row) & 7) << 4)))
#define SBAR() __builtin_amdgcn_sched_barrier(0)
__device__ __forceinline__ int crow(int r, int hi) { return (r & 3) + 8 * (r >> 2) + 4 * hi; }
__device__ __forceinline__ void partialSM(f32x16& p0, f32x16& p1, float& m_reg, float& mn, float& alpha) {
  constexpr float C = SCALE * 1.4426950408889634f;
  float pmax = p0[0]; for (int r = 1; r < 16; ++r) pmax = fmaxf(pmax, p0[r]); for (int r = 0; r < 16; ++r) pmax = fmaxf(pmax, p1[r]);
  { auto rr = __builtin_amdgcn_permlane32_swap(__float_as_uint(pmax), __float_as_uint(pmax), false, false);
    pmax = fmaxf(__uint_as_float(rr[0]), __uint_as_float(rr[1])); }
  if (__builtin_expect(__all(pmax - m_reg <= THR / SCALE), 1)) { mn = m_reg; alpha = 1.f; }
  else { mn = fmaxf(m_reg, pmax); alpha = __builtin_amdgcn_exp2f((m_reg - mn) * C); m_reg = mn; }
  float mnC = -mn * C;
  for (int r = 0; r < 16; ++r) p0[r] = fmaf(p0[r], C, mnC); for (int r = 0; r < 16; ++r) p1[r] = fmaf(p1[r], C, mnC);
  for (int r = 0; r < 16; ++r) p0[r] = __builtin_amdgcn_exp2f(p0[r]);
}
__device__ __forceinline__ void finishSM(f32x16& p0, f32x16& p1, float alpha, float& l_reg, bf16x8& pa0, bf16x8& pa1, bf16x8& pa2, bf16x8& pa3) {
  for (int r = 0; r < 16; ++r) p1[r] = __builtin_amdgcn_exp2f(p1[r]);
  float ps = 0; for (int r = 0; r < 16; ++r) ps += p0[r]; for (int r = 0; r < 16; ++r) ps += p1[r];
  { auto rr = __builtin_amdgcn_permlane32_swap(__float_as_uint(ps), __float_as_uint(ps), false, false);
    ps = __uint_as_float(rr[0]) + __uint_as_float(rr[1]); }
  l_reg = l_reg * alpha + ps;
#define PK4(P, BASE, OUT) do { unsigned a0 = cvt_pk_bf16(P[BASE + 0], P[BASE + 1]), a1 = cvt_pk_bf16(P[BASE + 2], P[BASE + 3]);   \
    unsigned b0 = cvt_pk_bf16(P[BASE + 4], P[BASE + 5]), b1 = cvt_pk_bf16(P[BASE + 6], P[BASE + 7]);                              \
    auto r0 = __builtin_amdgcn_permlane32_swap(a0, b0, false, false); auto r1 = __builtin_amdgcn_permlane32_swap(a1, b1, false, false); \
    u32x4 w = {r0[0], r1[0], r0[1], r1[1]}; OUT = *reinterpret_cast<bf16x8*>(&w); } while (0)
  PK4(p0, 0, pa0); PK4(p0, 8, pa1); PK4(p1, 0, pa2); PK4(p1, 8, pa3);
#undef PK4
}
__device__ __forceinline__ void qkt(f32x16& p0, f32x16& p1, const bf16_t* Ks, const bf16x8* qr, int r32, int hi) {
  p0 = f32x16{}; p1 = f32x16{};
  for (int d0 = 0; d0 < 8; ++d0) { int cb = (d0 * 16 + hi * 8) * 2;
    bf16x8 b0 = *reinterpret_cast<const bf16x8*>((const char*)Ks + KSWZ(r32, cb));
    bf16x8 b1 = *reinterpret_cast<const bf16x8*>((const char*)Ks + KSWZ(32 + r32, cb));
    p0 = __builtin_amdgcn_mfma_f32_32x32x16_bf16(b0, qr[d0], p0, 0, 0, 0);
    p1 = __builtin_amdgcn_mfma_f32_32x32x16_bf16(b1, qr[d0], p1, 0, 0, 0); }
}
__device__ __forceinline__ int v_st(int k, int c) { const int kk = (k & ~0xC) | ((k & 4) << 1) | ((k & 8) >> 1); return ((kk >> 3) * 4 + (c >> 5)) * 512 + ((kk & 7) * 32 + (c & 31)) * 2; }
__device__ __forceinline__ int v_rd_base(int lane) { return ((lane & 3) << 3) | (((lane >> 2) & 3) << 6) | (((lane >> 4) & 1) << 5) | (((lane >> 5) & 1) << 8); }
constexpr int v_rd_off(int d0, int ks, int half) { return d0 * 512 + ks * 4096 + half * 2048; }
template <int OFF> __device__ __forceinline__ s16x4 tr_read(int vb) {
  s16x4 r; asm volatile("ds_read_b64_tr_b16 %0, %1 offset:%2" : "=&v"(r) : "v"(vb), "i"(OFF) : "memory"); return r;
}
template <int D0> __device__ __forceinline__ void pv_one(f32x16& od, int vb, bf16x8 pa0, bf16x8 pa1, bf16x8 pa2, bf16x8 pa3) {
  const s16x4 l0 = tr_read<v_rd_off(D0, 0, 0)>(vb), h0 = tr_read<v_rd_off(D0, 0, 1)>(vb), l1 = tr_read<v_rd_off(D0, 1, 0)>(vb), h1 = tr_read<v_rd_off(D0, 1, 1)>(vb);
  const s16x4 l2 = tr_read<v_rd_off(D0, 2, 0)>(vb), h2 = tr_read<v_rd_off(D0, 2, 1)>(vb), l3 = tr_read<v_rd_off(D0, 3, 0)>(vb), h3 = tr_read<v_rd_off(D0, 3, 1)>(vb);
  asm volatile("s_waitcnt lgkmcnt(0)" ::: "memory"); SBAR();
#define PK(L, H) (bf16x8){L[0], L[1], L[2], L[3], H[0], H[1], H[2], H[3]}
  od = __builtin_amdgcn_mfma_f32_32x32x16_bf16(pa0, PK(l0, h0), od, 0, 0, 0);
  od = __builtin_amdgcn_mfma_f32_32x32x16_bf16(pa1, PK(l1, h1), od, 0, 0, 0);
  od = __builtin_amdgcn_mfma_f32_32x32x16_bf16(pa2, PK(l2, h2), od, 0, 0, 0);
  od = __builtin_amdgcn_mfma_f32_32x32x16_bf16(pa3, PK(l3, h3), od, 0, 0, 0);
#undef PK
}
__device__ __forceinline__ void pv_d0(f32x16* o, int vb, bf16x8 pa0, bf16x8 pa1, bf16x8 pa2, bf16x8 pa3) {
  pv_one<0>(o[0], vb, pa0, pa1, pa2, pa3); pv_one<1>(o[1], vb, pa0, pa1, pa2, pa3); pv_one<2>(o[2], vb, pa0, pa1, pa2, pa3); pv_one<3>(o[3], vb, pa0, pa1, pa2, pa3);
}
__device__ __forceinline__ void attn_dense_body(const bf16_t* __restrict__ Qb, const bf16_t* __restrict__ Kh, const bf16_t* __restrict__ Vh, bf16_t* __restrict__ Ob, int seq, char* lds) {
  const int tid = otid(), wid = tid >> 6, lane = tid & 63, r32 = lane & 31, hi = lane >> 5;
  bf16_t* V_lds = (bf16_t*)lds; bf16_t* K_lds = (bf16_t*)(lds + 2 * SHM_V);
  float* ws = (float*)(lds + 2 * SHM_V + 2 * SHM_K) + wid * 64; float* li_l = ws; float* al_l = ws + 32;
  float m_reg = -1e30f, l_reg = 0; f32x16 o[4] = {}; bf16x8 qr[8];
  const bf16_t* Qw = Qb + (long)(wid * QBLK + r32) * LDQ + hi * 8;
#pragma unroll
  for (int d0 = 0; d0 < 8; ++d0) qr[d0] = *reinterpret_cast<const bf16x8*>(Qw + d0 * 16);
  const int sr = tid >> 4, sc = (tid & 15) * 8, vst0 = v_st(sr, sc), vst1 = v_st(32 + sr, sc);
  const int vb0 = (int)(uintptr_t)V_lds + v_rd_base(lane);
  struct { bf16x8 vs0, vs1, ks0, ks1; } sr_[2];
#define SLOAD(i, k0) do { sr_[i].vs0 = *reinterpret_cast<const bf16x8*>(&Vh[(long)((k0) + sr) * LDK + sc]); sr_[i].vs1 = *reinterpret_cast<const bf16x8*>(&Vh[(long)((k0) + 32 + sr) * LDK + sc]); \
    sr_[i].ks0 = *reinterpret_cast<const bf16x8*>(&Kh[(long)((k0) + sr) * LDK + sc]); sr_[i].ks1 = *reinterpret_cast<const bf16x8*>(&Kh[(long)((k0) + 32 + sr) * LDK + sc]); } while (0)
#define SWRITE(b, i) do { *(bf16x8*)((char*)V_lds + (b) * SHM_V + vst0) = sr_[i].vs0;          \
    *(bf16x8*)((char*)V_lds + (b) * SHM_V + vst1) = sr_[i].vs1; int kc = sc * 2;               \
    *(bf16x8*)((char*)K_lds + (b) * SHM_K + KSWZ(sr, kc)) = sr_[i].ks0;                       \
    *(bf16x8*)((char*)K_lds + (b) * SHM_K + KSWZ(32 + sr, kc)) = sr_[i].ks1; } while (0)
#define SWAIT() asm volatile("s_waitcnt vmcnt(4)" ::: "memory")
#define RESC(a) do { if (__any((a) < 1.f)) { if (hi == 0) al_l[r32] = (a); asm volatile("s_waitcnt lgkmcnt(0)" ::: "memory"); \
    for (int d = 0; d < 4; ++d) for (int r = 0; r < 16; ++r) o[d][r] *= al_l[crow(r, hi)]; } } while (0)
  f32x16 pA0, pA1, pB0, pB1; float mnA, mnB, alA, alB; bf16x8 pa0, pa1, pa2, pa3; const int NT = seq / KVBLK;
  constexpr int SE = 0, SO = 1;
  SLOAD(SE, 0); asm volatile("s_waitcnt vmcnt(0)" ::: "memory"); SWRITE(0, SE); __syncthreads();
  qkt(pA0, pA1, K_lds, qr, r32, hi); partialSM(pA0, pA1, m_reg, mnA, alA);
  SLOAD(SO, KVBLK); if (2 < NT) SLOAD(SE, 2 * KVBLK);
  SWAIT(); SWRITE(1, SO); __syncthreads();
  for (int j = 1; j + 1 < NT; j += 2) {
    SBAR(); qkt(pB0, pB1, (bf16_t*)((char*)K_lds + SHM_K), qr, r32, hi);
    finishSM(pA0, pA1, alA, l_reg, pa0, pa1, pa2, pa3); SBAR();
    SLOAD(SO, (j + 2) * KVBLK); SBAR();
    pv_d0(o, vb0, pa0, pa1, pa2, pa3); partialSM(pB0, pB1, m_reg, mnB, alB);
    __syncthreads(); SWAIT(); SWRITE(0, SE);
    RESC(alB); __syncthreads();
    SBAR(); qkt(pA0, pA1, K_lds, qr, r32, hi);
    finishSM(pB0, pB1, alB, l_reg, pa0, pa1, pa2, pa3); SBAR();
    if (j + 3 < NT) SLOAD(SE, (j + 3) * KVBLK); SBAR();
    pv_d0(o, vb0 + (int)SHM_V, pa0, pa1, pa2, pa3); partialSM(pA0, pA1, m_reg, mnA, alA);
    __syncthreads(); SWAIT(); SWRITE(1, SO);
    RESC(alA); __syncthreads();
  }
  SBAR(); qkt(pB0, pB1, (bf16_t*)((char*)K_lds + SHM_K), qr, r32, hi);
  finishSM(pA0, pA1, alA, l_reg, pa0, pa1, pa2, pa3); SBAR();
  pv_d0(o, vb0, pa0, pa1, pa2, pa3); partialSM(pB0, pB1, m_reg, mnB, alB);
  __syncthreads(); RESC(alB);
  finishSM(pB0, pB1, alB, l_reg, pa0, pa1, pa2, pa3); SBAR();
  pv_d0(o, vb0 + (int)SHM_V, pa0, pa1, pa2, pa3);
  if (hi == 0) li_l[r32] = l_reg; asm volatile("s_waitcnt lgkmcnt(0)" ::: "memory");
  float rli[16];
#pragma unroll
  for (int r = 0; r < 16; ++r) rli[r] = __builtin_amdgcn_rcpf(li_l[crow(r, hi)]);
  bf16_t* Ow = Ob + (long)(wid * QBLK) * LDO;
#pragma unroll
  for (int r = 0; r < 16; ++r) { int orow = crow(r, hi);
    for (int d0 = 0; d0 < 4; ++d0) Ow[(long)orow * LDO + d0 * 32 + r32] = (bf16_t)(cvt_pk_bf16(o[d0][r] * rli[r], 0.f) & 0xffffu); }
#undef SLOAD
#undef SWRITE
#undef SWAIT
#undef RESC
}
}

__device__ __forceinline__ void attn_unit(const Params& p, unsigned char* lds_generic, int u) {
    const int qb = u & 7, g = (u >> 3) & 3, kvh = (u >> 5) & 1, b = u >> 6, hq = kvh * 4 + g;
    const bf16_t* Q = (const bf16_t*)(p.ws + WS_Q) + ((size_t)(b * TL + qb * 256)) * 1024 + hq * 128;
    const bf16_t* K = (const bf16_t*)(p.ws + WS_K) + (size_t)b * SKV * 256 + kvh * 128;
    const bf16_t* V = (const bf16_t*)(p.ws + WS_V) + (size_t)b * SKV * 256 + kvh * 128;
    bf16_t* O = (bf16_t*)(p.ws + WS_ATT) + ((size_t)(b * TL + qb * 256)) * 2048 + hq * 128;
    __syncthreads();
    att::attn_dense_body(Q, K, V, O, SKV, (char*)lds_generic);
}

__device__ __forceinline__ int jsw(int r, int c) { return r * 64 + ((((c) >> 3) ^ ((r ^ (r >> 3)) & 7)) << 3) + (c & 7); }
#define DPPF(idv, v, ctrl, rowmask) __builtin_bit_cast(float, __builtin_amdgcn_update_dpp(__builtin_bit_cast(int, (float)(idv)), __builtin_bit_cast(int, (float)(v)), ctrl, rowmask, 0xf, false))
__device__ __forceinline__ f32x4 mfma16(bf16x8 a, bf16x8 b, f32x4 c) { return __builtin_amdgcn_mfma_f32_16x16x32_bf16(a, b, c, 0, 0, 0); }
__device__ __forceinline__ void mlstm_stream(const Params& p, LAS unsigned char* lds, int sid) {
    const int tid = otid(), w = __builtin_amdgcn_readfirstlane(tid >> 6), lane = tid & 63, fr = lane & 15, fq = lane >> 4;
    const int dir = sid & 1, h = (sid >> 1) & 7, b = sid >> 4;
    LAS bf16_t* Qs = (LAS bf16_t*)(lds + ML_QS); LAS bf16_t* Ks = (LAS bf16_t*)(lds + ML_KS); LAS bf16_t* KT = (LAS bf16_t*)(lds + ML_KT);
    LAS bf16_t* VT = (LAS bf16_t*)(lds + ML_VT); LAS bf16_t* Ps = (LAS bf16_t*)(lds + ML_PS); LAS bf16_t* C0 = (LAS bf16_t*)(lds + ML_C0);
    LAS float* sc_u = (LAS float*)(lds + ML_SC); LAS float* sc_pm = sc_u + 64; LAS float* sc_a = sc_u + 128; LAS float* sc_e = sc_u + 192;
    LAS float* cw = (LAS float*)(lds + ML_CW); LAS float* cbv = (LAS float*)(lds + ML_CB);
    const bf16_t* MQK = (const bf16_t*)(p.ws + WS_MQK); const bf16_t* MV = (const bf16_t*)(p.ws + WS_MV); const float* GT = (const float*)(p.ws + WS_GT);
    bf16_t* HO = (bf16_t*)(p.ws + WS_H) + (size_t)dir * NLAT * 1024;
    const int cg8 = (tid & 15) * 8, rg = tid >> 4, tl0 = 2 * rg;
    const int i0 = dir ? 63 - tl0 : tl0, i1 = dir ? i0 - 1 : i0 + 1, ie = dir ? i1 : i0;
    __syncthreads();
    for (int i = tid; i < 16 * 64; i += 512) VT[128 * 64 + i] = 0x3F80;
    for (int i = tid; i < 5 * 256; i += 512) { const int j = i >> 8, c = i & 255; cw[i] = p.conv_w[j * 2048 + (c < 128 ? h * 128 + c : 1024 + h * 128 + (c - 128))]; }
    for (int i = tid; i < 256; i += 512) cbv[i] = p.conv_b[i < 128 ? h * 128 + i : 1024 + h * 128 + (i - 128)];
    f32x4 C[9];
#pragma unroll
    for (int i = 0; i < 9; ++i) C[i] = (f32x4){0.f, 0.f, 0.f, 0.f};
    float m0 = 0.f;
    bf16x8 xq[6], xk[6], xv0, xv1; float g_ig, g_lf;
#define ML_CHUNK(ci_, lat_, chunk_, TS_, rbase_, t0_) const bool lat_ = (ci_) >= 4; const int chunk_ = lat_ ? (dir ? 35 - (ci_) : (ci_) - 4) : (dir ? 3 - (ci_) : (ci_)); \
        const int TS_ = lat_ ? TL : TCX; const size_t rbase_ = lat_ ? (size_t)b * TL : (size_t)NLAT + (size_t)b * TCX; const int t0_ = chunk_ * 64;
#define ML_LOAD(ci_) do { ML_CHUNK(ci_, l_, c_, ts_, rb_, t_) \
        { const int tl = dir ? 63 - lane : lane; const size_t row = rb_ + t_ + tl; g_ig = GT[row * 32 + dir * 16 + h]; g_lf = GT[row * 32 + dir * 16 + 8 + h]; } \
        _Pragma("unroll") for (int rr = 0; rr < 6; ++rr) { const int sl = t_ + tl0 - 2 + rr; xq[rr] = (bf16x8){0, 0, 0, 0, 0, 0, 0, 0}; xk[rr] = xq[rr]; \
            if (sl >= 0 && sl < ts_) { const bf16_t* src = MQK + (rb_ + sl) * 2048 + h * 128 + cg8; xq[rr] = *(const bf16x8*)src; xk[rr] = *(const bf16x8*)(src + 1024); } } \
        xv0 = *(const bf16x8*)(MV + (rb_ + t_ + tl0) * 1024 + h * 128 + cg8); xv1 = *(const bf16x8*)(MV + (rb_ + t_ + tl0 + 1) * 1024 + h * 128 + cg8); } while (0)
    ML_LOAD(0);
    __syncthreads();
    for (int ci = 0; ci < 36; ++ci) {
        ML_CHUNK(ci, lat, chunk, TS, rbase, t0)
        (void)TS;
        float wgt, decay, m0n;
        {
            float bc = g_lf;
            bc += DPPF(0.f, bc, 0x111, 0xf); bc += DPPF(0.f, bc, 0x112, 0xf); bc += DPPF(0.f, bc, 0x114, 0xf); bc += DPPF(0.f, bc, 0x118, 0xf);
            bc += DPPF(0.f, bc, 0x142, 0xa); bc += DPPF(0.f, bc, 0x143, 0xc);
            const float uu = g_ig - bc; float px = uu;
            px = fmaxf(px, DPPF(-INFINITY, px, 0x111, 0xf)); px = fmaxf(px, DPPF(-INFINITY, px, 0x112, 0xf)); px = fmaxf(px, DPPF(-INFINITY, px, 0x114, 0xf)); px = fmaxf(px, DPPF(-INFINITY, px, 0x118, 0xf));
            px = fmaxf(px, DPPF(-INFINITY, px, 0x142, 0xa)); px = fmaxf(px, DPPF(-INFINITY, px, 0x143, 0xc));
            const float pm = fmaxf(m0, px);
            const float bL = __builtin_bit_cast(float, __builtin_amdgcn_readlane(__builtin_bit_cast(int, bc), 63)), pmL = __builtin_bit_cast(float, __builtin_amdgcn_readlane(__builtin_bit_cast(int, pm), 63));
            wgt = __expf(uu - pmL); decay = __expf(m0 - pmL); m0n = bL + pmL;
            if (w == 0) { sc_u[lane] = uu; sc_pm[lane] = pm; sc_a[lane] = __expf(m0 - pm); sc_e[lane] = __expf(-bc - pm); }
        }
        {
            const float w0 = __shfl(wgt, i0), w1 = __shfl(wgt, i1);
#pragma unroll
            for (int qk = 0; qk < 2; ++qk) {
                float y0[8], y1[8];
#pragma unroll
                for (int e = 0; e < 8; ++e) { y0[e] = cbv[qk * 128 + cg8 + e]; y1[e] = y0[e]; }
#pragma unroll
                for (int j = 0; j < 5; ++j) {
                    const f32x4 wa = *(const LAS f32x4*)(cw + j * 256 + qk * 128 + cg8), wb = *(const LAS f32x4*)(cw + j * 256 + qk * 128 + cg8 + 4);
#pragma unroll
                    for (int e = 0; e < 8; ++e) { const float wv = e < 4 ? wa[e] : wb[e - 4]; const bf16x8 xa = qk ? xk[j] : xq[j], xb = qk ? xk[j + 1] : xq[j + 1];
                        y0[e] += wv * bf2f((unsigned short)xa[e]); y1[e] += wv * bf2f((unsigned short)xb[e]); }
                }
                const float ksc = qk ? 0.08838834764831845f : 1.0f;
#pragma unroll
                for (int e = 0; e < 8; ++e) { y0[e] = silu_f(y0[e]) * ksc; y1[e] = silu_f(y1[e]) * ksc; }
                LAS bf16_t* dst = qk ? Ks : Qs;
                u32x4 p0, p1; p0.x = cvt_pk_bf16(y0[0], y0[1]); p0.y = cvt_pk_bf16(y0[2], y0[3]); p0.z = cvt_pk_bf16(y0[4], y0[5]); p0.w = cvt_pk_bf16(y0[6], y0[7]);
                p1.x = cvt_pk_bf16(y1[0], y1[1]); p1.y = cvt_pk_bf16(y1[2], y1[3]); p1.z = cvt_pk_bf16(y1[4], y1[5]); p1.w = cvt_pk_bf16(y1[6], y1[7]);
                *(LAS u32x4*)(dst + i0 * QS_LD + cg8) = p0; *(LAS u32x4*)(dst + i1 * QS_LD + cg8) = p1;
                if (qk) {
#pragma unroll
                    for (int e = 0; e < 8; ++e) { const float a0 = y0[e] * w0, a1 = y1[e] * w1; *(LAS unsigned*)(KT + jsw(cg8 + e, ie)) = dir ? cvt_pk_bf16(a1, a0) : cvt_pk_bf16(a0, a1); }
                }
            }
#pragma unroll
            for (int e = 0; e < 8; ++e) { const unsigned lo = (unsigned short)(dir ? xv1[e] : xv0[e]), hi = (unsigned short)(dir ? xv0[e] : xv1[e]); *(LAS unsigned*)(VT + jsw(cg8 + e, ie)) = lo | (hi << 16); }
        }
        if (ci + 1 < 36) ML_LOAD(ci + 1);
        __syncthreads();
        if (lat) {
            const int it = w >> 1;
#pragma unroll
            for (int jj = 0; jj < 2; ++jj) {
                const int jt = (w & 1) * 2 + jj;
                f32x4 s = (f32x4){0.f, 0.f, 0.f, 0.f};
                if (jt <= it) {
#pragma unroll
                    for (int ks = 0; ks < 4; ++ks) { const bf16x8 a = *(const LAS bf16x8*)(Ks + (jt * 16 + fr) * QS_LD + ks * 32 + fq * 8), bb = *(const LAS bf16x8*)(Qs + (it * 16 + fr) * QS_LD + ks * 32 + fq * 8); s = mfma16(a, bb, s); }
                    const int i = it * 16 + fr, j0 = jt * 16 + 4 * fq; const float pmi = sc_pm[i]; const f32x4 uj = *(const LAS f32x4*)(sc_u + j0);
#pragma unroll
                    for (int r = 0; r < 4; ++r) s[r] = (j0 + r <= i) ? s[r] * __expf(uj[r] - pmi) : 0.f;
                }
                u32x2 pw; pw.x = cvt_pk_bf16(s[0], s[1]); pw.y = cvt_pk_bf16(s[2], s[3]);
                *(LAS u32x2*)(Ps + (it * 16 + fr) * JS_LD + jt * 16 + 4 * fq) = pw;
            }
#pragma unroll
            for (int nt = 0; nt < 9; ++nt) { u32x2 cwd; cwd.x = cvt_pk_bf16(C[nt][0], C[nt][1]); cwd.y = cvt_pk_bf16(C[nt][2], C[nt][3]); *(LAS u32x2*)(C0 + (nt * 16 + fr) * QS_LD + w * 16 + 4 * fq) = cwd; }
        }
        {
            const bf16x8 a0 = *(const LAS bf16x8*)(KT + jsw(w * 16 + fr, fq * 8)), a1 = *(const LAS bf16x8*)(KT + jsw(w * 16 + fr, 32 + fq * 8));
#pragma unroll
            for (int nt = 0; nt < 9; ++nt) { C[nt] *= decay;
                C[nt] = mfma16(a0, *(const LAS bf16x8*)(VT + jsw(nt * 16 + fr, fq * 8)), C[nt]); C[nt] = mfma16(a1, *(const LAS bf16x8*)(VT + jsw(nt * 16 + fr, 32 + fq * 8)), C[nt]); }
        }
        __syncthreads();
        if (lat) {
            const int it = w >> 1, dvh = w & 1, i = it * 16 + fr;
            f32x4 ac[5];
#pragma unroll
            for (int t = 0; t < 5; ++t) ac[t] = (f32x4){0.f, 0.f, 0.f, 0.f};
#pragma unroll
            for (int ks = 0; ks < 4; ++ks) { const bf16x8 bq = *(const LAS bf16x8*)(Qs + i * QS_LD + ks * 32 + fq * 8);
#pragma unroll
                for (int t = 0; t < 5; ++t) { const int row = (t < 4 ? (dvh * 4 + t) * 16 : 128) + fr; ac[t] = mfma16(*(const LAS bf16x8*)(C0 + row * QS_LD + ks * 32 + fq * 8), bq, ac[t]); } }
            const float ai = sc_a[i];
#pragma unroll
            for (int t = 0; t < 5; ++t) ac[t] *= ai;
#pragma unroll
            for (int ks = 0; ks < 2; ++ks) { const bf16x8 bp = *(const LAS bf16x8*)(Ps + i * JS_LD + ks * 32 + fq * 8);
#pragma unroll
                for (int t = 0; t < 5; ++t) { const int row = (t < 4 ? (dvh * 4 + t) * 16 : 128) + fr; ac[t] = mfma16(*(const LAS bf16x8*)(VT + jsw(row, ks * 32 + fq * 8)), bp, ac[t]); } }
            const float den = fmaxf(fabsf(ac[4][0]), sc_e[i]); const float rd = 1.0f / den;
            const size_t row = rbase + t0 + (dir ? 63 - i : i);
#pragma unroll
            for (int t = 0; t < 4; ++t) { u32x2 hw; hw.x = cvt_pk_bf16(ac[t][0] * rd, ac[t][1] * rd); hw.y = cvt_pk_bf16(ac[t][2] * rd, ac[t][3] * rd);
                *(u32x2*)(HO + row * 1024 + h * 128 + (dvh * 4 + t) * 16 + 4 * fq) = hw; }
        }
        m0 = m0n;
        __syncthreads();
    }
#undef ML_LOAD
#undef ML_CHUNK
}

__device__ __forceinline__ void phase_combine(const Params& p) {
    const bf16_t* HF = (const bf16_t*)(p.ws + WS_H); const bf16_t* HB = HF + (size_t)NLAT * 1024; const bf16_t* MO = (const bf16_t*)(p.ws + WS_MO);
    bf16_t* AT = (bf16_t*)(p.ws + WS_ATT);
    const int tid = otid(), c8 = (tid & 127) * 8, rq = tid >> 7;
    f32x4 g0 = *(const f32x4*)(p.m_gain + c8), g1 = *(const f32x4*)(p.m_gain + c8 + 4);
    for (int r = blockIdx.x * 4 + rq; r < NLAT; r += gridDim.x * 4) {
        const bf16x8 a = *(const bf16x8*)(HF + (size_t)r * 1024 + c8), bb = *(const bf16x8*)(HB + (size_t)r * 1024 + c8), mo = *(const bf16x8*)(MO + (size_t)r * 1024 + c8);
        float x[8], ss = 0.f;
#pragma unroll
        for (int e = 0; e < 8; ++e) { x[e] = bf2f((unsigned short)a[e]) + bf2f((unsigned short)bb[e]); ss += x[e] * x[e]; }
        ss += __shfl_xor(ss, 1); ss += __shfl_xor(ss, 2); ss += __shfl_xor(ss, 4); ss += __shfl_xor(ss, 8);
        const float rs = rsqrtf(ss * (1.0f / 128.0f) + RMS_EPS);
        float y[8];
#pragma unroll
        for (int e = 0; e < 8; ++e) y[e] = x[e] * rs * (e < 4 ? g0[e] : g1[e - 4]) * bf2f((unsigned short)mo[e]);
        u32x4 wv; wv.x = cvt_pk_bf16(y[0], y[1]); wv.y = cvt_pk_bf16(y[2], y[3]); wv.z = cvt_pk_bf16(y[4], y[5]); wv.w = cvt_pk_bf16(y[6], y[7]);
        *(u32x4*)(AT + (size_t)r * 2048 + 1024 + c8) = wv;
    }
}

__device__ __forceinline__ void combine_item(const Params& p, int b, int h, int t0) {
    const bf16_t* HF = (const bf16_t*)(p.ws + WS_H); const bf16_t* HB = HF + (size_t)NLAT * 1024; const bf16_t* MO = (const bf16_t*)(p.ws + WS_MO);
    bf16_t* AT = (bf16_t*)(p.ws + WS_ATT);
    const int tid = otid(), c8 = (tid & 15) * 8, tr = tid >> 4;
    const f32x4 g0 = *(const f32x4*)(p.m_gain + h * 128 + c8), g1 = *(const f32x4*)(p.m_gain + h * 128 + c8 + 4);
    for (int it = 0; it < 16; it += 4) {
        bf16x8 a[4], bb[4], mo[4];
#pragma unroll
        for (int q = 0; q < 4; ++q) { const size_t r = (size_t)b * TL + t0 + (it + q) * 32 + tr; const size_t o = r * 1024 + h * 128 + c8;
            a[q] = *(const bf16x8*)(HF + o); bb[q] = *(const bf16x8*)(HB + o); mo[q] = *(const bf16x8*)(MO + o); }
#pragma unroll
        for (int q = 0; q < 4; ++q) {
            float x[8], ss = 0.f;
#pragma unroll
            for (int e = 0; e < 8; ++e) { x[e] = bf2f((unsigned short)a[q][e]) + bf2f((unsigned short)bb[q][e]); ss += x[e] * x[e]; }
            ss += __shfl_xor(ss, 1); ss += __shfl_xor(ss, 2); ss += __shfl_xor(ss, 4); ss += __shfl_xor(ss, 8);
            const float rs = rsqrtf(ss * (1.0f / 128.0f) + RMS_EPS);
            float y[8];
#pragma unroll
            for (int e = 0; e < 8; ++e) y[e] = x[e] * rs * (e < 4 ? g0[e] : g1[e - 4]) * bf2f((unsigned short)mo[q][e]);
            u32x4 wv; wv.x = cvt_pk_bf16(y[0], y[1]); wv.y = cvt_pk_bf16(y[2], y[3]); wv.z = cvt_pk_bf16(y[4], y[5]); wv.w = cvt_pk_bf16(y[6], y[7]);
            const size_t r = (size_t)b * TL + t0 + (it + q) * 32 + tr;
            *(u32x4*)(AT + r * 2048 + 1024 + h * 128 + c8) = wv;
        }
    }
}

#define XB_TMO      128
#define XB_XCNT(j)  (256  + 64 * (j))
#define XB_XSUB(j)  (1280 + 64 * (j))
#define XB_XGEN(j)  (2304 + 64 * (j))
#define XB_TOP      3328
#define XB_TOPGEN   3392
#define XCD_BAR_WORDS 3456
#define XB_SPIN_CAP (1u << 22)
__device__ __forceinline__ unsigned xb_ld(unsigned* p)              { return __hip_atomic_load(p, __ATOMIC_RELAXED, __HIP_MEMORY_SCOPE_AGENT); }
__device__ __forceinline__ unsigned xb_add(unsigned* p, unsigned v) { return __hip_atomic_fetch_add(p, v, __ATOMIC_RELAXED, __HIP_MEMORY_SCOPE_AGENT); }
__device__ __forceinline__ unsigned xb_xcc_id() { return (unsigned)__builtin_amdgcn_s_getreg((3 << 11) | 20) & 0xFu; }
#define XB_SPIN(cond, bar) do { unsigned _sp = 0; while (cond) { __builtin_amdgcn_s_sleep(1); \
    if ((++_sp & 255u) == 0u) { if (xb_ld(&(bar)[XB_TMO])) break; if (_sp > XB_SPIN_CAP) { atomicAdd(&(bar)[XB_TMO], 1u); break; } } } } while (0)
struct XcdBarrier { unsigned* bar; unsigned x; volatile LAS unsigned* st; };
__device__ __forceinline__ XcdBarrier xcd_barrier_post(unsigned* bar, volatile LAS unsigned* st) {
    XcdBarrier b; b.bar = bar; b.x = xb_xcc_id(); b.st = st;
    if (threadIdx.x == 0) (void)xb_add(&bar[XB_XCNT(b.x)], 1u);
    return b;
}
__device__ __forceinline__ void xcd_barrier_complete(unsigned* bar, unsigned x, unsigned& nloc, unsigned& nx) {
    const unsigned G = gridDim.x * gridDim.y * gridDim.z;
    unsigned sum, cnt, mine, sp = 0u;
    for (;;) {
        sum = 0u; cnt = 0u; mine = 0u;
#pragma unroll
        for (unsigned j = 0; j < 16; ++j) { const unsigned c = xb_ld(&bar[XB_XCNT(j)]); sum += c; cnt += (c > 0u) ? 1u : 0u; mine = (j == x) ? c : mine; }
        if (sum == G) break;
        __builtin_amdgcn_s_sleep(1);
        if ((++sp & 255u) == 0u) { if (xb_ld(&bar[XB_TMO])) break; if (sp > XB_SPIN_CAP) { atomicAdd(&bar[XB_TMO], 1u); break; } }
    }
    nloc = mine > 0u ? mine : 1u; nx = cnt > 0u ? cnt : 1u;
}
__device__ __forceinline__ void xcd_barrier(const XcdBarrier& b) {
    asm volatile("s_waitcnt vmcnt(0)" ::: "memory");
    __syncthreads();
    if (threadIdx.x == 0) {
        unsigned* bar = b.bar;
        __builtin_amdgcn_s_waitcnt(0);
        unsigned nloc = b.st[0], nx = b.st[1];
        if (nloc == 0u) { xcd_barrier_complete(bar, b.x, nloc, nx); b.st[0] = nloc; b.st[1] = nx; }
        const unsigned old = xb_add(&bar[XB_XSUB(b.x)], 1u);
        const unsigned gen = old / nloc;
        if (old + 1u == (gen + 1u) * nloc) {
            __builtin_amdgcn_fence(__ATOMIC_RELEASE, "agent");
            asm volatile("s_waitcnt vmcnt(0)" ::: "memory");
            const unsigned og = xb_add(&bar[XB_TOP], 1u);
            const unsigned tg = og / nx;
            if (og + 1u == (tg + 1u) * nx) xb_add(&bar[XB_TOPGEN], 1u);
            else XB_SPIN(xb_ld(&bar[XB_TOPGEN]) == tg, bar);
            __builtin_amdgcn_fence(__ATOMIC_ACQUIRE, "agent");
            xb_add(&bar[XB_XGEN(b.x)], 1u);
            asm volatile("s_waitcnt vmcnt(0)" ::: "memory");
        } else {
            XB_SPIN(xb_ld(&bar[XB_XGEN(b.x)]) == gen, bar);
            __builtin_amdgcn_fence(__ATOMIC_ACQUIRE, "agent");
            asm volatile("s_waitcnt vmcnt(0)" ::: "memory");
        }
    }
    __syncthreads();
}

__device__ __forceinline__ void panel_handoff(unsigned* cnt, unsigned need) {
    asm volatile("s_waitcnt vmcnt(0)" ::: "memory"); __syncthreads();
    if (threadIdx.x == 0) {
        __builtin_amdgcn_fence(__ATOMIC_RELEASE, "agent"); asm volatile("s_waitcnt vmcnt(0)" ::: "memory");
        (void)__hip_atomic_fetch_add(cnt, 1u, __ATOMIC_RELAXED, __HIP_MEMORY_SCOPE_AGENT);
        unsigned sp = 0u; while (__hip_atomic_load(cnt, __ATOMIC_RELAXED, __HIP_MEMORY_SCOPE_AGENT) < need) { __builtin_amdgcn_s_sleep(1); if (++sp > (1u << 22)) break; }
        __builtin_amdgcn_fence(__ATOMIC_ACQUIRE, "agent"); asm volatile("s_waitcnt vmcnt(0)" ::: "memory");
    }
    __syncthreads();
}

__global__ void __launch_bounds__(512, 2) fwd_megakernel(Params p0) {
    extern __shared__ __attribute__((aligned(16))) unsigned char lds_raw[];
    LAS unsigned char* lds = (LAS unsigned char*)lds_raw;
    if (threadIdx.x < 16) ((LAS unsigned*)(lds + LDS_CTL))[threadIdx.x] = 0u;
    __syncthreads();
    XcdBarrier xbar; xbar.bar = (unsigned*)(p0.ws + WS_BAR); xbar.x = 0; xbar.st = (volatile LAS unsigned*)(lds + LDS_CTL + 16);
    if (p0.ph_hi - p0.ph_lo > 1) xbar = xcd_barrier_post((unsigned*)(p0.ws + WS_BAR), (volatile LAS unsigned*)(lds + LDS_CTL + 16));
    for (int ph = p0.ph_lo; ph < p0.ph_hi; ++ph) {
#if defined(__HIP_DEVICE_COMPILE__)
        const __attribute__((address_space(4))) Params* pp = (const __attribute__((address_space(4))) Params*)__builtin_amdgcn_kernarg_segment_ptr();
        asm volatile("" : "+s"(pp));
        const Params p = *pp;
        int G = gridDim.x, bid = blockIdx.x; asm volatile("" : "+s"(G), "+s"(bid));
#else
        const Params p = p0; int G = 0, bid = 0;
#endif
        unsigned char* ws = p.ws;
        float* mod = (float*)(ws + WS_MOD);
        const bool fuse = (G == 256) && (p0.ph_hi - p0.ph_lo > 1);
        if (fuse && (ph == 4 || ph == 7 || ph == 9 || ph == 12)) continue;
        for (int rep = 0; rep < (((DUPMASK >> ph) & 1) ? 2 : 1); ++rep)
        if (HAS(0) && ph == 0) {
            phase_prep(p, lds, rep == 0);
        } else if (HAS(1) && (ph == 1 || ph == 4 || ph == 9)) {
            const float* sl = ph == 1 ? p.x : p.out; const float* scx = p.ctx;
            const int nrows = ph == 9 ? NLAT : MR, midx = ph == 1 ? 0 : (ph == 4 ? 3 : 6);
            if (fuse && ph == 4)
                phase_rows<0>(sl, scx, MR, p.g_norm + DM, mod, 3, (bf16_t*)(ws + WS_H), nullptr, (const float*)(ws + WS_PART), NLAT + bid * 8, G * 8);
            else
            phase_rows<0>(sl, scx, nrows, p.g_norm + (ph == 1 ? 0 : (ph == 4 ? 1 : 2)) * DM, mod, midx, (bf16_t*)(ws + WS_H), nullptr, ph == 4 ? (const float*)(ws + WS_PART) : nullptr);
        } else if (HAS(2) && (ph == 2 || ph == 10)) {
            pg8::Gemm g{(const bf16_t*)(ws + WS_H), (const bf16_t*)(ws + (ph == 2 ? WS_WUP1 : WS_WUP2)), ph == 2 ? MR : NLAT, NUP, DM, DM, 0};
            pg8::StaticOrder S; S.init(g.M, g.N, G, bid);
            EpiSwiglu E{(bf16_t*)(ws + WS_HID)};
            pg8::gemm_phase<EpiSwiglu>(lds, g, S, E);
            if (ph == 2) { const int busy = S.nwg % G; if (busy != 0 && bid >= busy) prep_weights(p, lds, 1, bid - busy, G - busy); else if (busy == 0) prep_weights(p, lds, 1, bid, G); }
        } else if (HAS(3) && (ph == 3 || ph == 8 || ph == 11)) {
            pg8::Gemm g;
            if (ph == 3) g = pg8::Gemm{(const bf16_t*)(ws + WS_HID), (const bf16_t*)(ws + WS_WDN1), NLAT, DM, DFF, DFF, 1};
            else if (ph == 8) g = pg8::Gemm{(const bf16_t*)(ws + WS_ATT), (const bf16_t*)(ws + WS_WOUT), NLAT, DM, DM, DM, 0};
            else g = pg8::Gemm{(const bf16_t*)(ws + WS_HID), (const bf16_t*)(ws + WS_WDN2), NLAT, DM, DFF, DFF, 1};
            pg8::StaticOrder S; S.init(g.M, g.N, G, bid);
            EpiResid E{ph == 3 ? p.x : p.out, p.ctx, p.out, nullptr, mod, ph == 3 ? 2 : (ph == 8 ? 5 : 8), ph == 8 ? 1.0f : 0.5f};
            pg8::gemm_phase<EpiResid>(lds, g, S, E);
            if (fuse) {
                pg8::Unit u0; S.next(0, u0);
                unsigned* cnt = (unsigned*)(ws + WS_PCNT) + ((ph == 3 ? 0 : (ph == 8 ? 1 : 2)) * 64 + u0.pm) * 64;
                panel_handoff(cnt, 4u);
                const int r0 = u0.pm * 256 + (u0.pn & 3) * 64;
                if (ph == 11) phase_rows<1>(p.out, nullptr, r0 + 64, p.g_final, nullptr, 0, nullptr, p.out, nullptr, r0, 8);
                else phase_rows<0>(p.out, nullptr, r0 + 64, p.g_norm + (ph == 3 ? 1 : 2) * DM, mod, ph == 3 ? 3 : 6, (bf16_t*)(ws + WS_H), nullptr, nullptr, r0, 8);
            }
            if (ph == 3) {
                pg8::Gemm g2{(const bf16_t*)(ws + WS_HID), (const bf16_t*)(ws + WS_WDN1), NCTX, DM, DFF / 4, DFF, 1};
                pg8::StaticOrder S2; S2.init(NCTX, DM, G, bid, 64, 4);
                EpiPartial E2{(float*)(ws + WS_PART)};
                pg8::gemm_phase<EpiPartial>(lds, g2, S2, E2);
                if (fuse) {
                    pg8::Unit u2; S2.next(0, u2);
                    panel_handoff((unsigned*)(ws + WS_PCNT) + (4 * 64 + (u2.pm - 64)) * 64, 32u);
                    const int rc = NLAT + (u2.pm - 64) * 256 + (u2.ks * 8 + u2.pn) * 8;
                    phase_rows<0>(p.out, p.ctx, rc + 8, p.g_norm + DM, mod, 3, (bf16_t*)(ws + WS_H), nullptr, (const float*)(ws + WS_PART), rc, 8);
                }
            }
        } else if (HAS(5) && ph == 5) {
            pg8::Gemm g{(const bf16_t*)(ws + WS_H), (const bf16_t*)(ws + WS_WIN), MR, PWP, DM, DM, 0};
            pg8::StaticOrder S; S.init(g.M, g.N, G, bid);
            EpiWin E{(bf16_t*)(ws + WS_Q), (bf16_t*)(ws + WS_K), (bf16_t*)(ws + WS_V), (bf16_t*)(ws + WS_MQK), (bf16_t*)(ws + WS_MV), (bf16_t*)(ws + WS_MO), (float*)(ws + WS_GT),
                     p.q_gain, p.k_gain, p.gate_b, (const float*)(ws + WS_ROPE), (LAS float*)(lds + LDS_RED)};
            pg8::gemm_phase<EpiWin>(lds, g, S, E);
            { const int busy = S.nwg % G; if (busy != 0 && bid >= busy) prep_weights(p, lds, 2, bid - busy, G - busy); else if (busy == 0) prep_weights(p, lds, 2, bid, G); }
        } else if (HAS(6) && ph == 6) {
#if !defined(NO_MLSTM)
            for (int s = bid; s < 128 && rep == 0; s += G) { mlstm_stream(p, lds, s);
                if (fuse) {
                    asm volatile("s_waitcnt vmcnt(0)" ::: "memory"); __syncthreads();
                    if (otid() == 0) { __builtin_amdgcn_fence(__ATOMIC_RELEASE, "agent"); asm volatile("s_waitcnt vmcnt(0)" ::: "memory");
                        (void)__hip_atomic_fetch_add((unsigned*)(ws + WS_PCNT) + (3 * 64 + (s >> 1)) * 64, 1u, __ATOMIC_RELAXED, __HIP_MEMORY_SCOPE_AGENT); } } }
#endif
#if !defined(NO_ATTN)
            {
                int* ctr = (int*)(ws + WS_CTR) + rep * 8;
                for (int qi = 0; qi < 8; ++qi) {
                    const int bq = (bid + qi) & 7;
                    for (;;) {
                        __syncthreads();
                        if (otid() == 0) { int v = __hip_atomic_load(ctr + bq, __ATOMIC_RELAXED, __HIP_MEMORY_SCOPE_AGENT); if (v < 64) v = atomicAdd(ctr + bq, 1); *(LAS int*)(lds + LDS_CTL) = v; }
                        __syncthreads();
                        const int u = *(LAS int*)(lds + LDS_CTL);
                        if (u >= 64) break;
                        attn_unit(p, lds_raw, bq * 64 + u);
                    }
                }
            }
#endif
            if (fuse) {
                unsigned* pc = (unsigned*)(ws + WS_PCNT);
                for (;;) {
                    __syncthreads();
                    if (otid() == 0) { unsigned v = __hip_atomic_fetch_add(pc + 5 * 64 * 64, 1u, __ATOMIC_RELAXED, __HIP_MEMORY_SCOPE_AGENT);
                        if (v < 256u) { unsigned* c2 = pc + (3 * 64 + (v >> 2)) * 64; unsigned sp = 0u;
                            while (__hip_atomic_load(c2, __ATOMIC_RELAXED, __HIP_MEMORY_SCOPE_AGENT) < 2u) { __builtin_amdgcn_s_sleep(1); if (++sp > (1u << 22)) break; }
                            __builtin_amdgcn_fence(__ATOMIC_ACQUIRE, "agent"); asm volatile("s_waitcnt vmcnt(0)" ::: "memory"); }
                        *(LAS int*)(lds + LDS_CTL) = (int)v; }
                    __syncthreads();
                    const int v = *(LAS int*)(lds + LDS_CTL);
                    if (v >= 256) break;
                    combine_item(p, v >> 5, (v >> 2) & 7, (v & 3) * 512);
                }
            }
        } else if (HAS(7) && ph == 7) {
            phase_combine(p);
        } else if (HAS(12) && ph == 12) {
            phase_rows<1>(p.out, nullptr, NLAT, p.g_final, nullptr, 0, nullptr, p.out, nullptr);
        }
        if (ph + 1 < p0.ph_hi && !(fuse && ph == 11)) {
            if (p0.ph_hi > 1000) cg::this_grid().sync(); else xcd_barrier(xbar);
        }
    }
}

extern "C" void kernel_launch(void* const* d_in, const int* in_sizes, int n_in, void* d_out, int out_size, void* d_ws, size_t ws_size, hipStream_t stream) {
    static int grid = 0;
    if (grid == 0) {
        if (n_in != 20 || out_size != NLAT * DM || ws_size < WS_END) { fprintf(stderr, "kernel_launch: unexpected shapes (n_in %d out %d ws %zu need %zu)\n", n_in, out_size, ws_size, (size_t)WS_END); grid = -1; return; }
        int dev = 0, cus = 0, per_cu = 0;
        hipGetDevice(&dev); hipDeviceGetAttribute(&cus, hipDeviceAttributeMultiprocessorCount, dev);
        if (hipFuncSetAttribute((const void*)fwd_megakernel, hipFuncAttributeMaxDynamicSharedMemorySize, LDS_BYTES) != hipSuccess) { fprintf(stderr, "kernel_launch: hipFuncSetAttribute failed\n"); grid = -1; return; }
        hipOccupancyMaxActiveBlocksPerMultiprocessor(&per_cu, (const void*)fwd_megakernel, 512, LDS_BYTES);
        if (per_cu < 1) { fprintf(stderr, "kernel_launch: occupancy query says %d blocks per CU\n", per_cu); per_cu = 1; }
        (void)hipGetLastError();
        grid = cus * 1;
    }
    if (grid < 0) return;
    (void)hipMemsetAsync((char*)d_ws + WS_MOD, 0, (size_t)(WS_ROPE - WS_MOD), stream);
    Params p{};
    p.x = (const float*)d_in[0]; p.c = (const float*)d_in[1]; p.ctx = (const float*)d_in[2]; p.c_ctx = (const float*)d_in[3]; p.w_mod = (const float*)d_in[4]; p.b_mod = (const float*)d_in[5];
    p.g_norm = (const float*)d_in[6]; p.w_up1 = (const float*)d_in[7]; p.w_dn1 = (const float*)d_in[8]; p.w_up2 = (const float*)d_in[9]; p.w_dn2 = (const float*)d_in[10]; p.w_in = (const float*)d_in[11];
    p.q_gain = (const float*)d_in[12]; p.k_gain = (const float*)d_in[13]; p.conv_w = (const float*)d_in[14]; p.conv_b = (const float*)d_in[15]; p.gate_b = (const float*)d_in[16]; p.m_gain = (const float*)d_in[17];
    p.w_out = (const float*)d_in[18]; p.g_final = (const float*)d_in[19]; p.out = (float*)d_out; p.ws = (unsigned char*)d_ws;
#if MK_MULTI
    for (int ph = 0; ph < NPH; ++ph) { p.ph_lo = ph; p.ph_hi = ph + 1; hipLaunchKernelGGL(fwd_megakernel, dim3(grid), dim3(512), LDS_BYTES, stream, p); }
#else
    p.ph_lo = 0; p.ph_hi = NPH;
    void* args[] = {&p};
    hipError_t e = hipLaunchCooperativeKernel((const void*)fwd_megakernel, dim3(grid), dim3(512), args, LDS_BYTES, stream);
    if (e != hipSuccess) fprintf(stderr, "cooperative launch failed: %s (grid %d)\n", hipGetErrorString(e), grid);
#endif
}
```
